# Optimizing an MI355X kernel written in HIP

```python
import math
import jax, jax.numpy as jnp
from jax import lax
import numpy as np

D_MODEL = 2048
BATCH = 2
SEQ = 8192
DEPTH = 1

MEM_LEN = 256
A_HEADS = 6
A_HEAD_DIM = 128
A_KV_RANK = 256
IDX_HEADS = 16
IDX_DIM = 64
TOPK_MAX = 256
Q_BLOCK = 128
B_HEADS = 12
B_KV_HEADS = 2
B_HEAD_DIM = 64
WINDOW = 128
BAND_BLOCK = 128
C_HEADS = 4
C_HEAD_DIM = 128
NUM_BUCKETS = 32
MAX_DISTANCE = 128
EPS = 1e-6

A_WIDTH = A_HEADS * A_HEAD_DIM
B_WIDTH = B_HEADS * B_HEAD_DIM
B_KV_WIDTH = B_KV_HEADS * B_HEAD_DIM
C_WIDTH = C_HEADS * C_HEAD_DIM
N_BRANCH = 3
IN_SIZES = (A_WIDTH, A_KV_RANK, IDX_HEADS * IDX_DIM, IDX_DIM, IDX_HEADS, A_WIDTH,
            B_WIDTH, B_KV_WIDTH, B_KV_WIDTH, B_WIDTH,
            C_WIDTH, C_WIDTH,
            N_BRANCH * D_MODEL)
IN_COLS = sum(IN_SIZES)

kernel_name = "hybrid_dsa_swa_memory_gated"


def rmsnorm(x, g):
    xf = x.astype(jnp.float32)
    y = xf * lax.rsqrt(jnp.mean(xf * xf, axis=-1, keepdims=True) + EPS)
    return (y * g.astype(jnp.float32)).astype(x.dtype)


def layernorm(x, g, b):
    xf = x.astype(jnp.float32)
    mu = jnp.mean(xf, axis=-1, keepdims=True)
    var = jnp.mean(jnp.square(xf - mu), axis=-1, keepdims=True)
    y = (xf - mu) * lax.rsqrt(var + EPS)
    return (y * g.astype(jnp.float32) + b.astype(jnp.float32)).astype(x.dtype)


def split_cols(y, sizes):
    cuts = np.cumsum(np.array(sizes))[:-1].tolist()
    return jnp.split(y, cuts, axis=-1)


def t5_bucket(dist):
    n = jnp.maximum(dist, 0)
    max_exact = NUM_BUCKETS // 2
    nf = jnp.maximum(n, 1).astype(jnp.float32)
    large = max_exact + (jnp.log(nf / max_exact) / math.log(MAX_DISTANCE / max_exact)
                         * (NUM_BUCKETS - max_exact)).astype(jnp.int32)
    large = jnp.minimum(large, NUM_BUCKETS - 1)
    return jnp.where(n < max_exact, n, large)


def dsa_attention(q, k, v, iq, ik, iw, bias_tab, topk):
    bsz, seq, nh, dh = q.shape
    nb = seq // Q_BLOCK
    key_pos = jnp.arange(seq, dtype=jnp.int32)

    def to_blocks(t):
        return jnp.moveaxis(t.reshape((bsz, nb, Q_BLOCK) + t.shape[2:]), 1, 0)

    def block_fn(args):
        qb, iqb, iwb, t0 = args
        tpos = t0 + jnp.arange(Q_BLOCK, dtype=jnp.int32)
        rel = jax.nn.relu(jnp.einsum('bthd,bsd->bths', iqb, ik))
        score = jnp.einsum('bths,bth->bts', rel, iwb).astype(jnp.float32)
        causal = key_pos[None, :] <= tpos[:, None]
        score = jnp.where(causal[None], score, -jnp.inf)
        _, idx = lax.top_k(score, topk)
        kg = jax.vmap(lambda kk, ii: kk[ii])(k, idx)
        vg = jax.vmap(lambda vv, ii: vv[ii])(v, idx)
        logits = jnp.einsum('bthd,btkhd->bthk', qb, kg).astype(jnp.float32) * (dh ** -0.5)
        dist = tpos[None, :, None] - idx
        bias = jnp.transpose(bias_tab[t5_bucket(dist)], (0, 1, 3, 2)).astype(jnp.float32)
        logits = jnp.where((dist >= 0)[:, :, None, :], logits + bias, -jnp.inf)
        p = jax.nn.softmax(logits, axis=-1).astype(vg.dtype)
        return jnp.einsum('bthk,btkhd->bthd', p, vg)

    t0s = jnp.arange(nb, dtype=jnp.int32) * Q_BLOCK
    out = lax.map(block_fn, (to_blocks(q), to_blocks(iq), to_blocks(iw), t0s))
    return jnp.moveaxis(out, 0, 1).reshape(bsz, seq, nh * dh)


def sliding_window_attention(q, k, v, sinks, bias_tab):
    bsz, seq, hq, dh = q.shape
    hkv = k.shape[2]
    g = hq // hkv
    blk = BAND_BLOCK
    nb = seq // blk
    qb = q.reshape(bsz, nb, blk, hkv, g, dh)

    def band(t):
        tb = t.reshape(bsz, nb, blk, hkv, dh)
        prev = jnp.concatenate([jnp.zeros_like(tb[:, :1]), tb[:, :-1]], axis=1)
        return jnp.concatenate([prev, tb], axis=2)

    kband, vband = band(k), band(v)
    logits = jnp.einsum('bnqhgd,bnkhd->bnhgqk', qb, kband).astype(jnp.float32) * (dh ** -0.5)
    qi = jnp.arange(blk, dtype=jnp.int32)[:, None]
    kj = jnp.arange(2 * blk, dtype=jnp.int32)[None, :]
    dist = blk + qi - kj
    bias = jnp.transpose(bias_tab[t5_bucket(dist)], (2, 0, 1)).reshape(hkv, g, blk, 2 * blk)
    key_pos = jnp.arange(nb, dtype=jnp.int32)[:, None, None] * blk + kj[None] - blk
    valid = (dist >= 0) & (dist < WINDOW) & (key_pos >= 0)
    logits = jnp.where(valid[None, :, None, None], logits + bias.astype(jnp.float32), -jnp.inf)
    sink = jnp.broadcast_to(sinks.astype(jnp.float32).reshape(hkv, g, 1, 1), logits.shape[:-1] + (1,))
    p = jax.nn.softmax(jnp.concatenate([logits, sink], axis=-1), axis=-1)[..., :-1]
    out = jnp.einsum('bnhgqk,bnkhd->bnqhgd', p.astype(v.dtype), vband)
    return out.reshape(bsz, seq, hq * dh)


def memory_attention(q, k, v):
    bsz, seq, nh, dh = q.shape
    logits = jnp.einsum('bthd,bmhd->bhtm', q, k).astype(jnp.float32) * (dh ** -0.5)
    p = jax.nn.softmax(logits, axis=-1).astype(v.dtype)
    return jnp.einsum('bhtm,bmhd->bthd', p, v).reshape(bsz, seq, nh * dh)


def setup_inputs(seed: int = 0) -> dict:
    key = jax.random.key(seed)
    ks = jax.random.split(key, 24)
    f32 = jnp.float32

    def w(k, shape, fan_in):
        return jax.random.normal(k, shape, f32) * (fan_in ** -0.5)

    def gain(k, shape):
        return 1.0 + 0.05 * jax.random.normal(k, shape, f32)

    return {
        "x": jax.random.normal(ks[0], (BATCH, SEQ, D_MODEL), f32),
        "mem": jax.random.normal(ks[1], (BATCH, MEM_LEN, D_MODEL), f32),
        "norm_g": gain(ks[2], (DEPTH, D_MODEL)),
        "w_in": w(ks[3], (DEPTH, D_MODEL, IN_COLS), D_MODEL),
        "kv_norm_g": gain(ks[4], (DEPTH, A_KV_RANK)),
        "w_kv_up": w(ks[5], (DEPTH, A_KV_RANK, 2 * A_WIDTH), A_KV_RANK),
        "idx_k_ln_g": gain(ks[6], (DEPTH, IDX_DIM)),
        "idx_k_ln_b": 0.02 * jax.random.normal(ks[7], (DEPTH, IDX_DIM), f32),
        "q_norm_a": gain(ks[8], (DEPTH, A_HEAD_DIM)),
        "k_norm_a": gain(ks[9], (DEPTH, A_HEAD_DIM)),
        "q_norm_b": gain(ks[10], (DEPTH, B_HEAD_DIM)),
        "k_norm_b": gain(ks[11], (DEPTH, B_HEAD_DIM)),
        "sinks_b": 0.5 * jax.random.normal(ks[12], (DEPTH, B_HEADS), f32),
        "mem_norm_g": gain(ks[13], (DEPTH, D_MODEL)),
        "w_mem_kv": w(ks[14], (DEPTH, D_MODEL, 2 * C_WIDTH), D_MODEL),
        "q_norm_c": gain(ks[15], (DEPTH, C_HEAD_DIM)),
        "k_norm_c": gain(ks[16], (DEPTH, C_HEAD_DIM)),
        "w_up_a": w(ks[17], (DEPTH, A_WIDTH, D_MODEL), A_WIDTH),
        "w_up_b": w(ks[18], (DEPTH, B_WIDTH, D_MODEL), B_WIDTH),
        "w_up_c": w(ks[19], (DEPTH, C_WIDTH, D_MODEL), C_WIDTH),
        "gate_bias": 0.02 * jax.random.normal(ks[20], (DEPTH, N_BRANCH * D_MODEL), f32),
        "w_o": w(ks[21], (DEPTH, D_MODEL, D_MODEL), D_MODEL),
        "rel_bias": 0.5 * jax.random.normal(ks[22], (NUM_BUCKETS, A_HEADS + B_HEADS), f32),
    }


def reference(x, mem, norm_g, w_in, kv_norm_g, w_kv_up, idx_k_ln_g, idx_k_ln_b,
              q_norm_a, k_norm_a, q_norm_b, k_norm_b, sinks_b, mem_norm_g, w_mem_kv,
              q_norm_c, k_norm_c, w_up_a, w_up_b, w_up_c, gate_bias, w_o, rel_bias):
    bsz, seq, _ = x.shape
    mlen = mem.shape[1]
    topk = min(TOPK_MAX, seq // 4)
    bias_a = rel_bias[:, :A_HEADS]
    bias_b = rel_bias[:, A_HEADS:]
    for l in range(DEPTH):
        h = rmsnorm(x, norm_g[l])
        (a_q, a_ckv, i_q, i_k, i_w, a_gate,
         b_q, b_k, b_v, b_gate,
         c_q, c_gate, mix_gate) = split_cols(h @ w_in[l], IN_SIZES)

        ckv = rmsnorm(a_ckv, kv_norm_g[l])
        a_k, a_v = jnp.split(ckv @ w_kv_up[l], 2, axis=-1)
        qa = rmsnorm(a_q.reshape(bsz, seq, A_HEADS, A_HEAD_DIM), q_norm_a[l])
        ka = rmsnorm(a_k.reshape(bsz, seq, A_HEADS, A_HEAD_DIM), k_norm_a[l])
        va = a_v.reshape(bsz, seq, A_HEADS, A_HEAD_DIM)
        iq = i_q.reshape(bsz, seq, IDX_HEADS, IDX_DIM)
        ik = layernorm(i_k, idx_k_ln_g[l], idx_k_ln_b[l])
        iw = i_w * (IDX_HEADS ** -0.5) * (IDX_DIM ** -0.5)
        oa = dsa_attention(qa, ka, va, iq, ik, iw, bias_a, topk) * jax.nn.silu(a_gate)

        qb = rmsnorm(b_q.reshape(bsz, seq, B_HEADS, B_HEAD_DIM), q_norm_b[l])
        kb = rmsnorm(b_k.reshape(bsz, seq, B_KV_HEADS, B_HEAD_DIM), k_norm_b[l])
        vb = b_v.reshape(bsz, seq, B_KV_HEADS, B_HEAD_DIM)
        ob = sliding_window_attention(qb, kb, vb, sinks_b[l], bias_b) * jax.nn.silu(b_gate)

        m_k, m_v = jnp.split(rmsnorm(mem, mem_norm_g[l]) @ w_mem_kv[l], 2, axis=-1)
        qc = rmsnorm(c_q.reshape(bsz, seq, C_HEADS, C_HEAD_DIM), q_norm_c[l])
        kc = rmsnorm(m_k.reshape(bsz, mlen, C_HEADS, C_HEAD_DIM), k_norm_c[l])
        vc = m_v.reshape(bsz, mlen, C_HEADS, C_HEAD_DIM)
        oc = memory_attention(qc, kc, vc) * jax.nn.silu(c_gate)

        g_a, g_b, g_c = jnp.split(jax.nn.sigmoid(mix_gate + gate_bias[l]), N_BRANCH, axis=-1)
        merged = g_a * (oa @ w_up_a[l]) + g_b * (ob @ w_up_b[l]) + g_c * (oc @ w_up_c[l])
        x = x + merged @ w_o[l]
    return x
```

```cpp
#include <hip/hip_runtime.h>
#include <hip/hip_cooperative_groups.h>
#include <cstdio>
#include <cstdint>
namespace cg = cooperative_groups;

#ifndef MK_SINGLE
#define MK_SINGLE 1
#endif

namespace pg8 {
#define PG8_LAS __attribute__((address_space(3)))
typedef unsigned short bf16_t;
typedef short bf16x8 __attribute__((ext_vector_type(8)));
typedef float f32x4 __attribute__((ext_vector_type(4)));
typedef unsigned u32x4 __attribute__((ext_vector_type(4)));
typedef unsigned u32x2 __attribute__((ext_vector_type(2)));
constexpr int BM = 256, BK = 64, HALF = 128, HTB = HALF * BK * 2, STAGE_BYTES = 8 * HTB, NXCD = 8, WGM = 8;

__host__ __device__ __forceinline__ int lds_byte(int r, int c) { const int st = (r >> 4) * 2 + (c >> 5), rr = r & 15, cc = c & 31, ob = rr * 64 + cc * 2; return st * 1024 + (ob ^ (((ob >> 9) & 1) << 5)); }
__host__ __device__ __forceinline__ void stage_rc(int b, int& R, int& C) { const int st = b / 1024, sb = b % 1024, swz = sb ^ (((sb >> 9) & 1) << 5); R = (st >> 1) * 16 + swz / 64; C = (st & 1) * 32 + (swz % 64) / 2; }
__host__ __device__ __forceinline__ int perm32(int rho) { const int n = rho >> 4, i = rho & 15; return 8 * (i >> 2) + 4 * n + (i & 3); }

struct Unit { int pm, pn; };
struct Gemm { const bf16_t* A; const bf16_t* Bt; int M, N, K, lda, ldb; };

struct StaticOrder {
    int nM, nN, nwg, G, c;
    __host__ __device__ void init(int M, int N, int G_, int c_) { nM = M / BM; nN = N / BM; nwg = nM * nN; G = G_; c = c_; }
    __host__ __device__ bool next(int i, Unit& u) const {
        const long L = (long)i * G + c; if (L >= nwg) return false;
        int wgid = (int)L; { const int q = nwg / NXCD, r = nwg % NXCD, xcd = wgid % NXCD, off = wgid / NXCD; wgid = (xcd < r ? xcd * (q + 1) : r * (q + 1) + (xcd - r) * q) + off; }
        const int nig = WGM * nN, gid = wgid / nig, fm = gid * WGM, gsz = (nM - fm) < WGM ? (nM - fm) : WGM;
        u.pm = fm + ((wgid % nig) % gsz); u.pn = (wgid % nig) / gsz; return true;
    }
    __device__ __forceinline__ void a_ready(const Unit&) const {}
    __device__ __forceinline__ void done(const Unit&) const {}
};

__device__ __forceinline__ unsigned cvt_pk_bf16(float lo, float hi) { unsigned r; asm volatile("v_cvt_pk_bf16_f32 %0, %1, %2" : "=v"(r) : "v"(lo), "v"(hi)); return r; }

template <class Epi, class Sched, bool ALIGN_EPI = true, bool SP2 = true>
__device__ __forceinline__ void gemm_phase(PG8_LAS unsigned char* lds, const Gemm g, const Sched& S, const Epi& E) {
    const int tid = threadIdx.x, wid = __builtin_amdgcn_readfirstlane(tid >> 6), lane = tid & 63, wr = wid >> 2, wc = wid & 3, fr = lane & 15, fq = lane >> 4;
    const int nt = g.K / BK;
    unsigned voffA[2], voffB[2];
#pragma unroll
    for (int i = 0; i < 2; ++i) { int R, C; stage_rc(tid * 16 + i * 8192, R, C); const int Rb = Epi::PERM ? ((R & ~31) + perm32(R & 31)) : R;
        voffA[i] = (unsigned)(R * g.lda + C) * 2u; voffB[i] = (unsigned)(Rb * g.ldb + C) * 2u; }
    const size_t kstep = (size_t)(BK * 2);
    const size_t hstepA = (size_t)HALF * g.lda * 2, hstepB = (size_t)HALF * g.ldb * 2;
    const size_t tstepA = 2 * hstepA, tstepB = 2 * hstepB;
    const unsigned ldsw = (unsigned)wid * 1024u;
    const int aoff = lds_byte(wr * 64 + fr, fq * 8), boff = lds_byte(wc * 32 + fr, fq * 8);
#define PG8_SA(b, h) (((b) * 2 + (h)) * HTB)
#define PG8_SB(b, h) ((4 + (b) * 2 + (h)) * HTB)
#define PG8_STAGE(bufoff, gbase, voff) do { _Pragma("unroll") for (int _i = 0; _i < 2; ++_i) \
        __builtin_amdgcn_global_load_lds((const unsigned*)((const char*)(gbase) + (voff)[_i]), (PG8_LAS unsigned*)(lds + (bufoff) + ldsw + _i * 8192), 16, 0, 0); } while (0)
#define PG8_LDA(dst, b, h) do { _Pragma("unroll") for (int m = 0; m < 4; ++m) _Pragma("unroll") for (int k = 0; k < 2; ++k) dst[m][k] = *(const PG8_LAS bf16x8*)(lds + PG8_SA(b, h) + aoff + m * 2048 + k * 1024); } while (0)
#define PG8_LDB(dst, b, h) do { _Pragma("unroll") for (int n = 0; n < 2; ++n) _Pragma("unroll") for (int k = 0; k < 2; ++k) dst[n][k] = *(const PG8_LAS bf16x8*)(lds + PG8_SB(b, h) + boff + n * 2048 + k * 1024); } while (0)
#define PG8_MMA(ai, bj, At, Bt) do { __builtin_amdgcn_s_setprio(1); _Pragma("unroll") for (int m = 0; m < 4; ++m) _Pragma("unroll") for (int n = 0; n < 2; ++n) _Pragma("unroll") for (int k = 0; k < 2; ++k) \
        acc[ai][bj][m][n] = __builtin_amdgcn_mfma_f32_16x16x32_bf16(Bt[n][k], At[m][k], acc[ai][bj][m][n], 0, 0, 0); __builtin_amdgcn_s_setprio(0); } while (0)
#define PG8_WAIT_V(n) asm volatile("s_waitcnt vmcnt(" #n ")" ::: "memory")
#define PG8_WAIT_L(n) asm volatile("s_waitcnt lgkmcnt(" #n ")" ::: "memory")
#define PG8_BAR __builtin_amdgcn_s_barrier()
#define PG8_SCHED __builtin_amdgcn_sched_barrier(0)
    Unit cur, nxt; int ui = 0;
    if (!S.next(0, cur)) return;
    f32x4 acc[2][2][4][2];
#pragma unroll
    for (int a = 0; a < 2; ++a)
#pragma unroll
        for (int b = 0; b < 2; ++b)
#pragma unroll
            for (int m = 0; m < 4; ++m)
#pragma unroll
                for (int n = 0; n < 2; ++n) acc[a][b][m][n] = (f32x4){0.f, 0.f, 0.f, 0.f};
    bf16x8 At[4][2], B0[2][2], B1[2][2];
    const char* cA = (const char*)g.A + (size_t)cur.pm * tstepA; const char* cB = (const char*)g.Bt + (size_t)cur.pn * tstepB;
    S.a_ready(cur);
    if constexpr (SP2) {
        PG8_STAGE(PG8_SB(0, 0), cB, voffB); PG8_STAGE(PG8_SB(0, 1), cB + hstepB, voffB); PG8_STAGE(PG8_SA(0, 0), cA, voffA); PG8_STAGE(PG8_SA(0, 1), cA + hstepA, voffA);
        if (wr == 1) PG8_BAR;
        PG8_WAIT_V(2); PG8_BAR;
        PG8_STAGE(PG8_SB(1, 0), cB + kstep, voffB); PG8_STAGE(PG8_SA(1, 0), cA + kstep, voffA); PG8_STAGE(PG8_SB(1, 1), cB + hstepB + kstep, voffB);
        PG8_WAIT_V(6); PG8_BAR;
    } else {
        PG8_STAGE(PG8_SB(0, 0), cB, voffB); PG8_STAGE(PG8_SA(0, 0), cA, voffA); PG8_STAGE(PG8_SB(0, 1), cB + hstepB, voffB); PG8_STAGE(PG8_SA(0, 1), cA + hstepA, voffA);
        if (wr == 1) PG8_BAR;
        PG8_WAIT_V(4); PG8_BAR;
        PG8_STAGE(PG8_SB(1, 0), cB + kstep, voffB); PG8_STAGE(PG8_SA(1, 0), cA + kstep, voffA); PG8_STAGE(PG8_SB(1, 1), cB + hstepB + kstep, voffB);
        PG8_WAIT_V(6); PG8_BAR;
    }
    for (;;) {
        const bool has_next = S.next(ui + 1, nxt);
        const char* nA = has_next ? (const char*)g.A + (size_t)nxt.pm * tstepA : cA; const char* nB = has_next ? (const char*)g.Bt + (size_t)nxt.pn * tstepB : cB;
#pragma unroll 1
        for (int t = 0; t < nt; t += 2) {
            const bool last = (t == nt - 2);
            const char* a1 = cA + (size_t)(t + 1) * kstep;
            const char* a2 = last ? nA : cA + (size_t)(t + 2) * kstep; const char* b2 = last ? nB : cB + (size_t)(t + 2) * kstep;
            const char* a3 = a2 + kstep; const char* b3 = b2 + kstep;
            if (last && has_next) S.a_ready(nxt);
            if constexpr (SP2) {
            PG8_LDB(B0, 0, 0); PG8_LDB(B1, 0, 1); PG8_SCHED; PG8_LDA(At, 0, 0); PG8_STAGE(PG8_SA(1, 1), a1 + hstepA, voffA);
            PG8_WAIT_V(8); PG8_WAIT_L(0); PG8_BAR; PG8_MMA(0, 0, At, B0); PG8_MMA(0, 1, At, B1); PG8_BAR; PG8_SCHED;
            PG8_LDA(At, 0, 1); PG8_STAGE(PG8_SB(0, 0), b2, voffB); PG8_STAGE(PG8_SB(0, 1), b2 + hstepB, voffB); PG8_STAGE(PG8_SA(0, 0), a2, voffA);
            PG8_WAIT_V(8); PG8_WAIT_L(0); PG8_BAR; PG8_MMA(1, 0, At, B0); PG8_MMA(1, 1, At, B1); PG8_BAR; PG8_SCHED;
            PG8_LDB(B0, 1, 0); PG8_LDB(B1, 1, 1); PG8_SCHED; PG8_LDA(At, 1, 0); PG8_STAGE(PG8_SA(0, 1), a2 + hstepA, voffA);
            PG8_WAIT_V(8); PG8_WAIT_L(0); PG8_BAR; PG8_MMA(0, 0, At, B0); PG8_MMA(0, 1, At, B1); PG8_BAR; PG8_SCHED;
            PG8_LDA(At, 1, 1); PG8_STAGE(PG8_SB(1, 0), b3, voffB); PG8_STAGE(PG8_SB(1, 1), b3 + hstepB, voffB); PG8_STAGE(PG8_SA(1, 0), a3, voffA);
            PG8_WAIT_V(8); PG8_WAIT_L(0); PG8_BAR; PG8_MMA(1, 0, At, B0); PG8_MMA(1, 1, At, B1); PG8_BAR; PG8_SCHED;
            } else {
            PG8_LDB(B0, 0, 0); PG8_SCHED; PG8_LDA(At, 0, 0); PG8_STAGE(PG8_SA(1, 1), a1 + hstepA, voffA);
            PG8_WAIT_L(8); PG8_BAR; PG8_WAIT_L(0); PG8_MMA(0, 0, At, B0); PG8_BAR; PG8_SCHED;
            PG8_LDB(B1, 0, 1); PG8_STAGE(PG8_SB(0, 0), b2, voffB);
            PG8_BAR; PG8_WAIT_L(0); PG8_MMA(0, 1, At, B1); PG8_BAR;
            PG8_LDA(At, 0, 1); PG8_STAGE(PG8_SA(0, 0), a2, voffA);
            PG8_BAR; PG8_WAIT_L(0); PG8_MMA(1, 0, At, B0); PG8_BAR; PG8_SCHED;
            PG8_STAGE(PG8_SB(0, 1), b2 + hstepB, voffB);
            PG8_WAIT_V(6); PG8_BAR; PG8_MMA(1, 1, At, B1); PG8_BAR;
            PG8_LDB(B0, 1, 0); PG8_SCHED; PG8_LDA(At, 1, 0); PG8_STAGE(PG8_SA(0, 1), a2 + hstepA, voffA);
            PG8_WAIT_L(8); PG8_BAR; PG8_WAIT_L(0); PG8_MMA(0, 0, At, B0); PG8_BAR; PG8_SCHED;
            PG8_LDB(B1, 1, 1); PG8_STAGE(PG8_SB(1, 0), b3, voffB);
            PG8_BAR; PG8_WAIT_L(0); PG8_MMA(0, 1, At, B1); PG8_BAR;
            PG8_LDA(At, 1, 1); PG8_STAGE(PG8_SA(1, 0), a3, voffA);
            PG8_BAR; PG8_WAIT_L(0); PG8_MMA(1, 0, At, B0); PG8_BAR; PG8_SCHED;
            PG8_STAGE(PG8_SB(1, 1), b3 + hstepB, voffB);
            PG8_WAIT_V(6); PG8_BAR; PG8_MMA(1, 1, At, B1); PG8_BAR;
            }
        }
        if constexpr (ALIGN_EPI) { if (wr == 0) PG8_BAR; }
        E(acc, cur, wr, wc, fr, fq);
        if (!has_next) break;
#pragma unroll
        for (int a = 0; a < 2; ++a)
#pragma unroll
            for (int b = 0; b < 2; ++b)
#pragma unroll
                for (int m = 0; m < 4; ++m)
#pragma unroll
                    for (int n = 0; n < 2; ++n) acc[a][b][m][n] = (f32x4){0.f, 0.f, 0.f, 0.f};
        cur = nxt; cA = nA; cB = nB; ++ui;
        if constexpr (ALIGN_EPI) { if (wr == 1) PG8_BAR; }
    }
    PG8_WAIT_V(0);
    if constexpr (!ALIGN_EPI) { if (wr == 0) PG8_BAR; }
    PG8_BAR;
#undef PG8_SA
#undef PG8_SB
#undef PG8_STAGE
#undef PG8_LDA
#undef PG8_LDB
#undef PG8_MMA
#undef PG8_WAIT_V
#undef PG8_WAIT_L
#undef PG8_BAR
#undef PG8_SCHED
}
}

using pg8::bf16_t; using pg8::f32x4; using pg8::u32x4; using pg8::u32x2;
#define LAS __attribute__((address_space(3)))
constexpr int BATCH = 2, SEQ = 8192, DM = 2048, M = BATCH * SEQ, MEMLEN = 256;
constexpr int IN_COLS = 11856, NWIN = 12032, NWIN_A = 5888, NWIN_B = 6144;
constexpr int RAWW = 2816;
constexpr int TOPK = 256;
constexpr float EPS = 1e-6f;
constexpr int NWAVES = 8, NTHREADS = 512;
constexpr int LDS_BYTES = 163840;
constexpr int NPH = 8;

constexpr size_t MiB = 1u << 20;
constexpr size_t WS_CTL = 0;
constexpr size_t WS_WMEMT = 1 * MiB, WS_WKT = 5 * MiB, WS_WQBD = 6 * MiB, WS_WVBD = 9 * MiB, WS_WUPT = 12 * MiB, WS_WOT = 20 * MiB;
constexpr size_t WS_WINT = 28 * MiB;
constexpr size_t WS_QABS = WS_WINT;
constexpr size_t WS_H = 76 * MiB;
constexpr size_t WS_OP = WS_H;
constexpr size_t WS_BIG = 140 * MiB;
constexpr size_t WS_QA = 332 * MiB, WS_CKV = 356 * MiB, WS_IK = 364 * MiB, WS_IW = 366 * MiB, WS_BQ = 367 * MiB, WS_BK = 391 * MiB, WS_BV = 395 * MiB, WS_CQ = 399 * MiB;
constexpr size_t WS_KC = 415 * MiB, WS_VC = 416 * MiB, WS_KSS = 417 * MiB;
constexpr size_t WS_MERGED = 332 * MiB;
constexpr size_t WS_MEMN = 418 * MiB, WS_RAWM = 420 * MiB, WS_IDX = 422 * MiB, WS_PC = 438 * MiB, WS_END = 486 * MiB;
constexpr size_t DO_GATE = 0, DO_IQ = 64 * MiB;

__device__ const unsigned char T5_BUCKET[128] = {
0,1,2,3,4,5,6,7,8,9,10,11,12,13,14,15,16,16,16,17,17,18,18,18,19,19,19,20,20,20,20,21,21,21,21,22,22,22,22,22,23,23,23,23,23,23,24,24,24,24,24,24,25,25,25,25,25,25,25,26,26,26,26,26,26,26,26,27,27,27,27,27,27,27,27,27,27,28,28,28,28,28,28,28,28,28,28,29,29,29,29,29,29,29,29,29,29,29,29,30,30,30,30,30,30,30,30,30,30,30,30,30,30,31,31,31,31,31,31,31,31,31,31,31,31,31,31,31};

__device__ __forceinline__ float bf2f(unsigned short b) { return __uint_as_float(((unsigned)b) << 16); }
__device__ __forceinline__ unsigned f2bf(float f) { unsigned u = __float_as_uint(f); return (u + 0x7fffu + ((u >> 16) & 1u)) >> 16; }
__device__ __forceinline__ unsigned pk2(float lo, float hi) { return f2bf(lo) | (f2bf(hi) << 16); }
__device__ __forceinline__ float wave_sum(float v) {
#pragma unroll
    for (int o = 1; o < 64; o <<= 1) v += __shfl_xor(v, o);
    return v;
}
__device__ __forceinline__ float wave_max(float v) {
#pragma unroll
    for (int o = 1; o < 64; o <<= 1) v = fmaxf(v, __shfl_xor(v, o));
    return v;
}
__device__ __forceinline__ float silu_f(float v) { return v / (1.f + __expf(-v)); }
__device__ __forceinline__ float sigmoid_f(float v) { return 1.f / (1.f + __expf(-v)); }

struct Args { const float* in[23]; float* out; unsigned char* ws; int ph_lo, ph_hi, single, pad; };
struct Ctx {
    const float* const* in; float* out; unsigned char* ws;
    LAS unsigned char* lds; int tid, lane, wave, vcu, G;
};

#define EPI_ROWS(ai, m) (u.pm * 256 + (ai) * 128 + wr * 64 + (m) * 16 + fr)
#define EPI_COLT(bj, n) ((bj) * 128 + wc * 32 + (n) * 16 + 4 * fq)

struct EpiInA {
    static constexpr bool PERM = false;
    float* RAW; bf16_t* IQ; bf16_t* GATE;
    __device__ __forceinline__ void operator()(const f32x4 (&acc)[2][2][4][2], const pg8::Unit& u, int wr, int wc, int fr, int fq) const {
        const int pn = u.pn; int kind, base;
        if (pn <= 3) { kind = 0; base = pn * 256; }
        else if (pn <= 7) { kind = 1; base = (pn - 4) * 256; }
        else if (pn == 8) { kind = 0; base = 1024; }
        else if (pn <= 11) { kind = 2; base = (pn - 9) * 256; }
        else if (pn <= 14) { kind = 0; base = 1280 + (pn - 12) * 256; }
        else if (pn == 15) { kind = 0; base = 2048; }
        else if (pn <= 18) { kind = 2; base = 768 + (pn - 16) * 256; }
        else if (pn <= 20) { kind = 0; base = 2304 + (pn - 19) * 256; }
        else { kind = 2; base = 1536 + (pn - 21) * 256; }
#pragma unroll
        for (int ai = 0; ai < 2; ++ai)
#pragma unroll
            for (int m = 0; m < 4; ++m) { const size_t row = EPI_ROWS(ai, m);
#pragma unroll
                for (int bj = 0; bj < 2; ++bj)
#pragma unroll
                    for (int n = 0; n < 2; ++n) { const int c = base + EPI_COLT(bj, n); const f32x4 v = acc[ai][bj][m][n];
                        if (kind == 0) *(f32x4*)(RAW + row * RAWW + c) = v;
                        else if (kind == 1) { u32x2 w; w.x = pk2(v[0], v[1]); w.y = pk2(v[2], v[3]); *(u32x2*)(IQ + row * 1024 + c) = w; }
                        else { u32x2 w; w.x = pk2(silu_f(v[0]), silu_f(v[1])); w.y = pk2(silu_f(v[2]), silu_f(v[3])); *(u32x2*)(GATE + row * 2048 + c) = w; } } }
    }
};
struct EpiMix {
    static constexpr bool PERM = false;
    bf16_t* MIX; const float* gb;
    __device__ __forceinline__ void operator()(const f32x4 (&acc)[2][2][4][2], const pg8::Unit& u, int wr, int wc, int fr, int fq) const {
#pragma unroll
        for (int bj = 0; bj < 2; ++bj)
#pragma unroll
            for (int n = 0; n < 2; ++n) { const int c = u.pn * 256 + EPI_COLT(bj, n); const f32x4 b = *(const f32x4*)(gb + c);
#pragma unroll
                for (int ai = 0; ai < 2; ++ai)
#pragma unroll
                    for (int m = 0; m < 4; ++m) { const size_t row = EPI_ROWS(ai, m); const f32x4 v = acc[ai][bj][m][n] + b;
                        u32x2 w; w.x = pk2(sigmoid_f(v[0]), sigmoid_f(v[1])); w.y = pk2(sigmoid_f(v[2]), sigmoid_f(v[3])); *(u32x2*)(MIX + row * 6144 + c) = w;
                        asm volatile("" ::: "memory"); } }
    }
};
struct EpiF32 {
    static constexpr bool PERM = false;
    float* C; int ldc;
    __device__ __forceinline__ void operator()(const f32x4 (&acc)[2][2][4][2], const pg8::Unit& u, int wr, int wc, int fr, int fq) const {
#pragma unroll
        for (int ai = 0; ai < 2; ++ai)
#pragma unroll
            for (int m = 0; m < 4; ++m) { const size_t row = EPI_ROWS(ai, m);
#pragma unroll
                for (int bj = 0; bj < 2; ++bj)
#pragma unroll
                    for (int n = 0; n < 2; ++n) *(f32x4*)(C + row * ldc + u.pn * 256 + EPI_COLT(bj, n)) = acc[ai][bj][m][n]; }
    }
};
struct EpiBf {
    static constexpr bool PERM = false;
    bf16_t* O; int ldc;
    __device__ __forceinline__ void operator()(const f32x4 (&acc)[2][2][4][2], const pg8::Unit& u, int wr, int wc, int fr, int fq) const {
#pragma unroll
        for (int ai = 0; ai < 2; ++ai)
#pragma unroll
            for (int m = 0; m < 4; ++m) { const size_t row = EPI_ROWS(ai, m);
#pragma unroll
                for (int bj = 0; bj < 2; ++bj)
#pragma unroll
                    for (int n = 0; n < 2; ++n) { const f32x4 v = acc[ai][bj][m][n]; u32x2 w; w.x = pk2(v[0], v[1]); w.y = pk2(v[2], v[3]);
                        *(u32x2*)(O + row * ldc + u.pn * 256 + EPI_COLT(bj, n)) = w; } }
    }
};
struct EpiKss {
    static constexpr bool PERM = false;
    float* KSS;
    __device__ __forceinline__ void operator()(const f32x4 (&acc)[2][2][4][2], const pg8::Unit& u, int wr, int wc, int fr, int fq) const {
#pragma unroll
        for (int ai = 0; ai < 2; ++ai)
#pragma unroll
            for (int m = 0; m < 4; ++m) { const size_t row = EPI_ROWS(ai, m);
#pragma unroll
                for (int bj = 0; bj < 2; ++bj) { float s = 0.f;
#pragma unroll
                    for (int n = 0; n < 2; ++n) { const f32x4 v = acc[ai][bj][m][n]; s += (v[0] * v[0] + v[1] * v[1]) + (v[2] * v[2] + v[3] * v[3]); }
                    atomicAdd(KSS + row * 8 + 2 * u.pn + bj, s); }
                asm volatile("" ::: "memory"); }
    }
};
struct EpiGateMul {
    static constexpr bool PERM = false;
    bf16_t* OP; const bf16_t* GATE;
    __device__ __forceinline__ void operator()(const f32x4 (&acc)[2][2][4][2], const pg8::Unit& u, int wr, int wc, int fr, int fq) const {
#pragma unroll
        for (int ai = 0; ai < 2; ++ai)
#pragma unroll
            for (int m = 0; m < 4; ++m) { const size_t row = EPI_ROWS(ai, m);
#pragma unroll
                for (int bj = 0; bj < 2; ++bj)
#pragma unroll
                    for (int n = 0; n < 2; ++n) { const int c = u.pn * 256 + EPI_COLT(bj, n); const f32x4 v = acc[ai][bj][m][n];
                        const u32x2 gw = *(const u32x2*)(GATE + row * 2048 + c);
                        u32x2 w; w.x = pk2(v[0] * bf2f(gw.x & 0xffff), v[1] * bf2f(gw.x >> 16)); w.y = pk2(v[2] * bf2f(gw.y & 0xffff), v[3] * bf2f(gw.y >> 16));
                        *(u32x2*)(OP + row * 2048 + c) = w; }
                asm volatile("" ::: "memory"); }
    }
};
struct EpiMerge {
    static constexpr bool PERM = false;
    float* MRG; bf16_t* MERGED; const bf16_t* MIX; int br;
    __device__ __forceinline__ void operator()(const f32x4 (&acc)[2][2][4][2], const pg8::Unit& u, int wr, int wc, int fr, int fq) const {
#pragma unroll
        for (int ai = 0; ai < 2; ++ai)
#pragma unroll
            for (int m = 0; m < 4; ++m) { const size_t row = EPI_ROWS(ai, m);
#pragma unroll
                for (int bj = 0; bj < 2; ++bj)
#pragma unroll
                    for (int n = 0; n < 2; ++n) { const int c = u.pn * 256 + EPI_COLT(bj, n); const f32x4 v = acc[ai][bj][m][n];
                        const u32x2 gw = *(const u32x2*)(MIX + row * 6144 + br * 2048 + c);
                        f32x4 r; r[0] = v[0] * bf2f(gw.x & 0xffff); r[1] = v[1] * bf2f(gw.x >> 16); r[2] = v[2] * bf2f(gw.y & 0xffff); r[3] = v[3] * bf2f(gw.y >> 16);
                        float* mp = MRG + row * 2048 + c;
                        if (br > 0) r = r + *(const f32x4*)mp;
                        if (br < 2) *(f32x4*)mp = r;
                        else { u32x2 w; w.x = pk2(r[0], r[1]); w.y = pk2(r[2], r[3]); *(u32x2*)(MERGED + row * 2048 + c) = w; } }
                asm volatile("" ::: "memory"); }
    }
};
struct EpiOut {
    static constexpr bool PERM = false;
    float* out; const float* x;
    __device__ __forceinline__ void operator()(const f32x4 (&acc)[2][2][4][2], const pg8::Unit& u, int wr, int wc, int fr, int fq) const {
#pragma unroll
        for (int ai = 0; ai < 2; ++ai)
#pragma unroll
            for (int m = 0; m < 4; ++m) { const size_t row = EPI_ROWS(ai, m);
#pragma unroll
                for (int bj = 0; bj < 2; ++bj)
#pragma unroll
                    for (int n = 0; n < 2; ++n) { const size_t o = row * 2048 + u.pn * 256 + EPI_COLT(bj, n);
                        *(f32x4*)(out + o) = *(const f32x4*)(x + o) + acc[ai][bj][m][n]; }
                asm volatile("" ::: "memory"); }
    }
};

template <class F>
__device__ __forceinline__ void cvt_matrix(Ctx& C, bf16_t* dst, int dld, int Nn, int K, const F& f) {
    const long total = (long)Nn * (K / 8);
    for (long it = (long)C.vcu * NTHREADS + C.tid; it < total; it += (long)C.G * NTHREADS) {
        const int n = (int)(it % Nn), k0 = (int)(it / Nn) * 8;
        u32x4 w; w.x = pk2(f(n, k0), f(n, k0 + 1)); w.y = pk2(f(n, k0 + 2), f(n, k0 + 3)); w.z = pk2(f(n, k0 + 4), f(n, k0 + 5)); w.w = pk2(f(n, k0 + 6), f(n, k0 + 7));
        *(u32x4*)(dst + (size_t)n * dld + k0) = w;
    }
}
__device__ __forceinline__ void rms_row_to_bf16(const float* xrow, const float* g, bf16_t* orow, int lane) {
    const f32x4* xr = (const f32x4*)xrow + lane; const f32x4* gr = (const f32x4*)g + lane;
    f32x4 v[8]; float s = 0.f;
#pragma unroll
    for (int j = 0; j < 8; ++j) { v[j] = xr[64 * j]; s += (v[j][0] * v[j][0] + v[j][1] * v[j][1]) + (v[j][2] * v[j][2] + v[j][3] * v[j][3]); }
    const float rstd = 1.0f / sqrtf(wave_sum(s) * (1.f / 2048.f) + EPS);
    u32x2* o8 = (u32x2*)orow + lane;
#pragma unroll
    for (int j = 0; j < 8; ++j) { const f32x4 gg = gr[64 * j]; u32x2 w; w.x = pk2(v[j][0] * rstd * gg[0], v[j][1] * rstd * gg[1]); w.y = pk2(v[j][2] * rstd * gg[2], v[j][3] * rstd * gg[3]); o8[64 * j] = w; }
}
__device__ __forceinline__ void p0_prologue(Ctx& C) {
    unsigned char* ws = C.ws;
    const float* w_in = C.in[3]; const float* w_kv_up = C.in[5]; const float* k_norm_a = C.in[9]; const float* w_mem_kv = C.in[14];
    const float* w_up_a = C.in[17]; const float* w_up_b = C.in[18]; const float* w_up_c = C.in[19]; const float* w_o = C.in[21];
    cvt_matrix(C, (bf16_t*)(ws + WS_WINT), 2048, NWIN, 2048, [=](int n, int k) -> float {
        if (n >= 2128 && n < 2304) return 0.f; const int c = n < 2128 ? n : n - 176; return w_in[(size_t)k * IN_COLS + c]; });
    cvt_matrix(C, (bf16_t*)(ws + WS_WMEMT), 2048, 1024, 2048, [=](int n, int k) -> float { return w_mem_kv[(size_t)k * 1024 + n]; });
    cvt_matrix(C, (bf16_t*)(ws + WS_WKT), 256, 768, 256, [=](int n, int k) -> float { return w_kv_up[(size_t)k * 1536 + n]; });
    cvt_matrix(C, (bf16_t*)(ws + WS_WVBD), 1536, 768, 1536, [=](int n, int k) -> float { return (k >> 8) == (n >> 7) ? w_kv_up[(size_t)(k & 255) * 1536 + 768 + n] : 0.f; });
    cvt_matrix(C, (bf16_t*)(ws + WS_WQBD), 768, 1536, 768, [=](int n, int k) -> float {
        return (k >> 7) == (n >> 8) ? w_kv_up[(size_t)(n & 255) * 1536 + k] * k_norm_a[k & 127] * 0.08838834764831845f : 0.f; });
    cvt_matrix(C, (bf16_t*)(ws + WS_WUPT), 2048, 2048, 2048, [=](int n, int k) -> float {
        return k < 768 ? w_up_a[(size_t)k * 2048 + n] : (k < 1536 ? w_up_b[(size_t)(k - 768) * 2048 + n] : w_up_c[(size_t)(k - 1536) * 2048 + n]); });
    cvt_matrix(C, (bf16_t*)(ws + WS_WOT), 2048, 2048, 2048, [=](int n, int k) -> float { return w_o[(size_t)k * 2048 + n]; });
    const int gw = C.vcu * NWAVES + C.wave, NGW = C.G * NWAVES;
    for (int m = gw; m < M; m += NGW) rms_row_to_bf16(C.in[0] + (size_t)m * DM, C.in[2], (bf16_t*)(ws + WS_H) + (size_t)m * DM, C.lane);
    for (int m = gw; m < BATCH * MEMLEN; m += NGW) rms_row_to_bf16(C.in[1] + (size_t)m * DM, C.in[13], (bf16_t*)(ws + WS_MEMN) + (size_t)m * DM, C.lane);
    float* kss = (float*)(ws + WS_KSS);
    for (int i = C.vcu * NTHREADS + C.tid; i < M * 8; i += C.G * NTHREADS) kss[i] = 0.f;
}

__device__ __forceinline__ void p2_post(Ctx& C) {
    unsigned char* ws = C.ws; const int lane = C.lane;
    const float* RAW = (const float*)(ws + WS_BIG);
    bf16_t* QA = (bf16_t*)(ws + WS_QA); bf16_t* CKV = (bf16_t*)(ws + WS_CKV); bf16_t* IK = (bf16_t*)(ws + WS_IK); float* IW = (float*)(ws + WS_IW);
    bf16_t* BQ = (bf16_t*)(ws + WS_BQ); bf16_t* BK = (bf16_t*)(ws + WS_BK); bf16_t* BV = (bf16_t*)(ws + WS_BV); bf16_t* CQ = (bf16_t*)(ws + WS_CQ);
    const float* kv_norm_g = C.in[4]; const float* ln_g = C.in[6]; const float* ln_b = C.in[7]; const float* q_norm_a = C.in[8];
    const float* q_norm_b = C.in[10]; const float* k_norm_b = C.in[11]; const float* q_norm_c = C.in[15]; const float* k_norm_c = C.in[16];
    const int gw = C.vcu * NWAVES + C.wave, NGW = C.G * NWAVES;
    for (int row = gw; row < M; row += NGW) {
        const float* r = RAW + (size_t)row * RAWW;
        for (int h = 0; h < 6; ++h) { const float v0 = r[h * 128 + 2 * lane], v1 = r[h * 128 + 2 * lane + 1];
            const float rs = 1.0f / sqrtf(wave_sum(v0 * v0 + v1 * v1) * (1.f / 128.f) + EPS);
            *(unsigned*)(QA + (size_t)row * 768 + h * 128 + 2 * lane) = pk2(v0 * rs * q_norm_a[2 * lane], v1 * rs * q_norm_a[2 * lane + 1]); }
        { const f32x4 v = *(const f32x4*)(r + 768 + 4 * lane); const f32x4 g = *(const f32x4*)(kv_norm_g + 4 * lane);
            const float rs = 1.0f / sqrtf(wave_sum((v[0] * v[0] + v[1] * v[1]) + (v[2] * v[2] + v[3] * v[3])) * (1.f / 256.f) + EPS);
            u32x2 w; w.x = pk2(v[0] * rs * g[0], v[1] * rs * g[1]); w.y = pk2(v[2] * rs * g[2], v[3] * rs * g[3]); *(u32x2*)(CKV + (size_t)row * 256 + 4 * lane) = w; }
        { const float v = r[1024 + lane]; const float mean = wave_sum(v) * (1.f / 64.f); const float d = v - mean; const float var = wave_sum(d * d) * (1.f / 64.f);
            IK[(size_t)row * 64 + lane] = (bf16_t)f2bf(d * (1.0f / sqrtf(var + EPS)) * ln_g[lane] + ln_b[lane]);
            if (lane < 16) IW[(size_t)row * 16 + lane] = r[1024 + 64 + lane] * 0.03125f; }
        for (int h = 0; h < 12; ++h) { const float v = r[1280 + h * 64 + lane]; const float rs = 1.0f / sqrtf(wave_sum(v * v) * (1.f / 64.f) + EPS);
            BQ[(size_t)row * 768 + h * 64 + lane] = (bf16_t)f2bf(v * rs * q_norm_b[lane] * 0.125f); }
        for (int g = 0; g < 2; ++g) { const float v = r[2048 + g * 64 + lane]; const float rs = 1.0f / sqrtf(wave_sum(v * v) * (1.f / 64.f) + EPS);
            BK[(size_t)row * 128 + g * 64 + lane] = (bf16_t)f2bf(v * rs * k_norm_b[lane]);
            BV[(size_t)row * 128 + g * 64 + lane] = (bf16_t)f2bf(r[2048 + 128 + g * 64 + lane]); }
        for (int h = 0; h < 4; ++h) { const float v0 = r[2304 + h * 128 + 2 * lane], v1 = r[2304 + h * 128 + 2 * lane + 1];
            const float rs = 1.0f / sqrtf(wave_sum(v0 * v0 + v1 * v1) * (1.f / 128.f) + EPS) * 0.08838834764831845f;
            *(unsigned*)(CQ + (size_t)row * 512 + h * 128 + 2 * lane) = pk2(v0 * rs * q_norm_c[2 * lane], v1 * rs * q_norm_c[2 * lane + 1]); }
    }
    const float* RAWM = (const float*)(ws + WS_RAWM); bf16_t* KC = (bf16_t*)(ws + WS_KC); bf16_t* VC = (bf16_t*)(ws + WS_VC);
    for (int row = gw; row < BATCH * MEMLEN; row += NGW) {
        const float* r = RAWM + (size_t)row * 1024;
        for (int h = 0; h < 4; ++h) { const float v0 = r[h * 128 + 2 * lane], v1 = r[h * 128 + 2 * lane + 1];
            const float rs = 1.0f / sqrtf(wave_sum(v0 * v0 + v1 * v1) * (1.f / 128.f) + EPS);
            *(unsigned*)(KC + (size_t)row * 512 + h * 128 + 2 * lane) = pk2(v0 * rs * k_norm_c[2 * lane], v1 * rs * k_norm_c[2 * lane + 1]);
            *(unsigned*)(VC + (size_t)row * 512 + h * 128 + 2 * lane) = pk2(r[512 + h * 128 + 2 * lane], r[512 + h * 128 + 2 * lane + 1]); }
    }
}

__device__ __forceinline__ unsigned block_sum_u32(unsigned v, volatile LAS unsigned* red, int wave, int lane) {
#pragma unroll
    for (int o = 1; o < 64; o <<= 1) v += __shfl_xor(v, o);
    __syncthreads();
    if (lane == 0) red[wave] = v;
    __syncthreads();
    unsigned s = 0;
#pragma unroll
    for (int w = 0; w < NWAVES; ++w) s += red[w];
    return s;
}
__device__ __forceinline__ void naive_indexer(Ctx& C) {
    unsigned char* ws = C.ws; const int tid = C.tid, lane = C.lane, wave = C.wave;
    const bf16_t* IQ = (const bf16_t*)((unsigned char*)C.out + DO_IQ); const bf16_t* IK = (const bf16_t*)(ws + WS_IK); const float* IW = (const float*)(ws + WS_IW);
    int* IDX = (int*)(ws + WS_IDX);
    LAS float* sc = (LAS float*)C.lds;
    LAS unsigned* keys = (LAS unsigned*)C.lds;
    LAS float* qf = (LAS float*)(C.lds + 32768);
    LAS float* wv = (LAS float*)(C.lds + 32768 + 4096);
    volatile LAS unsigned* red = (volatile LAS unsigned*)(C.lds + 32768 + 4096 + 64);
    volatile LAS unsigned* scan = (volatile LAS unsigned*)(C.lds + 32768 + 4096 + 128);
    for (int qi = C.vcu; qi < M; qi += C.G) {
        const int q = qi;
        const int b = q / SEQ, t = q % SEQ, N = t + 1;
        __syncthreads();
        for (int i = tid; i < 1024; i += NTHREADS) qf[i] = bf2f(IQ[(size_t)q * 1024 + i]);
        if (tid < 16) wv[tid] = IW[(size_t)q * 16 + tid];
        __syncthreads();
        for (int j = tid; j < N; j += NTHREADS) {
            const u32x4* kp = (const u32x4*)(IK + (size_t)(b * SEQ + j) * 64);
            float k[64];
#pragma unroll
            for (int c8 = 0; c8 < 8; ++c8) { const u32x4 w = kp[c8];
                k[c8 * 8 + 0] = bf2f(w.x & 0xffff); k[c8 * 8 + 1] = bf2f(w.x >> 16); k[c8 * 8 + 2] = bf2f(w.y & 0xffff); k[c8 * 8 + 3] = bf2f(w.y >> 16);
                k[c8 * 8 + 4] = bf2f(w.z & 0xffff); k[c8 * 8 + 5] = bf2f(w.z >> 16); k[c8 * 8 + 6] = bf2f(w.w & 0xffff); k[c8 * 8 + 7] = bf2f(w.w >> 16); }
            float s = 0.f;
            for (int h = 0; h < 16; ++h) { float d = 0.f;
#pragma unroll
                for (int e = 0; e < 64; ++e) d += qf[h * 64 + e] * k[e];
                s += wv[h] * fmaxf(d, 0.f); }
            sc[j] = s;
        }
        __syncthreads();
        if (N <= TOPK) { if (tid < TOPK) IDX[(size_t)q * TOPK + tid] = tid < N ? tid : -1; continue; }
        for (int j = tid; j < N; j += NTHREADS) { const unsigned uu = __float_as_uint(sc[j]); keys[j] = (uu & 0x80000000u) ? ~uu : (uu | 0x80000000u); }
        __syncthreads();
        unsigned prefix = 0u;
        for (int bit = 31; bit >= 0; --bit) {
            const unsigned cand = prefix | (1u << bit); unsigned c = 0;
            for (int j = tid; j < N; j += NTHREADS) c += keys[j] >= cand ? 1u : 0u;
            const unsigned tot = block_sum_u32(c, red, wave, lane);
            if (tot >= (unsigned)TOPK) prefix = cand;
        }
        unsigned cg_ = 0, ce = 0;
        for (int j = tid; j < N; j += NTHREADS) { const unsigned kx = keys[j]; cg_ += kx > prefix ? 1u : 0u; ce += kx == prefix ? 1u : 0u; }
        const unsigned ngt = block_sum_u32(cg_, red, wave, lane);
        const unsigned neq = block_sum_u32(ce, red, wave, lane);
        const unsigned need = (unsigned)TOPK - ngt;
        const bool take_eq = (neq == need);
        unsigned mine = take_eq ? cg_ + ce : cg_;
        unsigned incl = mine;
#pragma unroll
        for (int o = 1; o < 64; o <<= 1) { const unsigned y = __shfl_up(incl, o); if (lane >= o) incl += y; }
        __syncthreads();
        if (lane == 63) scan[wave] = incl;
        __syncthreads();
        unsigned base = 0;
        for (int w = 0; w < wave; ++w) base += scan[w];
        unsigned total = 0;
        for (int w = 0; w < NWAVES; ++w) total += scan[w];
        unsigned pos = base + incl - mine;
        for (int j = tid; j < N; j += NTHREADS) { const unsigned kx = keys[j]; if (kx > prefix || (take_eq && kx == prefix)) IDX[(size_t)q * TOPK + (pos++)] = j; }
        if (neq != need && tid == 0) {
            unsigned p = total, left = need;
            for (int j = 0; j < N && left > 0; ++j) if (keys[j] == prefix) { IDX[(size_t)q * TOPK + (p++)] = j; --left; }
        }
    }
}

__device__ __forceinline__ void naive_swa(Ctx& C) {
    unsigned char* ws = C.ws; const int lane = C.lane;
    const bf16_t* BQ = (const bf16_t*)(ws + WS_BQ); const bf16_t* BK = (const bf16_t*)(ws + WS_BK); const bf16_t* BV = (const bf16_t*)(ws + WS_BV);
    const bf16_t* GATE = (const bf16_t*)((unsigned char*)C.out + DO_GATE); bf16_t* OP = (bf16_t*)(ws + WS_OP);
    const float* sinks = C.in[12]; const float* rel_bias = C.in[22];
    const int gw = C.vcu * NWAVES + C.wave, NGW = C.G * NWAVES;
    for (int it = gw; it < M * 12; it += NGW) {
        const int q = it / 12, hq = it % 12, g = hq / 6, b = q / SEQ, t = q % SEQ;
        float qv[64];
        { const u32x4* qp = (const u32x4*)(BQ + (size_t)q * 768 + hq * 64);
#pragma unroll
            for (int c8 = 0; c8 < 8; ++c8) { const u32x4 w = qp[c8];
                qv[c8 * 8 + 0] = bf2f(w.x & 0xffff); qv[c8 * 8 + 1] = bf2f(w.x >> 16); qv[c8 * 8 + 2] = bf2f(w.y & 0xffff); qv[c8 * 8 + 3] = bf2f(w.y >> 16);
                qv[c8 * 8 + 4] = bf2f(w.z & 0xffff); qv[c8 * 8 + 5] = bf2f(w.z >> 16); qv[c8 * 8 + 6] = bf2f(w.w & 0xffff); qv[c8 * 8 + 7] = bf2f(w.w >> 16); } }
        float lg[2];
#pragma unroll
        for (int i = 0; i < 2; ++i) { const int kk = lane + 64 * i, s = t - kk; float v = -INFINITY;
            if (s >= 0) { const u32x4* kp = (const u32x4*)(BK + (size_t)(b * SEQ + s) * 128 + g * 64); float d = 0.f;
#pragma unroll
                for (int c8 = 0; c8 < 8; ++c8) { const u32x4 w = kp[c8];
                    d += qv[c8 * 8 + 0] * bf2f(w.x & 0xffff) + qv[c8 * 8 + 1] * bf2f(w.x >> 16) + qv[c8 * 8 + 2] * bf2f(w.y & 0xffff) + qv[c8 * 8 + 3] * bf2f(w.y >> 16)
                       + qv[c8 * 8 + 4] * bf2f(w.z & 0xffff) + qv[c8 * 8 + 5] * bf2f(w.z >> 16) + qv[c8 * 8 + 6] * bf2f(w.w & 0xffff) + qv[c8 * 8 + 7] * bf2f(w.w >> 16); }
                v = d + rel_bias[T5_BUCKET[kk] * 18 + 6 + hq]; }
            lg[i] = v; }
        const float sk = sinks[hq];
        const float mx = fmaxf(wave_max(fmaxf(lg[0], lg[1])), sk);
        const float p0 = __expf(lg[0] - mx), p1 = __expf(lg[1] - mx);
        const float den = wave_sum(p0 + p1) + __expf(sk - mx);
        float o = 0.f;
        for (int kk = 0; kk < 128; ++kk) { const float p = kk < 64 ? __shfl(p0, kk) : __shfl(p1, kk - 64); const int s = t - kk;
            if (s >= 0) o += p * bf2f(BV[(size_t)(b * SEQ + s) * 128 + g * 64 + lane]); }
        const size_t oc = (size_t)q * 2048 + 768 + hq * 64 + lane;
        OP[oc] = (bf16_t)f2bf(o / den * bf2f(GATE[oc]));
    }
}
__device__ __forceinline__ void naive_mem(Ctx& C) {
    unsigned char* ws = C.ws; const int lane = C.lane;
    const bf16_t* CQ = (const bf16_t*)(ws + WS_CQ); const bf16_t* KC = (const bf16_t*)(ws + WS_KC); const bf16_t* VC = (const bf16_t*)(ws + WS_VC);
    const bf16_t* GATE = (const bf16_t*)((unsigned char*)C.out + DO_GATE); bf16_t* OP = (bf16_t*)(ws + WS_OP);
    const int gw = C.vcu * NWAVES + C.wave, NGW = C.G * NWAVES;
    for (int it = gw; it < M * 4; it += NGW) {
        const int q = it / 4, h = it % 4, b = q / SEQ;
        float lg[4] = {0.f, 0.f, 0.f, 0.f};
        for (int c8 = 0; c8 < 16; ++c8) { const u32x4 w = *((const u32x4*)(CQ + (size_t)q * 512 + h * 128) + c8);
            const float q0 = bf2f(w.x & 0xffff), q1 = bf2f(w.x >> 16), q2 = bf2f(w.y & 0xffff), q3 = bf2f(w.y >> 16), q4 = bf2f(w.z & 0xffff), q5 = bf2f(w.z >> 16), q6 = bf2f(w.w & 0xffff), q7 = bf2f(w.w >> 16);
#pragma unroll
            for (int i = 0; i < 4; ++i) { const u32x4 kw = *((const u32x4*)(KC + (size_t)(b * MEMLEN + lane + 64 * i) * 512 + h * 128) + c8);
                lg[i] += q0 * bf2f(kw.x & 0xffff) + q1 * bf2f(kw.x >> 16) + q2 * bf2f(kw.y & 0xffff) + q3 * bf2f(kw.y >> 16) + q4 * bf2f(kw.z & 0xffff) + q5 * bf2f(kw.z >> 16) + q6 * bf2f(kw.w & 0xffff) + q7 * bf2f(kw.w >> 16); } }
        const float mx = wave_max(fmaxf(fmaxf(lg[0], lg[1]), fmaxf(lg[2], lg[3])));
        float p[4]; float ps = 0.f;
#pragma unroll
        for (int i = 0; i < 4; ++i) { p[i] = __expf(lg[i] - mx); ps += p[i]; }
        const float den = wave_sum(ps);
        float o0 = 0.f, o1 = 0.f;
#pragma unroll
        for (int i = 0; i < 4; ++i)
            for (int kk = 0; kk < 64; ++kk) { const float pv = __shfl(p[i], kk); const unsigned vw = *(const unsigned*)(VC + (size_t)(b * MEMLEN + kk + 64 * i) * 512 + h * 128 + 2 * lane);
                o0 += pv * bf2f(vw & 0xffff); o1 += pv * bf2f(vw >> 16); }
        const size_t oc = (size_t)q * 2048 + 1536 + h * 128 + 2 * lane;
        const unsigned gw2 = *(const unsigned*)(GATE + oc);
        *(unsigned*)(OP + oc) = pk2(o0 / den * bf2f(gw2 & 0xffff), o1 / den * bf2f(gw2 >> 16));
    }
}
__device__ __forceinline__ void naive_dsa(Ctx& C) {
    unsigned char* ws = C.ws; const int lane = C.lane, wave = C.wave;
    const bf16_t* QABS = (const bf16_t*)(ws + WS_QABS); const bf16_t* CKV = (const bf16_t*)(ws + WS_CKV); const float* KSS = (const float*)(ws + WS_KSS);
    const int* IDX = (const int*)(ws + WS_IDX); bf16_t* PC = (bf16_t*)(ws + WS_PC); const float* rel_bias = C.in[22];
    LAS float* qf = (LAS float*)(C.lds + wave * 16384);
    LAS float* pl = (LAS float*)(C.lds + wave * 16384 + 6144);
    LAS int* il = (LAS int*)(C.lds + wave * 16384 + 12288);
    const int gw = C.vcu * NWAVES + C.wave, NGW = C.G * NWAVES;
    for (int q = gw; q < M; q += NGW) {
        const int b = q / SEQ, t = q % SEQ;
        for (int i = lane; i < 1536; i += 64) qf[i] = bf2f(QABS[(size_t)q * 1536 + i]);
        float lg[4][6];
#pragma unroll
        for (int i = 0; i < 4; ++i) { const int k = lane + 64 * i; const int j = IDX[(size_t)q * TOPK + k]; il[k] = j;
            if (j >= 0 && j <= t) { const size_t kr = (size_t)(b * SEQ + j); float a[6] = {0.f, 0.f, 0.f, 0.f, 0.f, 0.f};
                for (int c8 = 0; c8 < 32; ++c8) { const u32x4 w = *((const u32x4*)(CKV + kr * 256) + c8);
                    const float c0 = bf2f(w.x & 0xffff), c1 = bf2f(w.x >> 16), c2 = bf2f(w.y & 0xffff), c3 = bf2f(w.y >> 16), c4 = bf2f(w.z & 0xffff), c5 = bf2f(w.z >> 16), c6 = bf2f(w.w & 0xffff), c7 = bf2f(w.w >> 16);
#pragma unroll
                    for (int h = 0; h < 6; ++h) { const LAS float* qp = qf + h * 256 + c8 * 8;
                        a[h] += c0 * qp[0] + c1 * qp[1] + c2 * qp[2] + c3 * qp[3] + c4 * qp[4] + c5 * qp[5] + c6 * qp[6] + c7 * qp[7]; } }
                const int dist = t - j; const int bk = dist < 128 ? T5_BUCKET[dist] : 31;
#pragma unroll
                for (int h = 0; h < 6; ++h) lg[i][h] = a[h] * (1.0f / sqrtf(KSS[kr * 8 + h] * (1.f / 128.f) + EPS)) + rel_bias[bk * 18 + h];
            } else {
#pragma unroll
                for (int h = 0; h < 6; ++h) lg[i][h] = -INFINITY; } }
        float linv[6];
#pragma unroll
        for (int h = 0; h < 6; ++h) { const float mx = wave_max(fmaxf(fmaxf(lg[0][h], lg[1][h]), fmaxf(lg[2][h], lg[3][h]))); float ps = 0.f;
#pragma unroll
            for (int i = 0; i < 4; ++i) { const float p = __expf(lg[i][h] - mx); pl[h * 256 + lane + 64 * i] = p; ps += p; }
            linv[h] = 1.0f / wave_sum(ps); }
        float o[6][4];
#pragma unroll
        for (int h = 0; h < 6; ++h) { o[h][0] = 0.f; o[h][1] = 0.f; o[h][2] = 0.f; o[h][3] = 0.f; }
        for (int k = 0; k < TOPK; ++k) { const int j = il[k]; if (j < 0 || j > t) continue;
            const u32x2 w = *(const u32x2*)(CKV + (size_t)(b * SEQ + j) * 256 + 4 * lane);
            const float c0 = bf2f(w.x & 0xffff), c1 = bf2f(w.x >> 16), c2 = bf2f(w.y & 0xffff), c3 = bf2f(w.y >> 16);
#pragma unroll
            for (int h = 0; h < 6; ++h) { const float p = pl[h * 256 + k]; o[h][0] += p * c0; o[h][1] += p * c1; o[h][2] += p * c2; o[h][3] += p * c3; } }
#pragma unroll
        for (int h = 0; h < 6; ++h) { u32x2 w; w.x = pk2(o[h][0] * linv[h], o[h][1] * linv[h]); w.y = pk2(o[h][2] * linv[h], o[h][3] * linv[h]);
            *(u32x2*)(PC + (size_t)q * 1536 + h * 256 + 4 * lane) = w; }
    }
}

__global__ void __launch_bounds__(NTHREADS, 2) mk_fwd(Args args) {
    extern __shared__ __attribute__((aligned(16))) unsigned char lds_raw[];
    Ctx C;
    C.in = args.in;
    C.out = args.out; C.ws = args.ws;
    C.lds = (LAS unsigned char*)lds_raw;
    C.tid = threadIdx.x; C.lane = C.tid & 63; C.wave = __builtin_amdgcn_readfirstlane(C.tid >> 6);
    C.G = gridDim.x; { const int bx = blockIdx.x; C.vcu = (C.G % 8 == 0) ? (bx % 8) * (C.G / 8) + bx / 8 : bx; }
    cg::grid_group grid = cg::this_grid();
    const int lo = args.ph_lo, hi = args.ph_hi;
    unsigned char* ws = C.ws;
#ifndef PHMASK
#define PHMASK 0x1ff
#endif
#define IN(k) (((PHMASK >> (k)) & 1) && lo <= (k) && (k) < hi)
#define SEAM(k) do { if (IN(k) && IN((k) + 1)) grid.sync(); } while (0)
    const int bx = (int)blockIdx.x;

    if (IN(0)) { p0_prologue(C); }
    SEAM(0);
    if (IN(1)) {
        { pg8::Gemm g{(const bf16_t*)(ws + WS_H), (const bf16_t*)(ws + WS_WINT), M, NWIN_A, 2048, 2048, 2048}; pg8::StaticOrder S; S.init(M, NWIN_A, C.G, bx);
          EpiInA E{(float*)(ws + WS_BIG), (bf16_t*)((unsigned char*)C.out + DO_IQ), (bf16_t*)((unsigned char*)C.out + DO_GATE)};
          pg8::gemm_phase<EpiInA, pg8::StaticOrder>(C.lds, g, S, E); }
        { pg8::Gemm g{(const bf16_t*)(ws + WS_MEMN), (const bf16_t*)(ws + WS_WMEMT), BATCH * MEMLEN, 1024, 2048, 2048, 2048}; pg8::StaticOrder S; S.init(BATCH * MEMLEN, 1024, C.G, (bx + 64) % C.G);
          EpiF32 E{(float*)(ws + WS_RAWM), 1024};
          pg8::gemm_phase<EpiF32, pg8::StaticOrder>(C.lds, g, S, E); }
    }
    SEAM(1);
    if (IN(2)) { p2_post(C); }
    SEAM(2);
#ifndef SUB3
#define SUB3 31
#endif
    if (IN(3)) {
        if (SUB3 & 8) { pg8::Gemm g{(const bf16_t*)(ws + WS_H), (const bf16_t*)(ws + WS_WINT) + (size_t)NWIN_A * 2048, M, NWIN_B, 2048, 2048, 2048}; pg8::StaticOrder S; S.init(M, NWIN_B, C.G, bx);
          EpiMix E{(bf16_t*)(ws + WS_BIG), C.in[20]};
          pg8::gemm_phase<EpiMix, pg8::StaticOrder>(C.lds, g, S, E); }
        if (SUB3 & 16) { pg8::Gemm g{(const bf16_t*)(ws + WS_CKV), (const bf16_t*)(ws + WS_WKT), M, 768, 256, 256, 256}; pg8::StaticOrder S; S.init(M, 768, C.G, bx);
          EpiKss E{(float*)(ws + WS_KSS)};
          pg8::gemm_phase<EpiKss, pg8::StaticOrder>(C.lds, g, S, E); }
        if (SUB3 & 1) naive_indexer(C);
        __syncthreads();
        if (SUB3 & 2) naive_swa(C);
        if (SUB3 & 4) naive_mem(C);
    }
    SEAM(3);
    if (IN(4)) {
        pg8::Gemm g{(const bf16_t*)(ws + WS_QA), (const bf16_t*)(ws + WS_WQBD), M, 1536, 768, 768, 768}; pg8::StaticOrder S; S.init(M, 1536, C.G, bx);
        EpiBf E{(bf16_t*)(ws + WS_QABS), 1536};
        pg8::gemm_phase<EpiBf, pg8::StaticOrder>(C.lds, g, S, E);
    }
    SEAM(4);
    if (IN(5)) { naive_dsa(C); }
    SEAM(5);
    if (IN(6)) {
        pg8::Gemm g{(const bf16_t*)(ws + WS_PC), (const bf16_t*)(ws + WS_WVBD), M, 768, 1536, 1536, 1536}; pg8::StaticOrder S; S.init(M, 768, C.G, bx);
        EpiGateMul E{(bf16_t*)(ws + WS_OP), (const bf16_t*)((unsigned char*)C.out + DO_GATE)};
        pg8::gemm_phase<EpiGateMul, pg8::StaticOrder>(C.lds, g, S, E);
    }
    SEAM(6);
    if (IN(7)) {
        for (int br = 0; br < 3; ++br) {
            const int koff = br * 768, kb = br < 2 ? 768 : 512;
            pg8::Gemm g{(const bf16_t*)(ws + WS_OP) + koff, (const bf16_t*)(ws + WS_WUPT) + koff, M, 2048, kb, 2048, 2048}; pg8::StaticOrder S; S.init(M, 2048, C.G, bx);
            EpiMerge E{C.out, (bf16_t*)(ws + WS_MERGED), (const bf16_t*)(ws + WS_BIG), br};
            pg8::gemm_phase<EpiMerge, pg8::StaticOrder>(C.lds, g, S, E);
        }
    }
    if (IN(7) && IN(8)) grid.sync();
    if (IN(8)) {
        pg8::Gemm g{(const bf16_t*)(ws + WS_MERGED), (const bf16_t*)(ws + WS_WOT), M, 2048, 2048, 2048, 2048}; pg8::StaticOrder S; S.init(M, 2048, C.G, bx);
        EpiOut E{C.out, C.in[0]};
        pg8::gemm_phase<EpiOut, pg8::StaticOrder>(C.lds, g, S, E);
    }
#undef IN
#undef SEAM
}

extern "C" void kernel_launch(void* const* d_in, const int* in_sizes, int n_in, void* d_out, int out_size, void* d_ws, size_t ws_size, hipStream_t stream) {
    static int grid = 0;
    if (grid == 0) {
        if (n_in != 23 || out_size != M * DM || ws_size < WS_END) { fprintf(stderr, "kernel_launch: unexpected shapes (n_in %d out %d ws %zu)\n", n_in, out_size, ws_size); grid = -1; return; }
        int dev = 0, cus = 0, per_cu = 0;
        hipGetDevice(&dev); hipDeviceGetAttribute(&cus, hipDeviceAttributeMultiprocessorCount, dev);
        hipFuncSetAttribute((const void*)mk_fwd, hipFuncAttributeMaxDynamicSharedMemorySize, LDS_BYTES);
        hipOccupancyMaxActiveBlocksPerMultiprocessor(&per_cu, (const void*)mk_fwd, NTHREADS, LDS_BYTES);
        if (per_cu < 1) { fprintf(stderr, "kernel_launch: occupancy query says %d blocks/CU\n", per_cu); per_cu = 1; }
        (void)hipGetLastError();
        grid = cus;
    }
    if (grid < 0) return;
    Args a{};
    for (int i = 0; i < 23; ++i) a.in[i] = (const float*)d_in[i];
    a.out = (float*)d_out; a.ws = (unsigned char*)d_ws;
#if MK_SINGLE
    a.ph_lo = 0; a.ph_hi = 9; a.single = 1;
    void* kargs[] = {&a};
    hipError_t e = hipLaunchCooperativeKernel((const void*)mk_fwd, dim3(grid), dim3(NTHREADS), kargs, LDS_BYTES, stream);
    if (e != hipSuccess) fprintf(stderr, "cooperative launch failed: %s (grid %d)\n", hipGetErrorString(e), grid);
#else
    for (int p = 0; p < 9; ++p) { a.ph_lo = p; a.ph_hi = p + 1; a.single = 0;
        hipLaunchKernelGGL(mk_fwd, dim3(grid), dim3(NTHREADS), LDS_BYTES, stream, a); }
#endif
}
```

```cpp
#include <hip/hip_runtime.h>
#include <hip/hip_cooperative_groups.h>
#include <cstdio>
#include <cstdint>
namespace cg = cooperative_groups;

#ifndef MK_SINGLE
#define MK_SINGLE 1
#endif

namespace pg8 {
#define PG8_LAS __attribute__((address_space(3)))
typedef unsigned short bf16_t;
typedef short bf16x8 __attribute__((ext_vector_type(8)));
typedef float f32x4 __attribute__((ext_vector_type(4)));
typedef unsigned u32x4 __attribute__((ext_vector_type(4)));
typedef unsigned u32x2 __attribute__((ext_vector_type(2)));
constexpr int BM = 256, BK = 64, HALF = 128, HTB = HALF * BK * 2, STAGE_BYTES = 8 * HTB, NXCD = 8, WGM = 2;

__host__ __device__ __forceinline__ int lds_byte(int r, int c) { const int st = (r >> 4) * 2 + (c >> 5), rr = r & 15, cc = c & 31, ob = rr * 64 + cc * 2; return st * 1024 + (ob ^ (((ob >> 9) & 1) << 5)); }
__host__ __device__ __forceinline__ void stage_rc(int b, int& R, int& C) { const int st = b / 1024, sb = b % 1024, swz = sb ^ (((sb >> 9) & 1) << 5); R = (st >> 1) * 16 + swz / 64; C = (st & 1) * 32 + (swz % 64) / 2; }
__host__ __device__ __forceinline__ int perm32(int rho) { const int n = rho >> 4, i = rho & 15; return 8 * (i >> 2) + 4 * n + (i & 3); }

struct Unit { int pm, pn; };
struct Gemm { const bf16_t* A; const bf16_t* Bt; int M, N, K, lda, ldb, akoff; int sca = 0x7f7f7f7f, scb = 0x79797979; };

struct StaticOrder {
    int nM, nN, nwg, G, c;
    __host__ __device__ void init(int M, int N, int G_, int c_) { nM = M / BM; nN = N / BM; nwg = nM * nN; G = G_; c = c_; }
    __host__ __device__ bool next(int i, Unit& u) const {
        const long L = (long)i * G + c; if (L >= nwg) return false;
        int wgid = (int)L; { const int q = nwg / NXCD, r = nwg % NXCD, xcd = wgid % NXCD, off = wgid / NXCD; wgid = (xcd < r ? xcd * (q + 1) : r * (q + 1) + (xcd - r) * q) + off; }
        const int nig = WGM * nN, gid = wgid / nig, fm = gid * WGM, gsz = (nM - fm) < WGM ? (nM - fm) : WGM;
        u.pm = fm + ((wgid % nig) % gsz); u.pn = (wgid % nig) / gsz; return true;
    }
    __device__ __forceinline__ void a_ready(const Unit&) const {}
    __device__ __forceinline__ void done(const Unit&) const {}
};

typedef int i32x8 __attribute__((ext_vector_type(8)));
typedef int i32x4v __attribute__((ext_vector_type(4)));
__device__ __forceinline__ unsigned cvt_pk_bf16(float lo, float hi) { unsigned r; asm volatile("v_cvt_pk_bf16_f32 %0, %1, %2" : "=v"(r) : "v"(lo), "v"(hi)); return r; }

template <class Epi, class Sched, bool ALIGN_EPI = true, bool SP2 = true, bool F8 = false>
__device__ __forceinline__ void gemm_phase(PG8_LAS unsigned char* lds, const Gemm g, const Sched& S, const Epi& E) {
    const int tid = threadIdx.x, wid = __builtin_amdgcn_readfirstlane(tid >> 6), lane = tid & 63, wr = wid >> 2, wc = wid & 3, fr = lane & 15, fq = lane >> 4;
    constexpr int ES = F8 ? 1 : 2;
    const int nt = g.K / (F8 ? 2 * BK : BK);
    unsigned voffA[2], voffB[2];
#pragma unroll
    for (int i = 0; i < 2; ++i) { int R, C; stage_rc(tid * 16 + i * 8192, R, C); const int Rb = Epi::PERM ? ((R & ~31) + perm32(R & 31)) : R;
        voffA[i] = (unsigned)(R * g.lda * ES + C * 2); voffB[i] = (unsigned)(Rb * g.ldb * ES + C * 2); }
    const size_t kstep = (size_t)(BK * 2);
    const size_t hstepA = (size_t)HALF * g.lda * ES, hstepB = (size_t)HALF * g.ldb * ES;
    const size_t tstepA = 2 * hstepA, tstepB = 2 * hstepB;
    const unsigned ldsw = (unsigned)wid * 1024u;
    const int aoff = F8 ? lds_byte(wr * 64 + fr, (fq >> 1) * 32 + (fq & 1) * 16) : lds_byte(wr * 64 + fr, fq * 8), boff = F8 ? lds_byte(wc * 32 + fr, (fq >> 1) * 32 + (fq & 1) * 16) : lds_byte(wc * 32 + fr, fq * 8);
#define PG8_SA(b, h) (((b) * 2 + (h)) * HTB)
#define PG8_SB(b, h) ((4 + (b) * 2 + (h)) * HTB)
#define PG8_STAGE(bufoff, gbase, voff) do { _Pragma("unroll") for (int _i = 0; _i < 2; ++_i) \
        __builtin_amdgcn_global_load_lds((const unsigned*)((const char*)(gbase) + (voff)[_i]), (PG8_LAS unsigned*)(lds + (bufoff) + ldsw + _i * 8192), 16, 0, 0); } while (0)
#define PG8_LD8(p) __builtin_shufflevector(*(const PG8_LAS i32x4v*)(p), *(const PG8_LAS i32x4v*)((p) + 16), 0, 1, 2, 3, 4, 5, 6, 7)
#define PG8_LDA(dst, b, h) do { _Pragma("unroll") for (int m = 0; m < 4; ++m) { if constexpr (F8) dst##8[m] = PG8_LD8(lds + PG8_SA(b, h) + aoff + m * 2048); else { _Pragma("unroll") for (int k = 0; k < 2; ++k) dst[m][k] = *(const PG8_LAS bf16x8*)(lds + PG8_SA(b, h) + aoff + m * 2048 + k * 1024); } } } while (0)
#define PG8_LDB(dst, b, h) do { _Pragma("unroll") for (int n = 0; n < 2; ++n) { if constexpr (F8) dst##8[n] = PG8_LD8(lds + PG8_SB(b, h) + boff + n * 2048); else { _Pragma("unroll") for (int k = 0; k < 2; ++k) dst[n][k] = *(const PG8_LAS bf16x8*)(lds + PG8_SB(b, h) + boff + n * 2048 + k * 1024); } } } while (0)
#define PG8_MMA(ai, bj, At, Bt) do { __builtin_amdgcn_s_setprio(1); _Pragma("unroll") for (int m = 0; m < 4; ++m) _Pragma("unroll") for (int n = 0; n < 2; ++n) { \
        if constexpr (F8) { asm volatile("s_nop 1\n\tv_mfma_scale_f32_16x16x128_f8f6f4 %0, %1, %2, %0, %3, %4 op_sel_hi:[0,0,0]" : "+v"(acc[ai][bj][m][n]) : "v"(Bt##8[n]), "v"(At##8[m]), "v"(sc_b), "v"(sc_a)); } \
        else { _Pragma("unroll") for (int k = 0; k < 2; ++k) acc[ai][bj][m][n] = __builtin_amdgcn_mfma_f32_16x16x32_bf16(Bt[n][k], At[m][k], acc[ai][bj][m][n], 0, 0, 0); } } \
        if constexpr (F8) asm volatile("s_nop 7" ::: "memory"); __builtin_amdgcn_s_setprio(0); } while (0)
#define PG8_WAIT_V(n) asm volatile("s_waitcnt vmcnt(" #n ")" ::: "memory")
#define PG8_WAIT_L(n) asm volatile("s_waitcnt lgkmcnt(" #n ")" ::: "memory")
#define PG8_BAR __builtin_amdgcn_s_barrier()
#define PG8_SCHED __builtin_amdgcn_sched_barrier(0)
    Unit cur, nxt; int ui = 0;
    if (!S.next(0, cur)) return;
    f32x4 acc[2][2][4][2];
#pragma unroll
    for (int a = 0; a < 2; ++a)
#pragma unroll
        for (int b = 0; b < 2; ++b)
#pragma unroll
            for (int m = 0; m < 4; ++m)
#pragma unroll
                for (int n = 0; n < 2; ++n) acc[a][b][m][n] = (f32x4){0.f, 0.f, 0.f, 0.f};
    if constexpr (F8) { _Pragma("unroll") for (int a = 0; a < 2; ++a) _Pragma("unroll") for (int b = 0; b < 2; ++b)
        asm volatile("s_nop 7" : "+v"(acc[a][b][0][0]), "+v"(acc[a][b][0][1]), "+v"(acc[a][b][1][0]), "+v"(acc[a][b][1][1]), "+v"(acc[a][b][2][0]), "+v"(acc[a][b][2][1]), "+v"(acc[a][b][3][0]), "+v"(acc[a][b][3][1])); }
    bf16x8 At[4][2], B0[2][2], B1[2][2]; i32x8 At8[4], B08[2], B18[2];
    int sc_a = g.sca, sc_b = g.scb;
    asm volatile("" : "+v"(sc_a), "+v"(sc_b));
    const char* cA = (const char*)g.A + (size_t)cur.pm * tstepA + (size_t)cur.pn * g.akoff * ES; const char* cB = (const char*)g.Bt + (size_t)cur.pn * tstepB;
    S.a_ready(cur);
    if constexpr (SP2) {
        PG8_STAGE(PG8_SB(0, 0), cB, voffB); PG8_STAGE(PG8_SB(0, 1), cB + hstepB, voffB); PG8_STAGE(PG8_SA(0, 0), cA, voffA); PG8_STAGE(PG8_SA(0, 1), cA + hstepA, voffA);
        if (wr == 1) PG8_BAR;
        PG8_WAIT_V(2); PG8_BAR;
        PG8_STAGE(PG8_SB(1, 0), cB + kstep, voffB); PG8_STAGE(PG8_SA(1, 0), cA + kstep, voffA); PG8_STAGE(PG8_SB(1, 1), cB + hstepB + kstep, voffB);
        PG8_WAIT_V(6); PG8_BAR;
    } else {
        PG8_STAGE(PG8_SB(0, 0), cB, voffB); PG8_STAGE(PG8_SA(0, 0), cA, voffA); PG8_STAGE(PG8_SB(0, 1), cB + hstepB, voffB); PG8_STAGE(PG8_SA(0, 1), cA + hstepA, voffA);
        if (wr == 1) PG8_BAR;
        PG8_WAIT_V(4); PG8_BAR;
        PG8_STAGE(PG8_SB(1, 0), cB + kstep, voffB); PG8_STAGE(PG8_SA(1, 0), cA + kstep, voffA); PG8_STAGE(PG8_SB(1, 1), cB + hstepB + kstep, voffB);
        PG8_WAIT_V(6); PG8_BAR;
    }
    for (;;) {
        const bool has_next = S.next(ui + 1, nxt);
        const char* nA = has_next ? (const char*)g.A + (size_t)nxt.pm * tstepA + (size_t)nxt.pn * g.akoff * ES : cA; const char* nB = has_next ? (const char*)g.Bt + (size_t)nxt.pn * tstepB : cB;
#pragma unroll 1
        for (int t = 0; t < nt; t += 2) {
            const bool last = (t == nt - 2);
            const char* a1 = cA + (size_t)(t + 1) * kstep;
            const char* a2 = last ? nA : cA + (size_t)(t + 2) * kstep; const char* b2 = last ? nB : cB + (size_t)(t + 2) * kstep;
            const char* a3 = a2 + kstep; const char* b3 = b2 + kstep;
            if (last && has_next) S.a_ready(nxt);
            if constexpr (Epi::HAS_MID) { if (t == E.mid_t0 || t == E.mid_t1) E.mid(acc, cur, t, wr, wc, fr, fq); }
            if constexpr (SP2) {
            PG8_LDB(B0, 0, 0); PG8_LDB(B1, 0, 1); PG8_SCHED; PG8_LDA(At, 0, 0); PG8_STAGE(PG8_SA(1, 1), a1 + hstepA, voffA);
            PG8_WAIT_V(8); PG8_WAIT_L(0); PG8_BAR; PG8_MMA(0, 0, At, B0); PG8_MMA(0, 1, At, B1); PG8_BAR; PG8_SCHED;
            PG8_LDA(At, 0, 1); PG8_STAGE(PG8_SB(0, 0), b2, voffB); PG8_STAGE(PG8_SB(0, 1), b2 + hstepB, voffB); PG8_STAGE(PG8_SA(0, 0), a2, voffA);
            PG8_WAIT_V(8); PG8_WAIT_L(0); PG8_BAR; PG8_MMA(1, 0, At, B0); PG8_MMA(1, 1, At, B1); PG8_BAR; PG8_SCHED;
            PG8_LDB(B0, 1, 0); PG8_LDB(B1, 1, 1); PG8_SCHED; PG8_LDA(At, 1, 0); PG8_STAGE(PG8_SA(0, 1), a2 + hstepA, voffA);
            PG8_WAIT_V(8); PG8_WAIT_L(0); PG8_BAR; PG8_MMA(0, 0, At, B0); PG8_MMA(0, 1, At, B1); PG8_BAR; PG8_SCHED;
            PG8_LDA(At, 1, 1); PG8_STAGE(PG8_SB(1, 0), b3, voffB); PG8_STAGE(PG8_SB(1, 1), b3 + hstepB, voffB); PG8_STAGE(PG8_SA(1, 0), a3, voffA);
            PG8_WAIT_V(8); PG8_WAIT_L(0); PG8_BAR; PG8_MMA(1, 0, At, B0); PG8_MMA(1, 1, At, B1); PG8_BAR; PG8_SCHED;
            } else {
            PG8_LDB(B0, 0, 0); PG8_SCHED; PG8_LDA(At, 0, 0); PG8_STAGE(PG8_SA(1, 1), a1 + hstepA, voffA);
            PG8_WAIT_L(8); PG8_BAR; PG8_WAIT_L(0); PG8_MMA(0, 0, At, B0); PG8_BAR; PG8_SCHED;
            PG8_LDB(B1, 0, 1); PG8_STAGE(PG8_SB(0, 0), b2, voffB);
            PG8_BAR; PG8_WAIT_L(0); PG8_MMA(0, 1, At, B1); PG8_BAR;
            PG8_LDA(At, 0, 1); PG8_STAGE(PG8_SA(0, 0), a2, voffA);
            PG8_BAR; PG8_WAIT_L(0); PG8_MMA(1, 0, At, B0); PG8_BAR; PG8_SCHED;
            PG8_STAGE(PG8_SB(0, 1), b2 + hstepB, voffB);
            PG8_WAIT_V(6); PG8_BAR; PG8_MMA(1, 1, At, B1); PG8_BAR;
            PG8_LDB(B0, 1, 0); PG8_SCHED; PG8_LDA(At, 1, 0); PG8_STAGE(PG8_SA(0, 1), a2 + hstepA, voffA);
            PG8_WAIT_L(8); PG8_BAR; PG8_WAIT_L(0); PG8_MMA(0, 0, At, B0); PG8_BAR; PG8_SCHED;
            PG8_LDB(B1, 1, 1); PG8_STAGE(PG8_SB(1, 0), b3, voffB);
            PG8_BAR; PG8_WAIT_L(0); PG8_MMA(0, 1, At, B1); PG8_BAR;
            PG8_LDA(At, 1, 1); PG8_STAGE(PG8_SA(1, 0), a3, voffA);
            PG8_BAR; PG8_WAIT_L(0); PG8_MMA(1, 0, At, B0); PG8_BAR; PG8_SCHED;
            PG8_STAGE(PG8_SB(1, 1), b3 + hstepB, voffB);
            PG8_WAIT_V(6); PG8_BAR; PG8_MMA(1, 1, At, B1); PG8_BAR;
            }
        }
        if constexpr (ALIGN_EPI) { if (wr == 0) PG8_BAR; }
        if constexpr (F8) { _Pragma("unroll") for (int a = 0; a < 2; ++a) _Pragma("unroll") for (int b = 0; b < 2; ++b)
            asm volatile("s_nop 15\n\ts_nop 15" : "+v"(acc[a][b][0][0]), "+v"(acc[a][b][0][1]), "+v"(acc[a][b][1][0]), "+v"(acc[a][b][1][1]), "+v"(acc[a][b][2][0]), "+v"(acc[a][b][2][1]), "+v"(acc[a][b][3][0]), "+v"(acc[a][b][3][1])); }
        E(acc, cur, wr, wc, fr, fq);
        if (!has_next) break;
#pragma unroll
        for (int a = 0; a < 2; ++a)
#pragma unroll
            for (int b = 0; b < 2; ++b)
#pragma unroll
                for (int m = 0; m < 4; ++m)
#pragma unroll
                    for (int n = 0; n < 2; ++n) acc[a][b][m][n] = (f32x4){0.f, 0.f, 0.f, 0.f};
        if constexpr (F8) { _Pragma("unroll") for (int a = 0; a < 2; ++a) _Pragma("unroll") for (int b = 0; b < 2; ++b)
        asm volatile("s_nop 7" : "+v"(acc[a][b][0][0]), "+v"(acc[a][b][0][1]), "+v"(acc[a][b][1][0]), "+v"(acc[a][b][1][1]), "+v"(acc[a][b][2][0]), "+v"(acc[a][b][2][1]), "+v"(acc[a][b][3][0]), "+v"(acc[a][b][3][1])); }
        cur = nxt; cA = nA; cB = nB; ++ui;
        if constexpr (ALIGN_EPI) { if (wr == 1) PG8_BAR; }
    }
    PG8_WAIT_V(0);
    if constexpr (!ALIGN_EPI) { if (wr == 0) PG8_BAR; }
    PG8_BAR;
#undef PG8_SA
#undef PG8_SB
#undef PG8_STAGE
#undef PG8_LDA
#undef PG8_LDB
#undef PG8_MMA
#undef PG8_WAIT_V
#undef PG8_WAIT_L
#undef PG8_BAR
#undef PG8_SCHED
}
}

using pg8::bf16_t; using pg8::f32x4; using pg8::u32x4; using pg8::u32x2;
#define LAS __attribute__((address_space(3)))
constexpr int BATCH = 2, SEQ = 8192, DM = 2048, M = BATCH * SEQ, MEMLEN = 256;
constexpr int IN_COLS = 11856, NWIN = 12032, NWIN_A = 1792, NWIN_B = 10240;
constexpr int RAWW = 2816;
constexpr int TOPK = 256;
constexpr float EPS = 1e-6f;
constexpr int NWAVES = 8, NTHREADS = 512;
constexpr int LDS_BYTES = 163840;
constexpr int NPH = 8;

constexpr size_t MiB = 1u << 20;
constexpr size_t WS_CTL = 0;
constexpr size_t WS_WMEMT = 1 * MiB, WS_WKT = 5 * MiB, WS_WQBD = 6 * MiB, WS_WVBD = 9 * MiB, WS_WUPT = 12 * MiB, WS_WOT = 20 * MiB;
constexpr size_t WS_WINT = 28 * MiB;
constexpr size_t WS_QABS = WS_WINT;
constexpr size_t WS_WMIX8 = WS_WINT + 16 * MiB;
constexpr size_t WS_H = 76 * MiB;
constexpr size_t WS_OP = WS_H;
constexpr size_t WS_BIG = 140 * MiB;
constexpr size_t WS_QA = 332 * MiB, WS_CKV = 356 * MiB, WS_IK = 364 * MiB, WS_IW = 366 * MiB, WS_BQ = 367 * MiB, WS_BK = 391 * MiB, WS_BV = 395 * MiB, WS_CQ = 399 * MiB;
constexpr size_t WS_KC = 415 * MiB, WS_VC = 416 * MiB, WS_KSS = 417 * MiB;
constexpr size_t WS_MERGED = 332 * MiB;
constexpr size_t WS_H8 = 438 * MiB;
constexpr size_t WS_MEMN = 418 * MiB, WS_RAWM = 420 * MiB, WS_IDX = 422 * MiB, WS_PC = 438 * MiB, WS_END = 486 * MiB;
constexpr size_t DO_GATE = 0, DO_IQ = 64 * MiB;

__device__ const unsigned char T5_BUCKET[128] = {
0,1,2,3,4,5,6,7,8,9,10,11,12,13,14,15,16,16,16,17,17,18,18,18,19,19,19,20,20,20,20,21,21,21,21,22,22,22,22,22,23,23,23,23,23,23,24,24,24,24,24,24,25,25,25,25,25,25,25,26,26,26,26,26,26,26,26,27,27,27,27,27,27,27,27,27,27,28,28,28,28,28,28,28,28,28,28,29,29,29,29,29,29,29,29,29,29,29,29,30,30,30,30,30,30,30,30,30,30,30,30,30,30,31,31,31,31,31,31,31,31,31,31,31,31,31,31,31};

__device__ __forceinline__ float bf2f(unsigned short b) { return __uint_as_float(((unsigned)b) << 16); }
__device__ __forceinline__ unsigned f2bf(float f) { unsigned u = __float_as_uint(f); return (u + 0x7fffu + ((u >> 16) & 1u)) >> 16; }
__device__ __forceinline__ unsigned pk2(float lo, float hi) { return pg8::cvt_pk_bf16(lo, hi); }
__device__ __forceinline__ float wave_sum(float v) {
#pragma unroll
    for (int o = 1; o < 64; o <<= 1) v += __shfl_xor(v, o);
    return v;
}
__device__ __forceinline__ float wave_max(float v) {
#pragma unroll
    for (int o = 1; o < 64; o <<= 1) v = fmaxf(v, __shfl_xor(v, o));
    return v;
}
__device__ __forceinline__ int opaque_v(int v) { asm volatile("" : "+v"(v)); return v; }
__device__ __forceinline__ float sigmoid_f(float v) { return __builtin_amdgcn_rcpf(1.f + __builtin_amdgcn_exp2f(v * -1.4426950408889634f)); }
__device__ __forceinline__ float silu_f(float v) { return v * sigmoid_f(v); }
__device__ __forceinline__ float einv_f(float v) { return fminf(1.f + __builtin_amdgcn_exp2f(v * -1.4426950408889634f), 1e20f); }
__device__ __forceinline__ float rsqrt_f(float v) { return __builtin_amdgcn_rsqf(v); }

struct Args { const float* in[23]; float* out; unsigned char* ws; int ph_lo, ph_hi, single, pad; };
struct Ctx {
    const float* const* in; float* out; unsigned char* ws;
    LAS unsigned char* lds; int tid, lane, wave, vcu, G;
};

#define GAS __attribute__((address_space(1)))
#define XB_TMO      128
#define XB_XCNT(j)  (256  + 64 * (j))
#define XB_XSUB(j)  (1280 + 64 * (j))
#define XB_XGEN(j)  (2304 + 64 * (j))
#define XB_TOP      3328
#define XB_TOPGEN   3392
#define XCD_BAR_WORDS 3456
#define XB_SPIN_CAP (1u << 22)
__device__ __forceinline__ unsigned xb_ld(unsigned* p)              { return __hip_atomic_load(p, __ATOMIC_RELAXED, __HIP_MEMORY_SCOPE_AGENT); }
__device__ __forceinline__ unsigned xb_add(unsigned* p, unsigned v) { return __hip_atomic_fetch_add(p, v, __ATOMIC_RELAXED, __HIP_MEMORY_SCOPE_AGENT); }
__device__ __forceinline__ unsigned xb_xcc_id() { return (unsigned)__builtin_amdgcn_s_getreg((3 << 11) | 20) & 0xFu; }
#define XB_SPIN(cond, bar) do { unsigned _sp = 0; while (cond) { __builtin_amdgcn_s_sleep(1); \
    if ((++_sp & 255u) == 0u) { if (xb_ld(&(bar)[XB_TMO])) break; if (_sp > XB_SPIN_CAP) { atomicAdd(&(bar)[XB_TMO], 1u); break; } } } } while (0)
struct XcdBarrier { unsigned* bar; unsigned x; volatile LAS unsigned* st; };
__device__ __forceinline__ XcdBarrier xcd_barrier_post(unsigned* bar, volatile LAS unsigned* st) {
    XcdBarrier b; b.bar = bar; b.x = xb_xcc_id(); b.st = st;
    if (threadIdx.x == 0) (void)xb_add(&bar[XB_XCNT(b.x)], 1u);
    return b;
}
__device__ __forceinline__ void xcd_barrier_complete(unsigned* bar, unsigned x, unsigned& nloc, unsigned& nx) {
    const unsigned G = gridDim.x * gridDim.y * gridDim.z;
    unsigned sum, cnt, mine, sp = 0u;
    for (;;) {
        sum = 0u; cnt = 0u; mine = 0u;
#pragma unroll
        for (unsigned j = 0; j < 16; ++j) { const unsigned c = xb_ld(&bar[XB_XCNT(j)]); sum += c; cnt += (c > 0u) ? 1u : 0u; mine = (j == x) ? c : mine; }
        if (sum == G) break;
        __builtin_amdgcn_s_sleep(1);
        if ((++sp & 255u) == 0u) { if (xb_ld(&bar[XB_TMO])) break; if (sp > XB_SPIN_CAP) { atomicAdd(&bar[XB_TMO], 1u); break; } }
    }
    nloc = mine > 0u ? mine : 1u; nx = cnt > 0u ? cnt : 1u;
}
__device__ __forceinline__ void xcd_barrier(const XcdBarrier& b) {
    asm volatile("s_waitcnt vmcnt(0)" ::: "memory");
    __syncthreads();
    if (threadIdx.x == 0) {
        unsigned* bar = b.bar;
        __builtin_amdgcn_s_waitcnt(0);
        unsigned nloc = b.st[0], nx = b.st[1];
        if (nloc == 0u) { xcd_barrier_complete(bar, b.x, nloc, nx); b.st[0] = nloc; b.st[1] = nx; }
        const unsigned old = xb_add(&bar[XB_XSUB(b.x)], 1u);
        const unsigned gen = old / nloc;
        if (old + 1u == (gen + 1u) * nloc) {
            __builtin_amdgcn_fence(__ATOMIC_RELEASE, "agent");
            asm volatile("s_waitcnt vmcnt(0)" ::: "memory");
            const unsigned og = xb_add(&bar[XB_TOP], 1u);
            const unsigned tg = og / nx;
            if (og + 1u == (tg + 1u) * nx) xb_add(&bar[XB_TOPGEN], 1u);
            else XB_SPIN(xb_ld(&bar[XB_TOPGEN]) == tg, bar);
            __builtin_amdgcn_fence(__ATOMIC_ACQUIRE, "agent");
            xb_add(&bar[XB_XGEN(b.x)], 1u);
            asm volatile("s_waitcnt vmcnt(0)" ::: "memory");
        } else {
            XB_SPIN(xb_ld(&bar[XB_XGEN(b.x)]) == gen, bar);
            __builtin_amdgcn_fence(__ATOMIC_ACQUIRE, "agent");
            asm volatile("s_waitcnt vmcnt(0)" ::: "memory");
        }
    }
    __syncthreads();
}

__device__ __forceinline__ unsigned pk4_fp8(float a, float b, float c, float d);
#define EPI_ROWS(ai, m) (u.pm * 256 + (ai) * 128 + wr * 64 + (m) * 16 + fr)
#define EPI_COLT(bj, n) ((bj) * 128 + wc * 32 + (n) * 16 + 4 * fq)
#define EPI_COLP(bj) ((bj) * 128 + wc * 32 + 8 * fq)

constexpr int EPX_OFF = 131072, EPY_OFF = 131072 + 8192;
struct EpiIn {
    static constexpr bool PERM = true, HAS_MID = false;
    LAS unsigned char* lds; unsigned char* ws; unsigned char* dout; const float* const* in;
    int memkv, pnoff;
    __device__ __forceinline__ void store4(bf16_t* p, const f32x4 v) const { u32x2 w; w.x = pk2(v[0], v[1]); w.y = pk2(v[2], v[3]); *(u32x2*)p = w; }
    __device__ __forceinline__ void store8(bf16_t* p, const f32x4 a, const f32x4 b) const { u32x4 w; w.x = pk2(a[0], a[1]); w.y = pk2(a[2], a[3]); w.z = pk2(b[0], b[1]); w.w = pk2(b[2], b[3]); *(u32x4*)p = w; }
    __device__ __forceinline__ void operator()(const f32x4 (&acc)[2][2][4][2], const pg8::Unit& u, int wr, int wc, int fr_, int fq_) const {
        int pn = u.pn;
        if (pnoff == 1) pn = pn < 6 ? pn + 3 : 12; else if (pnoff == 2) pn = pn < 3 ? pn : (pn < 6 ? pn + 6 : pn + 7);
        const int fr = opaque_v(fr_), fq = opaque_v(fq_);
        bf16_t* const QA = (bf16_t*)(ws + WS_QA); bf16_t* const CKV = (bf16_t*)(ws + WS_CKV); bf16_t* const IQ = (bf16_t*)(dout + DO_IQ); bf16_t* const IK = (bf16_t*)(ws + WS_IK);
        bf16_t* const BQ = (bf16_t*)(ws + WS_BQ); bf16_t* const BK = (bf16_t*)(ws + WS_BK); bf16_t* const BV = (bf16_t*)(ws + WS_BV); bf16_t* const CQ = (bf16_t*)(ws + WS_CQ);
        bf16_t* const GATE = (bf16_t*)(dout + DO_GATE); bf16_t* const MIX = (bf16_t*)(ws + WS_BIG); bf16_t* const KC = (bf16_t*)(ws + WS_KC); bf16_t* const VC = (bf16_t*)(ws + WS_VC); float* const IW = (float*)(ws + WS_IW);
        int kind; bf16_t* dst; int ld, cb; int gi = 0; float gsc = 1.f;
        if (memkv) { if (pn < 2) { kind = 3; dst = KC; ld = 512; cb = pn * 256; gi = 16; } else { kind = 0; dst = VC; ld = 512; cb = (pn - 2) * 256; } }
        else if (pn <= 2) { kind = 3; dst = QA; ld = 768; cb = pn * 256; gi = 8; }
        else if (pn == 3) { kind = 4; dst = CKV; ld = 256; cb = 0; gi = 4; }
        else if (pn <= 7) { kind = 0; dst = IQ; ld = 1024; cb = (pn - 4) * 256; }
        else if (pn == 8) { kind = 6; dst = IK; ld = 64; cb = 0; }
        else if (pn <= 11) { kind = 5; dst = BQ; ld = 768; cb = (pn - 9) * 256; gi = 10; gsc = 0.125f; }
        else if (pn == 12) { kind = 7; dst = BK; ld = 128; cb = 0; gi = 11; }
        else if (pn <= 14) { kind = 3; dst = CQ; ld = 512; cb = (pn - 13) * 256; gi = 15; gsc = 0.08838834764831845f; }
        else if (pn <= 17) { kind = 1; dst = GATE; ld = 2048; cb = (pn - 15) * 256; }
        else if (pn <= 20) { kind = 1; dst = GATE; ld = 2048; cb = 768 + (pn - 18) * 256; }
        else if (pn <= 22) { kind = 1; dst = GATE; ld = 2048; cb = 1536 + (pn - 21) * 256; }
        else { kind = 2; dst = MIX; ld = 6144; cb = (pn - 23) * 256; }
        if (kind <= 2) {
#pragma unroll
            for (int bj = 0; bj < 2; ++bj) { const int c = cb + EPI_COLP(bj); f32x4 b0 = (f32x4){0.f, 0.f, 0.f, 0.f}, b1 = b0; if (kind == 2) { b0 = *(const f32x4*)(in[20] + c); b1 = *(const f32x4*)(in[20] + c + 4); }
#pragma unroll
                for (int ai = 0; ai < 2; ++ai)
#pragma unroll
                    for (int m = 0; m < 4; ++m) { const size_t row = EPI_ROWS(ai, m); f32x4 v = acc[ai][bj][m][0] + b0, w = acc[ai][bj][m][1] + b1;
                        if (kind == 1) { v[0] = silu_f(v[0]); v[1] = silu_f(v[1]); v[2] = silu_f(v[2]); v[3] = silu_f(v[3]); w[0] = silu_f(w[0]); w[1] = silu_f(w[1]); w[2] = silu_f(w[2]); w[3] = silu_f(w[3]); }
                        if (kind == 2) { v[0] = einv_f(v[0]); v[1] = einv_f(v[1]); v[2] = einv_f(v[2]); v[3] = einv_f(v[3]); w[0] = einv_f(w[0]); w[1] = einv_f(w[1]); w[2] = einv_f(w[2]); w[3] = einv_f(w[3]); }
                        store8(dst + row * ld + c, v, w); asm volatile("" ::: "memory"); } }
            return;
        }
        LAS float* X = (LAS float*)(lds + EPX_OFF); LAS float* Y = (LAS float*)(lds + EPY_OFF);
        const float* gain = in[gi]; const float* ln_g = in[6]; const float* ln_b = in[7];
#pragma unroll
        for (int ai = 0; ai < 2; ++ai)
#pragma unroll
            for (int m = 0; m < 4; ++m) { const int rl = ai * 128 + wr * 64 + m * 16 + fr;
#pragma unroll
                for (int bj = 0; bj < 2; ++bj) { const f32x4 a0 = acc[ai][bj][m][0], a1 = acc[ai][bj][m][1];
                    float sq = (a0[0] * a0[0] + a0[1] * a0[1]) + (a0[2] * a0[2] + a0[3] * a0[3]) + (a1[0] * a1[0] + a1[1] * a1[1]) + (a1[2] * a1[2] + a1[3] * a1[3]);
                    sq += __shfl_xor(sq, 16); sq += __shfl_xor(sq, 32);
                    if (fq == 0) X[(rl * 2 + bj) * 4 + wc] = sq;
                    if (kind == 6) { float sm = (a0[0] + a0[1]) + (a0[2] + a0[3]) + (a1[0] + a1[1]) + (a1[2] + a1[3]); sm += __shfl_xor(sm, 16); sm += __shfl_xor(sm, 32); if (fq == 0) Y[(rl * 2 + bj) * 4 + wc] = sm; } } }
        asm volatile("s_waitcnt lgkmcnt(0)" ::: "memory"); __builtin_amdgcn_s_barrier(); asm volatile("" ::: "memory");
#pragma unroll
        for (int ai = 0; ai < 2; ++ai)
#pragma unroll
            for (int m = 0; m < 4; ++m) { const int rl = ai * 128 + wr * 64 + m * 16 + fr; const size_t row = EPI_ROWS(ai, m);
                const f32x4 x0 = *(const LAS f32x4*)(X + (rl * 2 + 0) * 4), x1 = *(const LAS f32x4*)(X + (rl * 2 + 1) * 4);
                float rs0, rs1;
                if (kind == 3) { rs0 = rsqrt_f(((x0[0] + x0[1]) + (x0[2] + x0[3])) * (1.f / 128.f) + EPS); rs1 = rsqrt_f(((x1[0] + x1[1]) + (x1[2] + x1[3])) * (1.f / 128.f) + EPS); }
                else if (kind == 4) { rs0 = rs1 = rsqrt_f((((x0[0] + x0[1]) + (x0[2] + x0[3])) + ((x1[0] + x1[1]) + (x1[2] + x1[3]))) * (1.f / 256.f) + EPS); }
                else { const int w2 = wc & 2; rs0 = rsqrt_f((w2 ? x0[2] + x0[3] : x0[0] + x0[1]) * (1.f / 64.f) + EPS); rs1 = rsqrt_f((w2 ? x1[2] + x1[3] : x1[0] + x1[1]) * (1.f / 64.f) + EPS); }
                if (kind == 6) {
                    if (wc < 2) { const f32x4 y0 = *(const LAS f32x4*)(Y + (rl * 2 + 0) * 4); const float mean = (y0[0] + y0[1]) * (1.f / 64.f); const float var = fmaxf((x0[0] + x0[1]) * (1.f / 64.f) - mean * mean, 0.f); const float rstd = rsqrt_f(var + EPS);
                        const int c = wc * 32 + 8 * fq; const f32x4 g0 = *(const f32x4*)(ln_g + c), g1 = *(const f32x4*)(ln_g + c + 4), e0 = *(const f32x4*)(ln_b + c), e1 = *(const f32x4*)(ln_b + c + 4);
                        store8(IK + row * 64 + c, (acc[ai][0][m][0] - mean) * rstd * g0 + e0, (acc[ai][0][m][1] - mean) * rstd * g1 + e1); }
                    else if (wc == 2 && fq < 2) { *(f32x4*)(IW + row * 16 + 8 * fq) = acc[ai][0][m][0] * 0.03125f; *(f32x4*)(IW + row * 16 + 8 * fq + 4) = acc[ai][0][m][1] * 0.03125f; }
                } else if (kind == 7) {
                    const int c = wc * 32 + 8 * fq; const f32x4 g0 = *(const f32x4*)(gain + (c & 63)), g1 = *(const f32x4*)(gain + (c & 63) + 4);
                    store8(BK + row * 128 + c, acc[ai][0][m][0] * rs0 * g0, acc[ai][0][m][1] * rs0 * g1); store8(BV + row * 128 + c, acc[ai][1][m][0], acc[ai][1][m][1]);
                } else {
#pragma unroll
                    for (int bj = 0; bj < 2; ++bj) { const int ct = EPI_COLP(bj); const int go = kind == 4 ? ct : (kind == 3 ? (ct & 127) : (ct & 63)); const f32x4 g0 = *(const f32x4*)(gain + go), g1 = *(const f32x4*)(gain + go + 4);
                        const float rr = (bj ? rs1 : rs0) * gsc;
                        store8(dst + row * ld + cb + ct, acc[ai][bj][m][0] * rr * g0, acc[ai][bj][m][1] * rr * g1); } }
                asm volatile("" ::: "memory"); }
    }
};
struct EpiMix {
    static constexpr bool PERM = true, HAS_MID = false;
    bf16_t* MIX; const float* gb;
    __device__ __forceinline__ void operator()(const f32x4 (&acc)[2][2][4][2], const pg8::Unit& u, int wr, int wc, int fr_, int fq_) const {
        const int fr = opaque_v(fr_), fq = opaque_v(fq_);
#pragma unroll
        for (int bj = 0; bj < 2; ++bj) { const int c = u.pn * 256 + EPI_COLP(bj); const f32x4 b0 = *(const f32x4*)(gb + c), b1 = *(const f32x4*)(gb + c + 4);
#pragma unroll
            for (int ai = 0; ai < 2; ++ai)
#pragma unroll
                for (int m = 0; m < 4; ++m) { const size_t row = EPI_ROWS(ai, m); const f32x4 v = acc[ai][bj][m][0] + b0, w = acc[ai][bj][m][1] + b1;
                    u32x4 o; o.x = pk2(sigmoid_f(v[0]), sigmoid_f(v[1])); o.y = pk2(sigmoid_f(v[2]), sigmoid_f(v[3])); o.z = pk2(sigmoid_f(w[0]), sigmoid_f(w[1])); o.w = pk2(sigmoid_f(w[2]), sigmoid_f(w[3]));
                    *(u32x4*)(MIX + row * 6144 + c) = o; asm volatile("" ::: "memory"); } }
    }
};
struct EpiF32 {
    static constexpr bool PERM = false, HAS_MID = false;
    float* C; int ldc;
    __device__ __forceinline__ void operator()(const f32x4 (&acc)[2][2][4][2], const pg8::Unit& u, int wr, int wc, int fr, int fq) const {
#pragma unroll
        for (int ai = 0; ai < 2; ++ai)
#pragma unroll
            for (int m = 0; m < 4; ++m) { const size_t row = EPI_ROWS(ai, m);
#pragma unroll
                for (int bj = 0; bj < 2; ++bj)
#pragma unroll
                    for (int n = 0; n < 2; ++n) *(f32x4*)(C + row * ldc + u.pn * 256 + EPI_COLT(bj, n)) = acc[ai][bj][m][n]; }
    }
};
struct EpiBf {
    static constexpr bool PERM = false, HAS_MID = false;
    bf16_t* O; int ldc;
    __device__ __forceinline__ void operator()(const f32x4 (&acc)[2][2][4][2], const pg8::Unit& u, int wr, int wc, int fr, int fq) const {
#pragma unroll
        for (int ai = 0; ai < 2; ++ai)
#pragma unroll
            for (int m = 0; m < 4; ++m) { const size_t row = EPI_ROWS(ai, m);
#pragma unroll
                for (int bj = 0; bj < 2; ++bj)
#pragma unroll
                    for (int n = 0; n < 2; ++n) { const f32x4 v = acc[ai][bj][m][n]; u32x2 w; w.x = pk2(v[0], v[1]); w.y = pk2(v[2], v[3]);
                        *(u32x2*)(O + row * ldc + u.pn * 256 + EPI_COLT(bj, n)) = w; } }
    }
};
struct EpiKss {
    static constexpr bool PERM = false, HAS_MID = false;
    float* KSS;
    __device__ __forceinline__ void operator()(const f32x4 (&acc)[2][2][4][2], const pg8::Unit& u, int wr, int wc, int fr, int fq) const {
#pragma unroll
        for (int ai = 0; ai < 2; ++ai)
#pragma unroll
            for (int m = 0; m < 4; ++m) { const size_t row = EPI_ROWS(ai, m);
#pragma unroll
                for (int bj = 0; bj < 2; ++bj) { float s = 0.f;
#pragma unroll
                    for (int n = 0; n < 2; ++n) { const f32x4 v = acc[ai][bj][m][n]; s += (v[0] * v[0] + v[1] * v[1]) + (v[2] * v[2] + v[3] * v[3]); }
                    atomicAdd(KSS + row * 8 + 2 * u.pn + bj, s); }
                asm volatile("" ::: "memory"); }
    }
};
struct EpiGateMul {
    static constexpr bool PERM = false, HAS_MID = false;
    bf16_t* OP; const bf16_t* GATE;
    __device__ __forceinline__ void operator()(const f32x4 (&acc)[2][2][4][2], const pg8::Unit& u, int wr, int wc, int fr, int fq) const {
#pragma unroll
        for (int ai = 0; ai < 2; ++ai)
#pragma unroll
            for (int m = 0; m < 4; ++m) { const size_t row = EPI_ROWS(ai, m);
#pragma unroll
                for (int bj = 0; bj < 2; ++bj)
#pragma unroll
                    for (int n = 0; n < 2; ++n) { const int c = u.pn * 256 + EPI_COLT(bj, n); const f32x4 v = acc[ai][bj][m][n];
                        const u32x2 gw = *(const u32x2*)(GATE + row * 2048 + c);
                        *(unsigned*)((unsigned char*)OP + row * 2048 + c) = pk4_fp8(16.f * v[0] * bf2f(gw.x & 0xffff), 16.f * v[1] * bf2f(gw.x >> 16), 16.f * v[2] * bf2f(gw.y & 0xffff), 16.f * v[3] * bf2f(gw.y >> 16)); }
                asm volatile("" ::: "memory"); }
    }
};
struct EpiMerge {
    static constexpr bool PERM = true, HAS_MID = true;
    bf16_t* MERGED; const bf16_t* MIX; int mid_t0, mid_t1;
    __device__ __forceinline__ void gate8(const bf16_t* p, f32x4& a, f32x4& b) const { const u32x4 w = *(const u32x4*)p;
        a[0] = bf2f(w.x & 0xffff); a[1] = bf2f(w.x >> 16); a[2] = bf2f(w.y & 0xffff); a[3] = bf2f(w.y >> 16); b[0] = bf2f(w.z & 0xffff); b[1] = bf2f(w.z >> 16); b[2] = bf2f(w.w & 0xffff); b[3] = bf2f(w.w >> 16);
#pragma unroll
        for (int j = 0; j < 4; ++j) { a[j] = fmaxf(a[j], 1e-20f); b[j] = fmaxf(b[j], 1e-20f); } }
    __device__ __forceinline__ void unpack8(const u32x4 w, f32x4& a, f32x4& b) const {
        a[0] = bf2f(w.x & 0xffff); a[1] = bf2f(w.x >> 16); a[2] = bf2f(w.y & 0xffff); a[3] = bf2f(w.y >> 16); b[0] = bf2f(w.z & 0xffff); b[1] = bf2f(w.z >> 16); b[2] = bf2f(w.w & 0xffff); b[3] = bf2f(w.w >> 16); }
    __device__ __forceinline__ void mid(f32x4 (&acc)[2][2][4][2], const pg8::Unit& u, int t, int wr, int wc, int fr_, int fq_) const {
        const int fr = opaque_v(fr_), fq = opaque_v(fq_); const int gprev = t == mid_t0 ? 0 : 2048;
        u32x4 wp[4][2][2], wn[4][2][2];
#define MID_LOAD(bt) do { _Pragma("unroll") for (int mm = 0; mm < 2; ++mm) { const size_t row = EPI_ROWS((bt) >> 1, 2 * ((bt) & 1) + mm); \
            _Pragma("unroll") for (int bj = 0; bj < 2; ++bj) { const int c = u.pn * 256 + EPI_COLP(bj); wp[bt][mm][bj] = *(const u32x4*)(MIX + row * 6144 + gprev + c); wn[bt][mm][bj] = *(const u32x4*)(MIX + row * 6144 + gprev + 2048 + c); } } } while (0)
#define MID_USE(bt) do { _Pragma("unroll") for (int mm = 0; mm < 2; ++mm) { const int ai = (bt) >> 1, m = 2 * ((bt) & 1) + mm; \
            _Pragma("unroll") for (int bj = 0; bj < 2; ++bj) { f32x4 p0, p1, n0, n1; unpack8(wp[bt][mm][bj], p0, p1); unpack8(wn[bt][mm][bj], n0, n1); \
                _Pragma("unroll") for (int j = 0; j < 4; ++j) { acc[ai][bj][m][0][j] *= n0[j] * __builtin_amdgcn_rcpf(p0[j]); acc[ai][bj][m][1][j] *= n1[j] * __builtin_amdgcn_rcpf(p1[j]); } } } } while (0)
        MID_LOAD(0); MID_LOAD(1); asm volatile("" ::: "memory");
        MID_USE(0); asm volatile("" ::: "memory"); MID_LOAD(2); asm volatile("" ::: "memory");
        MID_USE(1); asm volatile("" ::: "memory"); MID_LOAD(3); asm volatile("" ::: "memory");
        MID_USE(2); asm volatile("" ::: "memory");
        MID_USE(3); asm volatile("" ::: "memory");
#undef MID_LOAD
#undef MID_USE
    }
    __device__ __forceinline__ void operator()(const f32x4 (&acc)[2][2][4][2], const pg8::Unit& u, int wr, int wc, int fr_, int fq_) const {
        const int fr = opaque_v(fr_), fq = opaque_v(fq_);
#pragma unroll
        for (int ai = 0; ai < 2; ++ai) { u32x4 wg[4][2];
#pragma unroll
            for (int m = 0; m < 4; ++m) { const size_t row = EPI_ROWS(ai, m);
#pragma unroll
                for (int bj = 0; bj < 2; ++bj) wg[m][bj] = *(const u32x4*)(MIX + row * 6144 + 4096 + u.pn * 256 + EPI_COLP(bj)); }
            asm volatile("" ::: "memory");
#pragma unroll
            for (int m = 0; m < 4; ++m) { const size_t row = EPI_ROWS(ai, m);
#pragma unroll
                for (int bj = 0; bj < 2; ++bj) { const int c = u.pn * 256 + EPI_COLP(bj); f32x4 g0, g1; unpack8(wg[m][bj], g0, g1);
                    f32x4 v, w;
#pragma unroll
                    for (int j = 0; j < 4; ++j) { v[j] = acc[ai][bj][m][0][j] * __builtin_amdgcn_rcpf(g0[j]); w[j] = acc[ai][bj][m][1][j] * __builtin_amdgcn_rcpf(g1[j]); }
                    u32x2 o; o.x = pk4_fp8(16.f * v[0], 16.f * v[1], 16.f * v[2], 16.f * v[3]); o.y = pk4_fp8(16.f * w[0], 16.f * w[1], 16.f * w[2], 16.f * w[3]); *(u32x2*)((unsigned char*)MERGED + row * 2048 + c) = o; } }
            asm volatile("" ::: "memory"); }
    }
};
struct EpiOut {
    static constexpr bool PERM = false, HAS_MID = false;
    float* out; const float* x;
    __device__ __forceinline__ void operator()(const f32x4 (&acc)[2][2][4][2], const pg8::Unit& u, int wr, int wc, int fr, int fq) const {
#pragma unroll
        for (int ai = 0; ai < 2; ++ai)
#pragma unroll
            for (int mh = 0; mh < 2; ++mh) { f32x4 xv[2][2][2];
#pragma unroll
                for (int mm = 0; mm < 2; ++mm) { const size_t row = EPI_ROWS(ai, 2 * mh + mm);
#pragma unroll
                    for (int bj = 0; bj < 2; ++bj)
#pragma unroll
                        for (int n = 0; n < 2; ++n) xv[mm][bj][n] = *(const f32x4*)(x + row * 2048 + u.pn * 256 + EPI_COLT(bj, n)); }
                asm volatile("" ::: "memory");
#pragma unroll
                for (int mm = 0; mm < 2; ++mm) { const size_t row = EPI_ROWS(ai, 2 * mh + mm);
#pragma unroll
                    for (int bj = 0; bj < 2; ++bj)
#pragma unroll
                        for (int n = 0; n < 2; ++n) *(f32x4*)(out + row * 2048 + u.pn * 256 + EPI_COLT(bj, n)) = xv[mm][bj][n] + acc[ai][bj][2 * mh + mm][n]; }
                asm volatile("" ::: "memory"); }
    }
};

template <class F>
__device__ __forceinline__ void cvt_matrix(Ctx& C, bf16_t* dst, int dld, int Nn, int K, const F& f) {
    const long total = (long)Nn * (K / 8);
    for (long it = (long)C.vcu * NTHREADS + C.tid; it < total; it += (long)C.G * NTHREADS) {
        const int n = (int)(it % Nn), k0 = (int)(it / Nn) * 8;
        u32x4 w; w.x = pk2(f(n, k0), f(n, k0 + 1)); w.y = pk2(f(n, k0 + 2), f(n, k0 + 3)); w.z = pk2(f(n, k0 + 4), f(n, k0 + 5)); w.w = pk2(f(n, k0 + 6), f(n, k0 + 7));
        *(u32x4*)(dst + (size_t)n * dld + k0) = w;
    }
}
__device__ __forceinline__ unsigned pk4_fp8(float a, float b, float c, float d);
__device__ __forceinline__ void rms_rows2_to_bf16(const float* xrow, const float* g, bf16_t* orow, size_t rstride, int lane, unsigned char* o8row = nullptr) {
    const f32x4* xr0 = (const f32x4*)xrow + lane; const f32x4* xr1 = (const f32x4*)(xrow + rstride) + lane; const f32x4* gr = (const f32x4*)g + lane;
    f32x4 v0[8], v1[8]; float s0 = 0.f, s1 = 0.f;
#pragma unroll
    for (int j = 0; j < 8; ++j) { v0[j] = xr0[64 * j]; v1[j] = xr1[64 * j]; }
#pragma unroll
    for (int j = 0; j < 8; ++j) { s0 += (v0[j][0] * v0[j][0] + v0[j][1] * v0[j][1]) + (v0[j][2] * v0[j][2] + v0[j][3] * v0[j][3]); s1 += (v1[j][0] * v1[j][0] + v1[j][1] * v1[j][1]) + (v1[j][2] * v1[j][2] + v1[j][3] * v1[j][3]); }
    const float r0 = rsqrt_f(wave_sum(s0) * (1.f / 2048.f) + EPS), r1 = rsqrt_f(wave_sum(s1) * (1.f / 2048.f) + EPS);
    u32x2* o0 = (u32x2*)orow + lane; u32x2* o1 = (u32x2*)(orow + rstride) + lane;
#pragma unroll
    for (int j = 0; j < 8; ++j) { const f32x4 gg = gr[64 * j]; u32x2 w;
        w.x = pk2(v0[j][0] * r0 * gg[0], v0[j][1] * r0 * gg[1]); w.y = pk2(v0[j][2] * r0 * gg[2], v0[j][3] * r0 * gg[3]); o0[64 * j] = w;
        w.x = pk2(v1[j][0] * r1 * gg[0], v1[j][1] * r1 * gg[1]); w.y = pk2(v1[j][2] * r1 * gg[2], v1[j][3] * r1 * gg[3]); o1[64 * j] = w;
        if (o8row) { ((unsigned*)o8row)[lane + 64 * j] = pk4_fp8(v0[j][0] * r0 * gg[0], v0[j][1] * r0 * gg[1], v0[j][2] * r0 * gg[2], v0[j][3] * r0 * gg[3]);
            ((unsigned*)(o8row + rstride))[lane + 64 * j] = pk4_fp8(v1[j][0] * r1 * gg[0], v1[j][1] * r1 * gg[1], v1[j][2] * r1 * gg[2], v1[j][3] * r1 * gg[3]); } }
}
template <class F>
__device__ __forceinline__ void transpose_item(const F& f, bf16_t* dst, int dld, int k0, int n0, LAS float* scr, int lane) {
    float tv[32];
#pragma unroll
    for (int i = 0; i < 32; ++i) tv[i] = f(k0 + 2 * i + (lane >> 5), n0 + (lane & 31));
#pragma unroll
    for (int i = 0; i < 32; ++i) scr[(2 * i + (lane >> 5)) * 33 + (lane & 31)] = tv[i];
    asm volatile("s_waitcnt lgkmcnt(0)" ::: "memory");
    const int c = lane & 7;
#pragma unroll
    for (int j = 0; j < 4; ++j) { const int n = (lane >> 3) + 8 * j; const LAS float* sp = scr + (8 * c) * 33 + n;
        u32x4 o; o.x = pk2(sp[0 * 33], sp[1 * 33]); o.y = pk2(sp[2 * 33], sp[3 * 33]); o.z = pk2(sp[4 * 33], sp[5 * 33]); o.w = pk2(sp[6 * 33], sp[7 * 33]);
        *(u32x4*)(dst + (size_t)(n0 + n) * dld + k0 + 8 * c) = o; }
    asm volatile("s_waitcnt lgkmcnt(0)" ::: "memory");
}
__device__ __forceinline__ unsigned pk4_fp8(float a, float b, float c, float d) { int w = 0; w = __builtin_amdgcn_cvt_pk_fp8_f32(a, b, w, false); w = __builtin_amdgcn_cvt_pk_fp8_f32(c, d, w, true); return (unsigned)w; }
template <class F>
__device__ __forceinline__ void transpose_item8(const F& f, unsigned char* dst, int dld, int k0, int n0, LAS float* scr, int lane) {
    float tv[32];
#pragma unroll
    for (int i = 0; i < 32; ++i) tv[i] = f(k0 + 2 * i + (lane >> 5), n0 + (lane & 31));
#pragma unroll
    for (int i = 0; i < 32; ++i) scr[(2 * i + (lane >> 5)) * 33 + (lane & 31)] = tv[i];
    asm volatile("s_waitcnt lgkmcnt(0)" ::: "memory");
    const int c = lane & 7;
#pragma unroll
    for (int j = 0; j < 4; ++j) { const int n = (lane >> 3) + 8 * j; const LAS float* sp = scr + (8 * c) * 33 + n;
        u32x2 o; o.x = pk4_fp8(sp[0 * 33], sp[1 * 33], sp[2 * 33], sp[3 * 33]); o.y = pk4_fp8(sp[4 * 33], sp[5 * 33], sp[6 * 33], sp[7 * 33]);
        *(u32x2*)(dst + (size_t)(n0 + n) * dld + k0 + 8 * c) = o; }
    asm volatile("s_waitcnt lgkmcnt(0)" ::: "memory");
}
__device__ __forceinline__ void p0_prologue(Ctx& C) {
    unsigned char* ws = C.ws;
    const float* w_in = C.in[3]; const float* w_kv_up = C.in[5]; const float* k_norm_a = C.in[9]; const float* w_mem_kv = C.in[14];
    const float* w_up_a = C.in[17]; const float* w_up_b = C.in[18]; const float* w_up_c = C.in[19]; const float* w_o = C.in[21];
    const int lane = C.lane;
    const int gw = C.vcu * NWAVES + C.wave, NGW = C.G * NWAVES;
    LAS float* scr = (LAS float*)(C.lds + C.wave * 8704);
    constexpr int I_WIN = 32 * (NWIN_A / 32), I_MIX = 32 * (NWIN_B / 32), I_UP = 32 * 64, I_O = 32 * 64, I_MEM = 32 * 32;
    for (int it = gw; it < I_WIN + I_MIX + I_UP + I_O + I_MEM; it += NGW) {
        int r = it;
        if (r < I_WIN) { const int nb = r % (NWIN_A / 32), kb = r / (NWIN_A / 32);
            transpose_item([=](int k, int n) -> float { if (n >= 1360 && n < 1536) return 0.f;
                const int c = n < 1360 ? 768 + n : 3664 + (n - 1536); return w_in[(size_t)k * IN_COLS + c]; }, (bf16_t*)(ws + WS_WINT), 2048, 64 * kb, 32 * nb, scr, lane); continue; }
        r -= I_WIN;
        if (r < I_MIX) { const int nb = r % (NWIN_B / 32), kb = r / (NWIN_B / 32);
            transpose_item8([=](int k, int n) -> float { int c;
                if (n < 768) c = n; else if (n < 1536) c = 2896 + (n - 768); else if (n < 2048) c = 4688 + (n - 1536);
                else { const int m = n - 2048; c = m < 768 ? 2128 + m : (m < 1536 ? 3920 + (m - 768) : (m < 2048 ? 5200 + (m - 1536) : 5712 + (m - 2048))); }
                return 64.0f * w_in[(size_t)k * IN_COLS + c]; }, ws + WS_WMIX8, 2048, 64 * kb, 32 * nb, scr, lane); continue; }
        r -= I_MIX;
        if (r < I_UP) { const int nb = r % 64, kb = r / 64; const int k0 = 64 * kb;
            const float* src = k0 < 768 ? w_up_a : (k0 < 1536 ? w_up_b - (size_t)768 * 2048 : w_up_c - (size_t)1536 * 2048);
            transpose_item8([=](int k, int n) -> float { return 32.0f * src[(size_t)k * 2048 + n]; }, ws + WS_WUPT, 2048, k0, 32 * nb, scr, lane); continue; }
        r -= I_UP;
        if (r < I_O) { const int nb = r % 64, kb = r / 64;
            transpose_item8([=](int k, int n) -> float { return 64.0f * w_o[(size_t)k * 2048 + n]; }, ws + WS_WOT, 2048, 64 * kb, 32 * nb, scr, lane); continue; }
        r -= I_O;
        { const int nb = r % 32, kb = r / 32;
            transpose_item([=](int k, int n) -> float { return w_mem_kv[(size_t)k * 1024 + n]; }, (bf16_t*)(ws + WS_WMEMT), 2048, 64 * kb, 32 * nb, scr, lane); }
    }
    cvt_matrix(C, (bf16_t*)(ws + WS_WKT), 256, 768, 256, [=](int n, int k) -> float { return w_kv_up[(size_t)k * 1536 + n]; });
    cvt_matrix(C, (bf16_t*)(ws + WS_WVBD), 512, 768, 512, [=](int n, int k) -> float { return (k >> 8) == ((n >> 7) & 1) ? w_kv_up[(size_t)(k & 255) * 1536 + 768 + n] : 0.f; });
    cvt_matrix(C, (bf16_t*)(ws + WS_WQBD), 128, 1536, 128, [=](int n, int k) -> float {
        return w_kv_up[(size_t)(n & 255) * 1536 + (n >> 8) * 128 + k] * k_norm_a[k] * 0.08838834764831845f; });
    for (int m = gw; m < M / 2; m += NGW) rms_rows2_to_bf16(C.in[0] + (size_t)m * DM, C.in[2], (bf16_t*)(ws + WS_H) + (size_t)m * DM, (size_t)(M / 2) * DM, C.lane, ws + WS_H8 + (size_t)m * DM);
    for (int m = gw; m < BATCH * MEMLEN / 2; m += NGW) rms_rows2_to_bf16(C.in[1] + (size_t)m * DM, C.in[13], (bf16_t*)(ws + WS_MEMN) + (size_t)m * DM, (size_t)(BATCH * MEMLEN / 2) * DM, C.lane);
    float* kss = (float*)(ws + WS_KSS);
    for (int i = C.vcu * NTHREADS + C.tid; i < M * 8; i += C.G * NTHREADS) kss[i] = 0.f;
}

typedef __bf16 bf8v __attribute__((ext_vector_type(8)));
typedef int i32x4 __attribute__((ext_vector_type(4)));
typedef float f32x16 __attribute__((ext_vector_type(16)));
#define MFMA32(a, b, c) __builtin_amdgcn_mfma_f32_32x32x16_bf16(__builtin_bit_cast(bf8v, (a)), __builtin_bit_cast(bf8v, (b)), (c), 0, 0, 0)
constexpr int IX_NB = 256, IX_CAP = 128, IX_QROW = 144;
constexpr int IX_Q = 0, IX_HIST = 78848, IX_CAND = IX_HIST + 32768, IX_PAR = IX_CAND + 32768, IX_STAT = IX_PAR + 1024;
static_assert(IX_STAT + 3072 <= LDS_BYTES, "indexer LDS map");
#define LDS_ADD(p, v) __hip_atomic_fetch_add((p), (v), __ATOMIC_RELAXED, __HIP_MEMORY_SCOPE_WORKGROUP)
#define LDS_OR(p, v) __hip_atomic_fetch_or((p), (v), __ATOMIC_RELAXED, __HIP_MEMORY_SCOPE_WORKGROUP)

__device__ __forceinline__ float inv_norm_top(float p) {
    const bool flip = p > 0.5f; float pp = flip ? 1.f - p : p; pp = fmaxf(pp, 1e-6f);
    const float t = sqrtf(-2.f * __logf(pp));
    const float z = t - (2.515517f + 0.802853f * t + 0.010328f * t * t) / (1.f + 1.432788f * t + 0.189269f * t * t + 0.001308f * t * t * t);
    return flip ? -z : z;
}
constexpr int IX_W = IX_STAT + 8192;
#define MFMA16I(a, b, c) __builtin_amdgcn_mfma_f32_16x16x32_bf16(__builtin_bit_cast(bf8v, (a)), __builtin_bit_cast(bf8v, (b)), (c), 0, 0, 0)
__device__ __forceinline__ void ix_load_k(const bf16_t* IKb, int p, int lane, u32x4 (&ka)[4][2]) {
#pragma unroll
    for (int kt = 0; kt < 4; ++kt) { int key = 64 * p + 16 * kt + (lane & 15); key = key < SEQ ? key : SEQ - 1;
        const u32x4* kp = (const u32x4*)(IKb + (size_t)key * 64) + (lane >> 4);
#pragma unroll
        for (int s = 0; s < 2; ++s) ka[kt][s] = kp[4 * s]; }
}
template <bool PREF>
__device__ __forceinline__ void ix_scores(const u32x4 (&ka)[4][2], const LAS unsigned char* Qs, int lane, f32x4 (&sacc)[2][4], const bf16_t* IKb, int pn, u32x4 (&kn)[4][2]) {
    const LAS unsigned char* qb = Qs + (lane & 15) * IX_QROW + (lane >> 4) * 16;
    const LAS float* wl = (const LAS float*)(Qs - IX_Q + IX_W) + (lane & 15);
    u32x4 qc[2][2], qn[2][2]; float wc0, wc1, wn0, wn1, wp1 = 0.f;
#pragma unroll
    for (int qt = 0; qt < 2; ++qt)
#pragma unroll
        for (int s = 0; s < 2; ++s) qc[qt][s] = *(const LAS u32x4*)(qb + (16 * 32 + 16 * qt) * IX_QROW + 64 * s);
#pragma unroll
    for (int qt = 0; qt < 2; ++qt)
#pragma unroll
        for (int s = 0; s < 2; ++s) qn[qt][s] = *(const LAS u32x4*)(qb + (16 * qt) * IX_QROW + 64 * s);
    wn0 = wl[0]; wn1 = wl[16];
    asm volatile("" ::: "memory");
#pragma unroll
    for (int qt = 0; qt < 2; ++qt)
#pragma unroll
        for (int kt = 0; kt < 4; ++kt) sacc[qt][kt] = (f32x4){0.f, 0.f, 0.f, 0.f};
#pragma unroll
    for (int s = 0; s < 2; ++s)
#pragma unroll
        for (int qt = 0; qt < 2; ++qt)
#pragma unroll
            for (int kt = 0; kt < 4; ++kt) sacc[qt][kt] = MFMA16I(ka[kt][s], qc[qt][s], sacc[qt][kt]);
    f32x4 z0[4], z1[4];
#pragma unroll
    for (int kt = 0; kt < 4; ++kt) z1[kt] = (f32x4){0.f, 0.f, 0.f, 0.f};
#pragma unroll
    for (int hh = 0; hh < 16; ++hh) {
#pragma unroll
        for (int qt = 0; qt < 2; ++qt)
#pragma unroll
            for (int s = 0; s < 2; ++s) qc[qt][s] = qn[qt][s];
        wc0 = wn0; wc1 = wn1;
#pragma unroll
        for (int kt = 0; kt < 4; ++kt) z0[kt] = (f32x4){0.f, 0.f, 0.f, 0.f};
#pragma unroll
        for (int s = 0; s < 2; ++s)
#pragma unroll
            for (int kt = 0; kt < 4; ++kt) z0[kt] = MFMA16I(ka[kt][s], qc[0][s], z0[kt]);
        if (hh > 0) {
#pragma unroll
            for (int kt = 0; kt < 4; ++kt)
#pragma unroll
                for (int i = 0; i < 4; ++i) { float t1 = __builtin_fmaf(__builtin_fabsf(z1[kt][i]), wp1, sacc[1][kt][i]); asm volatile("" : "+v"(t1)); sacc[1][kt][i] = t1; }
#pragma unroll
            for (int i = 0; i < 8; ++i) { __builtin_amdgcn_sched_group_barrier(0x008, 1, 0); __builtin_amdgcn_sched_group_barrier(0x002, 2, 0); }
            asm volatile("" : "+v"(sacc[1][0]), "+v"(sacc[1][1]), "+v"(sacc[1][2]), "+v"(sacc[1][3]));
        }
        __builtin_amdgcn_sched_barrier(0);
#pragma unroll
        for (int kt = 0; kt < 4; ++kt) z1[kt] = (f32x4){0.f, 0.f, 0.f, 0.f};
#pragma unroll
        for (int s = 0; s < 2; ++s)
#pragma unroll
            for (int kt = 0; kt < 4; ++kt) z1[kt] = MFMA16I(ka[kt][s], qc[1][s], z1[kt]);
        if (hh < 15) {
#pragma unroll
            for (int qt = 0; qt < 2; ++qt)
#pragma unroll
                for (int s = 0; s < 2; ++s) qn[qt][s] = *(const LAS u32x4*)(qb + ((hh + 1) * 32 + 16 * qt) * IX_QROW + 64 * s);
            wn0 = wl[(hh + 1) * 32]; wn1 = wl[(hh + 1) * 32 + 16]; }
#pragma unroll
        for (int kt = 0; kt < 4; ++kt)
#pragma unroll
            for (int i = 0; i < 4; ++i) { float t0 = __builtin_fmaf(__builtin_fabsf(z0[kt][i]), wc0, sacc[0][kt][i]); asm volatile("" : "+v"(t0)); sacc[0][kt][i] = t0; }
#pragma unroll
        for (int i = 0; i < 8; ++i) { __builtin_amdgcn_sched_group_barrier(0x008, 1, 0); __builtin_amdgcn_sched_group_barrier(0x002, 2, 0); if (hh < 15 && i < 6) __builtin_amdgcn_sched_group_barrier(0x100, 1, 0); }
        asm volatile("" : "+v"(sacc[0][0]), "+v"(sacc[0][1]), "+v"(sacc[0][2]), "+v"(sacc[0][3]));
        __builtin_amdgcn_sched_barrier(0);
        wp1 = wc1;
        if (PREF && hh == 5) { ix_load_k(IKb, pn, lane, kn); asm volatile("" ::: "memory"); }
    }
#pragma unroll
    for (int kt = 0; kt < 4; ++kt)
#pragma unroll
        for (int i = 0; i < 4; ++i) { float t1 = __builtin_fmaf(__builtin_fabsf(z1[kt][i]), wp1, sacc[1][kt][i]); asm volatile("" : "+v"(t1)); sacc[1][kt][i] = t1; }
    asm volatile("" : "+v"(sacc[1][0]), "+v"(sacc[1][1]), "+v"(sacc[1][2]), "+v"(sacc[1][3]));
}
typedef __bf16 bf16x2v __attribute__((ext_vector_type(2)));
__device__ __forceinline__ float dot2_bf16(unsigned w, unsigned x, float acc) { return __builtin_amdgcn_fdot2_f32_bf16(__builtin_bit_cast(bf16x2v, w), __builtin_bit_cast(bf16x2v, x), acc, false); }
__device__ __forceinline__ int ix_bin(float sv, float scale, float nls) { int bb = (int)__builtin_fmaf(sv, scale, nls); return bb < 0 ? 0 : (bb > IX_NB - 1 ? IX_NB - 1 : bb); }
__device__ __forceinline__ float f_next(float x) { int i = __float_as_int(x); if (x == 0.f) return __int_as_float(1); i += (i >= 0) ? 1 : -1; return __int_as_float(i); }
__device__ __forceinline__ float f_prev(float x) { int i = __float_as_int(x); if (x == 0.f) return __int_as_float((int)0x80000001u); i += (i >= 0) ? -1 : 1; return __int_as_float(i); }
__device__ __forceinline__ float ix_threshold(int k, float scale, float nls) {
    float gs = ((float)k - nls) / scale;
    for (int i = 0; i < 64 && ix_bin(gs, scale, nls) >= k; ++i) gs = f_prev(gs);
    for (int i = 0; i < 64 && ix_bin(gs, scale, nls) < k; ++i) gs = f_next(gs);
    return gs;
}
constexpr int IX_LIST = IX_STAT;
static_assert(IX_STAT + 8 * 1024 <= LDS_BYTES - 64, "indexer LDS map");
template <int MODE>
__device__ __forceinline__ void fast_indexer(Ctx& C, int* IDX) {
    unsigned char* ws = C.ws; const int wave = C.wave;
    const bf16_t* IQ = (const bf16_t*)((unsigned char*)C.out + DO_IQ); const bf16_t* IK = (const bf16_t*)(ws + WS_IK); const float* IW = (const float*)(ws + WS_IW);
    LAS unsigned char* Qs = C.lds + IX_Q;
    LAS unsigned* hist = (LAS unsigned*)(C.lds + IX_HIST);
    LAS unsigned* cmask = (LAS unsigned*)(C.lds + IX_CAND);
    LAS float* p_nls = (LAS float*)(C.lds + IX_PAR);
    LAS float* p_scale = p_nls + 32;
    LAS int* p_bst = (LAS int*)(p_nls + 64);
    LAS int* p_above = (LAS int*)(p_nls + 96);
    LAS float* p_tlo = p_nls + 128;
    LAS float* p_thi = p_nls + 160;
    LAS unsigned* p_notok = (LAS unsigned*)(p_nls + 192);
    LAS float* stat = (LAS float*)(C.lds + IX_STAT);
#pragma unroll 1
    for (int uu = 0; uu < 2; ++uu) {
        const int tid = opaque_v(C.tid), lane = tid & 63, c16 = lane & 15, g4 = lane >> 4;
        const int b = uu, qblk = uu == 0 ? C.vcu : (255 - C.vcu);
        if (qblk < 0 || qblk > 255) continue;
        const int t0 = 32 * qblk, npairs = (qblk + 2) >> 1;
        const size_t qrow0 = (size_t)b * SEQ + t0;
        const bf16_t* IKb = IK + (size_t)b * SEQ * 64;
        unsigned char* const bins = C.vcu < 192 ? ws + WS_H8 + (size_t)C.vcu * 262144 : ws + WS_H + 32 * MiB + (size_t)(C.vcu - 192) * 262144;
        __syncthreads();
        { u32x4 qv[8];
#pragma unroll
            for (int i = 0; i < 8; ++i) { const int c = tid + NTHREADS * i, r = c >> 7, ch = c & 127; qv[i] = *((const u32x4*)(IQ + (qrow0 + r) * 1024) + ch); }
#pragma unroll
            for (int i = 0; i < 8; ++i) { const int c = tid + NTHREADS * i, r = c >> 7, ch = c & 127, hh = ch >> 3, c8 = ch & 7; *(LAS u32x4*)(Qs + (hh * 32 + r) * IX_QROW + c8 * 16) = qv[i]; } }
        for (int i = tid; i < 8192; i += NTHREADS) { hist[i] = 0u; cmask[i] = 0u; }
        if (tid < 32) { p_bst[tid] = -1; p_above[tid] = 0; p_nls[tid] = 0.f; p_scale[tid] = 0.f; p_tlo[tid] = -INFINITY; p_thi[tid] = -INFINITY; }
        if (tid == 32) p_notok[0] = 0u;
        if (tid < 512) { LAS float* wt = (LAS float*)(C.lds + IX_W); wt[tid] = 0.5f * IW[(qrow0 + (tid & 31)) * 16 + (tid >> 5)]; }
        __syncthreads();
        for (int e = tid; e < 32 * 64; e += NTHREADS) { const int r = e >> 6, d = e & 63; float a = 0.f;
#pragma unroll
            for (int hh = 0; hh < 16; ++hh) a += ((const LAS float*)(C.lds + IX_W))[hh * 32 + r] * bf2f(*(const LAS bf16_t*)(Qs + (hh * 32 + r) * IX_QROW + d * 2));
            *(LAS bf16_t*)(Qs + (16 * 32 + r) * IX_QROW + d * 2) = (bf16_t)f2bf(a); }
        __syncthreads();
        if (MODE & 1) { float sn[2] = {0.f, 0.f}, ss[2] = {0.f, 0.f}, sq[2] = {0.f, 0.f};
            const int ps = npairs <= 8 ? wave : (wave * npairs) >> 3;
            if (ps < npairs) { f32x4 sacc[2][4]; u32x4 ka[4][2]; ix_load_k(IKb, ps, lane, ka); ix_scores<false>(ka, Qs, lane, sacc, IKb, 0, ka);
#pragma unroll
                for (int qt = 0; qt < 2; ++qt)
#pragma unroll
                    for (int kt = 0; kt < 4; ++kt)
#pragma unroll
                        for (int i = 0; i < 4; ++i) { const int key = 64 * ps + 16 * kt + 4 * g4 + i;
                            const float m = key <= t0 + 16 * qt + c16 ? 1.f : 0.f; const float v = sacc[qt][kt][i] * m; sn[qt] += m; ss[qt] += v; sq[qt] += v * v; } }
#pragma unroll
            for (int qt = 0; qt < 2; ++qt) { sn[qt] += __shfl_xor(sn[qt], 16); ss[qt] += __shfl_xor(ss[qt], 16); sq[qt] += __shfl_xor(sq[qt], 16);
                sn[qt] += __shfl_xor(sn[qt], 32); ss[qt] += __shfl_xor(ss[qt], 32); sq[qt] += __shfl_xor(sq[qt], 32);
                if (lane < 16) { stat[(wave * 32 + 16 * qt + lane) * 3 + 0] = sn[qt]; stat[(wave * 32 + 16 * qt + lane) * 3 + 1] = ss[qt]; stat[(wave * 32 + 16 * qt + lane) * 3 + 2] = sq[qt]; } } }
        __syncthreads();
        if (tid < 32) { float sn = 0.f, ss = 0.f, sq = 0.f;
            for (int w = 0; w < 8; ++w) { sn += stat[(w * 32 + tid) * 3 + 0]; ss += stat[(w * 32 + tid) * 3 + 1]; sq += stat[(w * 32 + tid) * 3 + 2]; }
            const int Nt = t0 + tid + 1;
            if (Nt > TOPK) { const float mean = ss / fmaxf(sn, 1.f); const float var = fmaxf(sq / fmaxf(sn, 1.f) - mean * mean, 0.f); const float sd = sqrtf(var);
                const float zq = inv_norm_top((float)TOPK / (float)Nt);
                const float width = fmaxf(3.0f * sd, 1e-6f * fabsf(mean) + 1e-30f);
                const float lo = mean + (zq - 1.5f) * sd, sc = (float)IX_NB / width;
                p_scale[tid] = sc; p_nls[tid] = -lo * sc; p_bst[tid] = 0; } }
        __syncthreads();
#pragma unroll 1
        for (int iter = 0; iter < ((MODE & 2) ? 8 : 0); ++iter) {
            const float nls0 = p_nls[c16], scale0 = p_scale[c16], nls1 = p_nls[16 + c16], scale1 = p_scale[16 + c16];
            u32x4 ka[4][2], kn[4][2];
            if (wave < npairs) ix_load_k(IKb, wave, lane, ka);
#pragma unroll 1
            for (int p = wave; p < npairs; p += 8) { f32x4 sacc[2][4];
                ix_scores<true>(ka, Qs, lane, sacc, IKb, p + 8 < npairs ? p + 8 : p, kn);
#pragma unroll
                for (int kt = 0; kt < 4; ++kt)
#pragma unroll
                    for (int s4 = 0; s4 < 2; ++s4) ka[kt][s4] = kn[kt][s4];
                if (64 * p + 63 <= t0) {
#pragma unroll
                    for (int qt = 0; qt < 2; ++qt) { LAS unsigned* hq = hist + 16 * qt + c16; const float scale = qt ? scale1 : scale0, nls = qt ? nls1 : nls0;
                        unsigned char* brow = bins + (size_t)(16 * qt + c16) * 8192 + 64 * p + 4 * g4;
#pragma unroll
                        for (int kt = 0; kt < 4; ++kt) { int bb[4];
#pragma unroll
                            for (int i = 0; i < 4; ++i) { bb[i] = ix_bin(sacc[qt][kt][i], scale, nls); LDS_ADD(hq + bb[i] * 32, 1u); }
                            *(unsigned*)(brow + 16 * kt) = (unsigned)bb[0] | ((unsigned)bb[1] << 8) | ((unsigned)bb[2] << 16) | ((unsigned)bb[3] << 24); } }
                } else {
#pragma unroll
                    for (int qt = 0; qt < 2; ++qt) { LAS unsigned* hq = hist + 16 * qt + c16; const float scale = qt ? scale1 : scale0, nls = qt ? nls1 : nls0; const int query = t0 + 16 * qt + c16;
                        unsigned char* brow = bins + (size_t)(16 * qt + c16) * 8192 + 64 * p + 4 * g4;
#pragma unroll
                        for (int kt = 0; kt < 4; ++kt) { int bb[4];
#pragma unroll
                            for (int i = 0; i < 4; ++i) { const int key = 64 * p + 16 * kt + 4 * g4 + i;
                                bb[i] = ix_bin(sacc[qt][kt][i], scale, nls); LDS_ADD(hq + bb[i] * 32, key <= query ? 1u : 0u); }
                            *(unsigned*)(brow + 16 * kt) = (unsigned)bb[0] | ((unsigned)bb[1] << 8) | ((unsigned)bb[2] << 16) | ((unsigned)bb[3] << 24); } } }
                asm volatile("" ::: "memory"); }
            __syncthreads();
#pragma unroll 1
            for (int k = 0; k < 4; ++k) { const int tq = 4 * wave + k; const int Nt = t0 + tq + 1;
                if (Nt <= TOPK) continue;
                unsigned c[4]; unsigned cs = 0;
#pragma unroll
                for (int i = 0; i < 4; ++i) { c[i] = hist[(IX_NB - 1 - (4 * lane + i)) * 32 + tq]; cs += c[i]; }
                unsigned pre = cs;
#pragma unroll
                for (int o = 1; o < 64; o <<= 1) { const unsigned y = __shfl_up(pre, o); if (lane >= o) pre += y; }
                const unsigned long long mask = __ballot(pre >= (unsigned)TOPK);
                const int L = __ffsll((long long)mask) - 1;
                if (lane == L) { unsigned ex = pre - cs; int ii = 0;
#pragma unroll
                    for (int i = 0; i < 3; ++i) if (ii == i && ex + c[i] < (unsigned)TOPK) { ex += c[i]; ii = i + 1; }
                    const unsigned nin = ii == 0 ? c[0] : (ii == 1 ? c[1] : (ii == 2 ? c[2] : c[3]));
                    const int bst = IX_NB - 1 - (4 * lane + ii);
                    p_bst[tq] = bst; p_above[tq] = (int)ex;
                    const float sc_q = p_scale[tq], nls_q = p_nls[tq];
                    bool again = false;
                    if (nin > (unsigned)IX_CAP && iter < 7) { const float w1 = 1.0f / sc_q, wd = (float)IX_NB * w1, lo_q = -nls_q * w1;
                        float nlo, nwd;
                        if (bst == 0) { nwd = 2.f * wd; nlo = lo_q + w1 - nwd; }
                        else if (bst == IX_NB - 1) { nwd = 2.f * wd; nlo = lo_q + (float)(IX_NB - 1) * w1; }
                        else { nwd = w1; nlo = lo_q + (float)bst * w1; }
                        if (nwd > 1e-7f * fabsf(nlo) + 1e-36f) { const float nsc = (float)IX_NB / nwd; p_scale[tq] = nsc; p_nls[tq] = -nlo * nsc; LDS_ADD(p_notok, 1u); again = true; } }
                    (void)again; } }
            __syncthreads();
            const unsigned notok = p_notok[0];
            __syncthreads();
            for (int i = tid; i < 8192; i += NTHREADS) hist[i] = 0u;
            if (tid == 0) p_notok[0] = 0u;
            __syncthreads();
            if (notok == 0u) break;
        }
        if (MODE & 4) {
            asm volatile("s_waitcnt vmcnt(0)" ::: "memory"); __syncthreads(); __builtin_amdgcn_fence(__ATOMIC_ACQUIRE, "agent");
            const int nit = (t0 + 32 + 1023) >> 10;
            unsigned Kgt[4];
#pragma unroll
            for (int k = 0; k < 4; ++k) Kgt[k] = (unsigned)(0x7fff - p_bst[4 * wave + k]) * 0x00010001u;
            const unsigned char* brow = bins + (size_t)(4 * wave) * 8192 + 16 * lane;
            u32x4 xn[4];
#pragma unroll
            for (int k = 0; k < 4; ++k) xn[k] = *(const u32x4*)(brow + k * 8192);
#pragma unroll 1
            for (int it = 0; it < nit; ++it) {
                u32x4 xc[4];
#pragma unroll
                for (int k = 0; k < 4; ++k) xc[k] = xn[k];
                if (it + 1 < nit) {
#pragma unroll
                    for (int k = 0; k < 4; ++k) xn[k] = *(const u32x4*)(brow + k * 8192 + 1024 * (it + 1)); }
#pragma unroll
                for (int k = 0; k < 4; ++k) { const int tq = 4 * wave + k; const unsigned kgt = Kgt[k], kge = kgt + 0x00010001u;
                    const unsigned xs[4] = {xc[k].x, xc[k].y, xc[k].z, xc[k].w};
                    unsigned sel = 0u, ge = 0u;
#pragma unroll
                    for (int j = 0; j < 4; ++j) { const unsigned lo = xs[j] & 0x00ff00ffu, hi = (xs[j] >> 8) & 0x00ff00ffu;
                        { const unsigned u = (((lo + kgt) >> 15) & 0x00010001u) | (((hi + kgt) >> 14) & 0x00020002u); sel |= ((u | (u >> 14)) & 0xfu) << (4 * j); }
                        { const unsigned u = (((lo + kge) >> 15) & 0x00010001u) | (((hi + kge) >> 14) & 0x00020002u); ge |= ((u | (u >> 14)) & 0xfu) << (4 * j); } }
                    unsigned cand = ge & ~sel;
                    const int lim = t0 + tq - (1024 * it + 16 * lane);
                    const unsigned vm = lim >= 15 ? 0xffffu : (lim < 0 ? 0u : ((2u << lim) - 1u));
                    sel &= vm; cand &= vm;
                    const unsigned pk = sel | (cand << 16);
                    const unsigned other = (unsigned)__shfl_xor((int)pk, 1);
                    if (!(lane & 1)) { hist[tq * 256 + 32 * it + (lane >> 1)] = (pk & 0xffffu) | (other << 16); cmask[tq * 256 + 32 * it + (lane >> 1)] = (pk >> 16) | (other & 0xffff0000u); } }
            }
        }
        __syncthreads();
        LAS unsigned* klist = (LAS unsigned*)(C.lds + IX_LIST + wave * 1024);
        LAS float* slist = (LAS float*)(klist + 128);
        unsigned slowmask = 0u, ncs = 0u;
        if (MODE & 8) {
#pragma unroll 1
            for (int k = 0; k < 4; ++k) { const int tq = 4 * wave + k; const int Nt = t0 + tq + 1;
                const int R = TOPK - p_above[tq];
                if (Nt > TOPK && R > 0) {
                    unsigned cw[4]; unsigned cnt = 0;
#pragma unroll
                    for (int i = 0; i < 4; ++i) { cw[i] = cmask[tq * 256 + 4 * lane + i]; cnt += __popc(cw[i]); }
                    unsigned pre = cnt;
#pragma unroll
                    for (int o = 1; o < 64; o <<= 1) { const unsigned y = __shfl_up(pre, o); if (lane >= o) pre += y; }
                    const unsigned tot = (unsigned)__builtin_amdgcn_readfirstlane((int)__shfl(pre, 63));
                    if (tot > 16u) slowmask |= 1u << k;
                    else { ncs |= tot << (8 * k);
                        unsigned pos = pre - cnt;
#pragma unroll
                        for (int i = 0; i < 4; ++i) { unsigned wbits = cw[i];
                            while (wbits) { const int bb = __ffs((int)wbits) - 1; wbits &= wbits - 1; klist[16 * k + pos] = (unsigned)(32 * (4 * lane + i) + bb); ++pos; } } } } }
            const int j = lane >> 4, ci = lane & 15, tqj = 4 * wave + j;
            const int ncj = (int)((ncs >> (8 * j)) & 0xffu);
            if (ci < ncj) { const unsigned key = klist[16 * j + ci]; const u32x4* kp = (const u32x4*)(IKb + (size_t)key * 64);
                unsigned kw[32];
#pragma unroll
                for (int c8 = 0; c8 < 8; ++c8) { const u32x4 w = kp[c8]; kw[4 * c8] = w.x; kw[4 * c8 + 1] = w.y; kw[4 * c8 + 2] = w.z; kw[4 * c8 + 3] = w.w; }
                const LAS float* wt = (const LAS float*)(C.lds + IX_W) + tqj;
                float sc = 0.f;
#pragma unroll
                for (int hh = 0; hh < 17; ++hh) { const LAS u32x4* qp = (const LAS u32x4*)(Qs + (hh * 32 + tqj) * IX_QROW); float d0 = 0.f, d1 = 0.f;
#pragma unroll
                    for (int c8 = 0; c8 < 8; ++c8) { const u32x4 qv = qp[c8];
                        d0 = dot2_bf16(qv.x, kw[4 * c8], d0); d1 = dot2_bf16(qv.y, kw[4 * c8 + 1], d1); d0 = dot2_bf16(qv.z, kw[4 * c8 + 2], d0); d1 = dot2_bf16(qv.w, kw[4 * c8 + 3], d1); }
                    const float dd = d0 + d1;
                    sc += hh == 16 ? dd : wt[(hh & 15) * 32] * fabsf(dd); }
                slist[16 * j + ci] = sc; }
            asm volatile("s_waitcnt lgkmcnt(0)" ::: "memory");
            if (ci < ncj) { const float ms = slist[16 * j + ci]; const unsigned mk = klist[16 * j + ci]; int rank = 0; const int Rj = TOPK - p_above[tqj];
                for (int o = 0; o < 16; ++o) { const float os = slist[16 * j + o]; const unsigned ok = klist[16 * j + o]; rank += (o < ncj && (os > ms || (os == ms && ok < mk))) ? 1 : 0; }
                if (rank < Rj) LDS_OR(hist + tqj * 256 + (mk >> 5), 1u << (mk & 31)); }
            asm volatile("s_waitcnt lgkmcnt(0)" ::: "memory");
        }
#pragma unroll 1
        for (int k = 0; k < ((MODE & 8) ? 4 : 0); ++k) { const int tq = 4 * wave + k; const int Nt = t0 + tq + 1;
            const int R = TOPK - p_above[tq];
            if ((slowmask >> k) & 1u) {
                unsigned cw[4]; unsigned cnt = 0;
#pragma unroll
                for (int i = 0; i < 4; ++i) { cw[i] = cmask[tq * 256 + 4 * lane + i]; cnt += __popc(cw[i]); }
                unsigned pre = cnt;
#pragma unroll
                for (int o = 1; o < 64; o <<= 1) { const unsigned y = __shfl_up(pre, o); if (lane >= o) pre += y; }
                const unsigned tot = __shfl(pre, 63); const int nc = (int)(tot < (unsigned)IX_CAP ? tot : (unsigned)IX_CAP);
                unsigned pos = pre - cnt;
#pragma unroll
                for (int i = 0; i < 4; ++i) { unsigned wbits = cw[i];
                    while (wbits) { const int bb = __ffs((int)wbits) - 1; wbits &= wbits - 1; if (pos < (unsigned)IX_CAP) klist[pos] = (unsigned)(32 * (4 * lane + i) + bb); ++pos; } }
                const float wq = 0.5f * IW[(qrow0 + tq) * 16 + (lane & 15)];
#pragma unroll 1
                for (int ii = 0; ii < 2; ++ii) { const int ci = lane + 64 * ii;
                    if (ci < nc) { const unsigned key = klist[ci]; const u32x4* kp = (const u32x4*)(IKb + (size_t)key * 64);
                        unsigned kw[32];
#pragma unroll
                        for (int c8 = 0; c8 < 8; ++c8) { const u32x4 w = kp[c8]; kw[4 * c8] = w.x; kw[4 * c8 + 1] = w.y; kw[4 * c8 + 2] = w.z; kw[4 * c8 + 3] = w.w; }
                        float sc = 0.f;
#pragma unroll
                        for (int hh = 0; hh < 17; ++hh) { const LAS u32x4* qp = (const LAS u32x4*)(Qs + (hh * 32 + tq) * IX_QROW); float d0 = 0.f, d1 = 0.f;
#pragma unroll
                            for (int c8 = 0; c8 < 8; ++c8) { const u32x4 qv = qp[c8];
                                d0 = dot2_bf16(qv.x, kw[4 * c8], d0); d1 = dot2_bf16(qv.y, kw[4 * c8 + 1], d1); d0 = dot2_bf16(qv.z, kw[4 * c8 + 2], d0); d1 = dot2_bf16(qv.w, kw[4 * c8 + 3], d1); }
                            const float dd = d0 + d1;
                            sc += hh == 16 ? dd : __builtin_bit_cast(float, __builtin_amdgcn_readlane(__builtin_bit_cast(int, wq), hh & 15)) * fabsf(dd); }
                        slist[ci] = sc; } }
#pragma unroll 1
                for (int ii = 0; ii < 2; ++ii) { const int ci = lane + 64 * ii;
                    if (ci < nc) { const float ms = slist[ci]; const unsigned mk = klist[ci]; int rank = 0;
                        for (int o = 0; o < nc; ++o) { const float os = slist[o]; const unsigned ok = klist[o]; rank += (os > ms || (os == ms && ok < mk)) ? 1 : 0; }
                        if (rank < R) LDS_OR(hist + tq * 256 + (mk >> 5), 1u << (mk & 31)); } }
            }
            unsigned wd[4]; unsigned cnt = 0;
#pragma unroll
            for (int i = 0; i < 4; ++i) { wd[i] = hist[tq * 256 + 4 * lane + i]; cnt += __popc(wd[i]); }
            unsigned pre = cnt;
#pragma unroll
            for (int o = 1; o < 64; o <<= 1) { const unsigned y = __shfl_up(pre, o); if (lane >= o) pre += y; }
            const unsigned total = __shfl(pre, 63);
            unsigned pos = pre - cnt; LAS int* olist = (LAS int*)klist;
#pragma unroll
            for (int i = 0; i < 4; ++i) { unsigned wbits = wd[i];
                while (wbits) { const int bb = __ffs((int)wbits) - 1; wbits &= wbits - 1; if (pos < (unsigned)TOPK) olist[pos] = 32 * (4 * lane + i) + bb; ++pos; } }
            asm volatile("s_waitcnt lgkmcnt(0)" ::: "memory");
            { i32x4 ov = *(const LAS i32x4*)(olist + 4 * lane); const int tl = (int)total;
                ov.x = 4 * lane + 0 < tl ? ov.x : -1; ov.y = 4 * lane + 1 < tl ? ov.y : -1; ov.z = 4 * lane + 2 < tl ? ov.z : -1; ov.w = 4 * lane + 3 < tl ? ov.w : -1;
                *((i32x4*)(IDX + (qrow0 + tq) * TOPK) + lane) = ov; }
            asm volatile("s_waitcnt lgkmcnt(0)" ::: "memory");
        }
    }
}

typedef short s16x4 __attribute__((ext_vector_type(4)));
typedef int i32x4 __attribute__((ext_vector_type(4)));
typedef __attribute__((address_space(3))) s16x4 las_s16x4;
using pg8::bf16x8;
#define MFMA16(a, b, c) __builtin_amdgcn_mfma_f32_16x16x32_bf16((a), (b), (c), 0, 0, 0)
constexpr int DS_ROW = 544, DS_IMG = 32 * DS_ROW, DS_WSTRIDE = DS_IMG + 2048, DS_BIAS = 8 * DS_WSTRIDE;
static_assert(DS_BIAS + 129 * 8 * 4 <= LDS_BYTES, "dsa LDS map");
__device__ __forceinline__ float gain_absmax(const float* g, int n, int lane) { float m = 0.f; for (int i = lane; i < n; i += 64) m = fmaxf(m, fabsf(g[i])); return wave_max(m); }

__device__ __forceinline__ void fast_dsa(Ctx& C) {
    unsigned char* ws = C.ws; const int tid = opaque_v(C.tid), lane = tid & 63, wave = C.wave;
    const bf16_t* QABS = (const bf16_t*)(ws + WS_QABS); const bf16_t* CKV = (const bf16_t*)(ws + WS_CKV); const float* KSS = (const float*)(ws + WS_KSS);
    const int* IDX = (const int*)(ws + WS_IDX); bf16_t* PC = (bf16_t*)(ws + WS_PC); const float* rel_bias = C.in[22];
    LAS unsigned char* img = C.lds + wave * DS_WSTRIDE;
    LAS int* idxs = (LAS int*)(img + DS_IMG);
    LAS unsigned* offs = (LAS unsigned*)(img + DS_IMG + 1024);
    LAS float* biasA = (LAS float*)(C.lds + DS_BIAS);
    __syncthreads();
    float bmax = 0.f;
    for (int i = tid; i < 129 * 8; i += NTHREADS) { const int dist = i >> 3, h = i & 7; const float v = h < 6 ? rel_bias[(dist < 128 ? T5_BUCKET[dist] : 31) * 18 + h] : 0.f; biasA[i] = v; }
    for (int i = lane; i < 32 * 6; i += 64) bmax = fmaxf(bmax, fabsf(rel_bias[(i / 6) * 18 + (i % 6)]));
    bmax = wave_max(bmax);
    const float bound = gain_absmax(C.in[8], 128, lane) * gain_absmax(C.in[9], 128, lane) * 11.3137085f + bmax;
    const float shift = fmaxf(0.f, bound - 30.f);
    __syncthreads();
    const int g = lane >> 4, hd = lane & 15, hq = hd & 7;
    const int xcd = C.vcu >> 5, b = xcd & 1;
    const int wl = ((xcd >> 1) * 32 + (C.vcu & 31)) * NWAVES + wave;
    const float* KSSb = KSS + (size_t)b * SEQ * 8; const bf16_t* CKVb = CKV + (size_t)b * SEQ * 256;
    i32x4 idxrow = *((const i32x4*)(IDX + ((size_t)b * SEQ + wl) * TOPK) + lane);
#pragma unroll 1
    for (int t = wl; t < SEQ; t += 1024) {
        const size_t q = (size_t)b * SEQ + t;
        { const i32x4 v = idxrow; *((LAS i32x4*)idxs + lane) = v; if (t + 1024 < SEQ) idxrow = *((const i32x4*)(IDX + (q + 1024) * TOPK) + lane);
          u32x4 o; o.x = (unsigned)(v.x < 0 ? 0 : v.x) << 9; o.y = (unsigned)(v.y < 0 ? 0 : v.y) << 9; o.z = (unsigned)(v.z < 0 ? 0 : v.z) << 9; o.w = (unsigned)(v.w < 0 ? 0 : v.w) << 9; *((LAS u32x4*)offs + lane) = o; }
        bf16x8 qb[8];
#pragma unroll
        for (int ks = 0; ks < 8; ++ks) { u32x4 w = (u32x4){0u, 0u, 0u, 0u}; if (hd < 6) w = *(const u32x4*)(QABS + q * 1536 + hd * 256 + 32 * ks + 8 * g); qb[ks] = __builtin_bit_cast(bf16x8, w); }
        f32x4 pcT[16];
#pragma unroll
        for (int rt = 0; rt < 16; ++rt) pcT[rt] = (f32x4){0.f, 0.f, 0.f, 0.f};
        float lsum = 0.f;
        u32x4 gr[16]; f32x4 ksv[2];
        const int rl = lane >> 5, cl = lane & 31;
#define DSA_GATHER(pp_) do { _Pragma("unroll") for (int i = 0; i < 16; ++i) { const unsigned ro = offs[32 * (pp_) + 2 * i + rl]; \
                gr[i] = *(const u32x4*)((const unsigned char*)CKVb + (ro + (unsigned)(cl * 16))); } \
            _Pragma("unroll") for (int tt = 0; tt < 2; ++tt) { const unsigned ro = offs[32 * (pp_) + 16 * tt + hd]; ksv[tt] = *(const f32x4*)((const unsigned char*)KSSb + ((ro >> 4) + (unsigned)(16 * (g & 1)))); } } while (0)
        DSA_GATHER(0);
#pragma unroll 1
        for (int pp = 0; pp < 8; ++pp) {
            const i32x4 kv0 = *((const LAS i32x4*)idxs + (8 * pp + g)), kv1 = *((const LAS i32x4*)idxs + (8 * pp + 4 + g));
            const int kq[8] = {kv0.x, kv0.y, kv0.z, kv0.w, kv1.x, kv1.y, kv1.z, kv1.w};
            float bv[8];
#pragma unroll
            for (int i = 0; i < 8; ++i) { const int kk = kq[i] < 0 ? 0 : kq[i]; const int dist = t - kk; bv[i] = biasA[(dist < 128 ? dist : 128) * 8 + hq]; }
#pragma unroll
            for (int i = 0; i < 16; ++i) *(LAS u32x4*)(img + (2 * i + rl) * DS_ROW + cl * 16) = gr[i];
#pragma unroll
            for (int tt = 0; tt < 2; ++tt) { f32x4 rr; rr[0] = rsqrt_f(ksv[tt][0] * (1.f / 128.f) + EPS); rr[1] = rsqrt_f(ksv[tt][1] * (1.f / 128.f) + EPS); rr[2] = rsqrt_f(ksv[tt][2] * (1.f / 128.f) + EPS); rr[3] = rsqrt_f(ksv[tt][3] * (1.f / 128.f) + EPS);
                *(LAS f32x4*)(img + (16 * tt + hd) * DS_ROW + 512 + 16 * (g & 1)) = rr; }
            asm volatile("" ::: "memory");
            if (pp < 7) DSA_GATHER(pp + 1);
            asm volatile("" ::: "memory");
            f32x4 lg[2];
#pragma unroll
            for (int tt = 0; tt < 2; ++tt) { lg[tt] = (f32x4){0.f, 0.f, 0.f, 0.f}; bf16x8 af[8];
#pragma unroll
                for (int ks = 0; ks < 8; ++ks) af[ks] = __builtin_bit_cast(bf16x8, *(const LAS u32x4*)(img + (16 * tt + hd) * DS_ROW + 64 * ks + 16 * g));
#pragma unroll
                for (int ks = 0; ks < 8; ++ks) lg[tt] = MFMA16(af[ks], qb[ks], lg[tt]); }
            float rsv[8];
#pragma unroll
            for (int i = 0; i < 8; ++i) rsv[i] = *(const LAS float*)(img + (16 * (i >> 2) + 4 * g + (i & 3)) * DS_ROW + 512 + 4 * hq);
            float p[8];
#pragma unroll
            for (int i = 0; i < 8; ++i) { const float e = __expf(lg[i >> 2][i & 3] * rsv[i] + bv[i] - shift); p[i] = kq[i] < 0 ? 0.f : e; lsum += p[i]; }
            u32x4 pw; pw.x = pg8::cvt_pk_bf16(p[0], p[1]); pw.y = pg8::cvt_pk_bf16(p[2], p[3]); pw.z = pg8::cvt_pk_bf16(p[4], p[5]); pw.w = pg8::cvt_pk_bf16(p[6], p[7]);
            const bf16x8 pb = __builtin_bit_cast(bf16x8, pw);
            const LAS unsigned char* tb = img + (4 * g + ((lane & 15) >> 2)) * DS_ROW + (lane & 3) * 8;
#pragma unroll
            for (int rh = 0; rh < 2; ++rh) { s16x4 a0[8], a1[8];
#pragma unroll
                for (int r8 = 0; r8 < 8; ++r8) { const int rt = 8 * rh + r8; a0[r8] = __builtin_amdgcn_ds_read_tr16_b64_v4i16((las_s16x4*)(tb + rt * 32)); a1[r8] = __builtin_amdgcn_ds_read_tr16_b64_v4i16((las_s16x4*)(tb + 16 * DS_ROW + rt * 32)); }
#pragma unroll
                for (int r8 = 0; r8 < 8; ++r8) { const int rt = 8 * rh + r8; const bf16x8 a = (bf16x8){a0[r8][0], a0[r8][1], a0[r8][2], a0[r8][3], a1[r8][0], a1[r8][1], a1[r8][2], a1[r8][3]};
                    pcT[rt] = MFMA16(a, pb, pcT[rt]); } }
            asm volatile("" ::: "memory");
        }
#undef DSA_GATHER
        lsum += __shfl_xor(lsum, 16); lsum += __shfl_xor(lsum, 32);
        const float linv = __builtin_amdgcn_rcpf(lsum);
        if (hd < 6) {
#pragma unroll
            for (int rt = 0; rt < 16; ++rt) { u32x2 w; w.x = pk2(pcT[rt][0] * linv, pcT[rt][1] * linv); w.y = pk2(pcT[rt][2] * linv, pcT[rt][3] * linv);
                *(u32x2*)(PC + q * 1536 + hd * 256 + 16 * rt + 4 * g) = w; } }
    }
}

template <int D, int KSTR, class F>
__device__ __forceinline__ void tile_attn_item(const LAS unsigned char* Kl, const LAS unsigned char* Vt, const u32x4 (&qf)[D / 16], int kt_lo, int kt_hi, int lane, const F& elem, f32x16 (&O)[D / 32], float& lsum) {
    const int h = lane >> 5, ql = lane & 31;
#pragma unroll
    for (int dt = 0; dt < D / 32; ++dt)
#pragma unroll
        for (int r = 0; r < 16; ++r) O[dt][r] = 0.f;
    lsum = 0.f;
#pragma unroll 1
    for (int kt = kt_lo; kt < kt_hi; ++kt) {
        f32x16 S;
#pragma unroll
        for (int r = 0; r < 16; ++r) S[r] = 0.f;
        const LAS unsigned char* kr = Kl + (32 * kt + ql) * KSTR + 16 * h;
#pragma unroll
        for (int ks = 0; ks < D / 16; ++ks) { const u32x4 ka = *(const LAS u32x4*)(kr + 32 * ks); S = MFMA32(ka, qf[ks], S); }
        float p[16];
#pragma unroll
        for (int r = 0; r < 16; ++r) { p[r] = elem(32 * kt + (r & 3) + 8 * (r >> 2) + 4 * h, S[r]); lsum += p[r]; }
        u32x4 pb[2];
#pragma unroll
        for (int s2 = 0; s2 < 2; ++s2) { pb[s2].x = pg8::cvt_pk_bf16(p[8 * s2 + 0], p[8 * s2 + 1]); pb[s2].y = pg8::cvt_pk_bf16(p[8 * s2 + 2], p[8 * s2 + 3]);
            pb[s2].z = pg8::cvt_pk_bf16(p[8 * s2 + 4], p[8 * s2 + 5]); pb[s2].w = pg8::cvt_pk_bf16(p[8 * s2 + 6], p[8 * s2 + 7]); }
#pragma unroll
        for (int dt = 0; dt < D / 32; ++dt)
#pragma unroll
            for (int s2 = 0; s2 < 2; ++s2) { const LAS unsigned char* vp = Vt + (32 * dt + ql) * 520 + (32 * kt + 16 * s2 + 4 * h) * 2;
                const u32x2 lo = *(const LAS u32x2*)vp, hi = *(const LAS u32x2*)(vp + 16);
                u32x4 va; va.x = lo.x; va.y = lo.y; va.z = hi.x; va.w = hi.y;
                O[dt] = MFMA32(va, pb[s2], O[dt]); }
    }
}

constexpr int SW_K = 0, SW_KSTR = 144, SW_VT = 256 * SW_KSTR, SW_BIAS = SW_VT + 64 * 520, SW_T = SW_BIAS + 6 * 128 * 4;
static_assert(SW_T + 8 * 32 * SW_KSTR <= LDS_BYTES - 64, "swa LDS map");
__device__ __forceinline__ void fast_swa(Ctx& C) {
    unsigned char* ws = C.ws; const int tid = opaque_v(C.tid), lane = tid & 63, wave = C.wave;
    const bf16_t* BQ = (const bf16_t*)(ws + WS_BQ); const bf16_t* BK = (const bf16_t*)(ws + WS_BK); const bf16_t* BV = (const bf16_t*)(ws + WS_BV);
    const bf16_t* GATE = (const bf16_t*)((unsigned char*)C.out + DO_GATE); bf16_t* OP = (bf16_t*)(ws + WS_OP);
    const float* sinks = C.in[12]; const float* rel_bias = C.in[22];
    LAS unsigned char* Kl = C.lds + SW_K; LAS unsigned char* Vt = C.lds + SW_VT; LAS float* bl = (LAS float*)(C.lds + SW_BIAS);
    float bmax = 0.f;
    for (int i = lane; i < 32 * 12; i += 64) bmax = fmaxf(bmax, fabsf(rel_bias[(i / 12) * 18 + 6 + (i % 12)]));
    bmax = wave_max(bmax);
    const float bound = gain_absmax(C.in[10], 64, lane) * gain_absmax(C.in[11], 64, lane) * 8.0f + bmax;
    const float shift = fmaxf(0.f, bound - 30.f);
#pragma unroll 1
    for (int u = C.vcu; u < 256; u += C.G) {
        const int b = u >> 7, g = (u >> 6) & 1, n = u & 63;
        const long s0 = (long)128 * n - 128;
        __syncthreads();
        { u32x4 kvr[4], vvr[4];
#pragma unroll
            for (int i = 0; i < 4; ++i) { const int c = tid + NTHREADS * i, kk = c >> 3, c8 = c & 7; const long sp = s0 + kk;
                kvr[i] = (u32x4){0u, 0u, 0u, 0u}; vvr[i] = (u32x4){0u, 0u, 0u, 0u};
                if (sp >= 0) { kvr[i] = *((const u32x4*)(BK + ((size_t)b * SEQ + sp) * 128 + g * 64) + c8); vvr[i] = *((const u32x4*)(BV + ((size_t)b * SEQ + sp) * 128 + g * 64) + c8); } }
#pragma unroll
            for (int i = 0; i < 4; ++i) { const int c = tid + NTHREADS * i, kk = c >> 3, c8 = c & 7;
                *(LAS u32x4*)(Kl + kk * SW_KSTR + c8 * 16) = kvr[i];
                const unsigned vw[4] = {vvr[i].x, vvr[i].y, vvr[i].z, vvr[i].w};
#pragma unroll
                for (int e = 0; e < 4; ++e) { *(LAS bf16_t*)(Vt + (c8 * 8 + 2 * e) * 520 + kk * 2) = (bf16_t)(vw[e] & 0xffff); *(LAS bf16_t*)(Vt + (c8 * 8 + 2 * e + 1) * 520 + kk * 2) = (bf16_t)(vw[e] >> 16); } } }
        for (int i = tid; i < 6 * 128; i += NTHREADS) { const int hl = i >> 7, dist = i & 127; bl[i] = rel_bias[T5_BUCKET[dist] * 18 + 6 + 6 * g + hl]; }
        __syncthreads();
#pragma unroll 1
        for (int it = wave; it < 24; it += NWAVES) {
            const int hl = it >> 2, qt = it & 3, hq = 6 * g + hl;
            const size_t qrow = (size_t)b * SEQ + 128 * n + 32 * qt + (lane & 31);
            u32x4 qf[4];
#pragma unroll
            for (int ks = 0; ks < 4; ++ks) qf[ks] = *((const u32x4*)(BQ + qrow * 768 + hq * 64) + 2 * ks + (lane >> 5));
            const int dq = 128 + 32 * qt + (lane & 31);
            const LAS float* blh = bl + hl * 128;
            auto elem = [&](int kk, float sv) -> float { const int dist = dq - kk; const bool ok = dist >= 0 && dist < 128 && (s0 + kk) >= 0;
                const float e = __expf(sv + blh[dist & 127] - shift); return ok ? e : 0.f; };
            f32x16 O[2]; float lsum;
            tile_attn_item<64, SW_KSTR>(Kl, Vt, qf, qt, qt + 5, lane, elem, O, lsum);
            lsum += __shfl_xor(lsum, 32);
            const float inv = 1.0f / (lsum + __expf(sinks[hq] - shift));
            LAS unsigned char* T = C.lds + SW_T + wave * (32 * SW_KSTR);
#pragma unroll
            for (int dt = 0; dt < 2; ++dt)
#pragma unroll
                for (int r4 = 0; r4 < 4; ++r4) { u32x2 w; w.x = pk2(O[dt][4 * r4 + 0] * inv, O[dt][4 * r4 + 1] * inv); w.y = pk2(O[dt][4 * r4 + 2] * inv, O[dt][4 * r4 + 3] * inv);
                    *(LAS u32x2*)(T + (lane & 31) * SW_KSTR + (32 * dt + 8 * r4 + 4 * (lane >> 5)) * 2) = w; }
            asm volatile("s_waitcnt lgkmcnt(0)" ::: "memory");
            const size_t qb0 = (size_t)b * SEQ + 128 * n + 32 * qt;
#pragma unroll
            for (int i = 0; i < 4; ++i) { const int rw = 8 * i + (lane >> 3), ch = lane & 7; const size_t ob = (qb0 + rw) * 2048 + 768 + hq * 64 + 8 * ch;
                const u32x4 ov = *(const LAS u32x4*)(T + rw * SW_KSTR + ch * 16); const u32x4 gw = *(const u32x4*)(GATE + ob);
                u32x2 o8;
                o8.x = pk4_fp8(16.f * bf2f(ov.x & 0xffff) * bf2f(gw.x & 0xffff), 16.f * bf2f(ov.x >> 16) * bf2f(gw.x >> 16), 16.f * bf2f(ov.y & 0xffff) * bf2f(gw.y & 0xffff), 16.f * bf2f(ov.y >> 16) * bf2f(gw.y >> 16));
                o8.y = pk4_fp8(16.f * bf2f(ov.z & 0xffff) * bf2f(gw.z & 0xffff), 16.f * bf2f(ov.z >> 16) * bf2f(gw.z >> 16), 16.f * bf2f(ov.w & 0xffff) * bf2f(gw.w & 0xffff), 16.f * bf2f(ov.w >> 16) * bf2f(gw.w >> 16));
                *(u32x2*)((unsigned char*)OP + ob) = o8; }
            asm volatile("s_waitcnt lgkmcnt(0)" ::: "memory");
        }
    }
}
constexpr int MA_K = 0, MA_KSTR = 272, MA_VT = 256 * MA_KSTR;
static_assert(MA_VT + 128 * 520 <= LDS_BYTES, "mem-attn LDS map");
__device__ __forceinline__ void fast_mem(Ctx& C) {
    unsigned char* ws = C.ws; const int tid = opaque_v(C.tid), lane = tid & 63, wave = C.wave;
    const bf16_t* CQ = (const bf16_t*)(ws + WS_CQ); const bf16_t* KC = (const bf16_t*)(ws + WS_KC); const bf16_t* VC = (const bf16_t*)(ws + WS_VC);
    const bf16_t* GATE = (const bf16_t*)((unsigned char*)C.out + DO_GATE); bf16_t* OP = (bf16_t*)(ws + WS_OP);
    LAS unsigned char* Kl = C.lds + MA_K; LAS unsigned char* Vt = C.lds + MA_VT;
    const float bound = gain_absmax(C.in[15], 128, lane) * gain_absmax(C.in[16], 128, lane) * 11.3137085f;
    const float shift = fmaxf(0.f, bound - 30.f);
#pragma unroll 1
    for (int u = C.vcu; u < 256; u += C.G) {
        const int b = u >> 7, h = (u >> 5) & 3, n = u & 31;
        __syncthreads();
        { u32x4 kvr[8], vvr[8];
#pragma unroll
            for (int i = 0; i < 8; ++i) { const int c = tid + NTHREADS * i, kk = c >> 4, c8 = c & 15;
                kvr[i] = *((const u32x4*)(KC + ((size_t)b * MEMLEN + kk) * 512 + h * 128) + c8); vvr[i] = *((const u32x4*)(VC + ((size_t)b * MEMLEN + kk) * 512 + h * 128) + c8); }
#pragma unroll
            for (int i = 0; i < 8; ++i) { const int c = tid + NTHREADS * i, kk = c >> 4, c8 = c & 15;
                *(LAS u32x4*)(Kl + kk * MA_KSTR + c8 * 16) = kvr[i];
                const unsigned vw[4] = {vvr[i].x, vvr[i].y, vvr[i].z, vvr[i].w};
#pragma unroll
                for (int e = 0; e < 4; ++e) { *(LAS bf16_t*)(Vt + (c8 * 8 + 2 * e) * 520 + kk * 2) = (bf16_t)(vw[e] & 0xffff); *(LAS bf16_t*)(Vt + (c8 * 8 + 2 * e + 1) * 520 + kk * 2) = (bf16_t)(vw[e] >> 16); } } }
        __syncthreads();
        {
            const size_t qrow = (size_t)b * SEQ + 256 * n + 32 * wave + (lane & 31);
            u32x4 qf[8];
#pragma unroll
            for (int ks = 0; ks < 8; ++ks) qf[ks] = *((const u32x4*)(CQ + qrow * 512 + h * 128) + 2 * ks + (lane >> 5));
            auto elem = [&](int, float sv) -> float { return __expf(sv - shift); };
            f32x16 O[4]; float lsum;
            tile_attn_item<128, MA_KSTR>(Kl, Vt, qf, 0, 8, lane, elem, O, lsum);
            lsum += __shfl_xor(lsum, 32);
            const float inv = 1.0f / lsum;
            __syncthreads();
            LAS unsigned char* T = C.lds + wave * (32 * MA_KSTR);
#pragma unroll
            for (int dt = 0; dt < 4; ++dt)
#pragma unroll
                for (int r4 = 0; r4 < 4; ++r4) { u32x2 w; w.x = pk2(O[dt][4 * r4 + 0] * inv, O[dt][4 * r4 + 1] * inv); w.y = pk2(O[dt][4 * r4 + 2] * inv, O[dt][4 * r4 + 3] * inv);
                    *(LAS u32x2*)(T + (lane & 31) * MA_KSTR + (32 * dt + 8 * r4 + 4 * (lane >> 5)) * 2) = w; }
            asm volatile("s_waitcnt lgkmcnt(0)" ::: "memory");
            const size_t qb0 = (size_t)b * SEQ + 256 * n + 32 * wave;
#pragma unroll
            for (int i = 0; i < 8; ++i) { const int rw = 4 * i + (lane >> 4), ch = lane & 15; const size_t ob = (qb0 + rw) * 2048 + 1536 + h * 128 + 8 * ch;
                const u32x4 ov = *(const LAS u32x4*)(T + rw * MA_KSTR + ch * 16); const u32x4 gw = *(const u32x4*)(GATE + ob);
                u32x2 o8;
                o8.x = pk4_fp8(16.f * bf2f(ov.x & 0xffff) * bf2f(gw.x & 0xffff), 16.f * bf2f(ov.x >> 16) * bf2f(gw.x >> 16), 16.f * bf2f(ov.y & 0xffff) * bf2f(gw.y & 0xffff), 16.f * bf2f(ov.y >> 16) * bf2f(gw.y >> 16));
                o8.y = pk4_fp8(16.f * bf2f(ov.z & 0xffff) * bf2f(gw.z & 0xffff), 16.f * bf2f(ov.z >> 16) * bf2f(gw.z >> 16), 16.f * bf2f(ov.w & 0xffff) * bf2f(gw.w & 0xffff), 16.f * bf2f(ov.w >> 16) * bf2f(gw.w >> 16));
                *(u32x2*)((unsigned char*)OP + ob) = o8; }
        }
    }
}

__global__ void __launch_bounds__(NTHREADS, 2) mk_fwd(Args args) {
    extern __shared__ __attribute__((aligned(16))) unsigned char lds_raw[];
    Ctx C;
    C.in = args.in;
    C.out = args.out; C.ws = args.ws;
    C.lds = (LAS unsigned char*)lds_raw;
    C.tid = threadIdx.x; C.lane = C.tid & 63; C.wave = __builtin_amdgcn_readfirstlane(C.tid >> 6);
    C.G = gridDim.x; { const int bx = blockIdx.x; C.vcu = (C.G % 8 == 0) ? (bx % 8) * (C.G / 8) + bx / 8 : bx; }
    cg::grid_group grid = cg::this_grid();
    volatile LAS unsigned* bst = (volatile LAS unsigned*)(C.lds + LDS_BYTES - 64);
    if (C.tid < 16) bst[C.tid] = 0u;
    __syncthreads();
    if (blockIdx.x == 0) { unsigned* bw = (unsigned*)(args.ws + WS_CTL); for (int i = C.tid; i < XCD_BAR_WORDS; i += NTHREADS) bw[i] = 0u; }
    XcdBarrier xbar;
    const int lo = args.ph_lo, hi = args.ph_hi;
    unsigned char* ws = C.ws;
#ifndef PHMASK
#define PHMASK 0x7f
#endif
#define IN(k) (((PHMASK >> (k)) & 1) && lo <= (k) && (k) < hi)
#define SEAM(k) do { if (IN(k) && IN((k) + 1)) { if ((k) == 0) grid.sync(); else xcd_barrier(xbar); } } while (0)
    const int bx = (int)blockIdx.x;

    if (IN(0)) { p0_prologue(C); }
    grid.sync();
    xbar = xcd_barrier_post((unsigned*)(args.ws + WS_CTL), bst);
    if (IN(1)) {
        EpiIn E{C.lds, ws, (unsigned char*)C.out, C.in, 0, 1};
        { pg8::Gemm g{(const bf16_t*)(ws + WS_H), (const bf16_t*)(ws + WS_WINT), M, NWIN_A, 2048, 2048, 2048, 0}; pg8::StaticOrder S; S.init(M, NWIN_A, C.G, bx);
          pg8::gemm_phase<EpiIn, pg8::StaticOrder>(C.lds, g, S, E); }
        {
          pg8::Gemm g{(const bf16_t*)(ws + WS_H8), (const bf16_t*)(ws + WS_WMIX8), M, NWIN_B, 2048, 2048, 2048, 0}; pg8::StaticOrder S; S.init(M, NWIN_B, C.G, bx);
          E.pnoff = 2;
          pg8::gemm_phase<EpiIn, pg8::StaticOrder, true, true, true>(C.lds, g, S, E); E.pnoff = 0; }
        { E.memkv = 1; pg8::Gemm g{(const bf16_t*)(ws + WS_MEMN), (const bf16_t*)(ws + WS_WMEMT), BATCH * MEMLEN, 1024, 2048, 2048, 2048, 0}; pg8::StaticOrder S; S.init(BATCH * MEMLEN, 1024, C.G, (bx + 64) % C.G);
          pg8::gemm_phase<EpiIn, pg8::StaticOrder>(C.lds, g, S, E); }
    }
    SEAM(1);
    if (IN(2)) {
        { pg8::Gemm g{(const bf16_t*)(ws + WS_CKV), (const bf16_t*)(ws + WS_WKT), M, 768, 256, 256, 256, 0}; pg8::StaticOrder S; S.init(M, 768, C.G, bx);
          EpiKss E{(float*)(ws + WS_KSS)};
          pg8::gemm_phase<EpiKss, pg8::StaticOrder>(C.lds, g, S, E); }
        { int kq = 128; asm volatile("" : "+s"(kq));
          pg8::Gemm g{(const bf16_t*)(ws + WS_QA), (const bf16_t*)(ws + WS_WQBD), M, 1536, kq, 768, 128, 128}; pg8::StaticOrder S; S.init(M, 1536, C.G, bx);
          EpiBf E{(bf16_t*)(ws + WS_QABS), 1536};
          pg8::gemm_phase<EpiBf, pg8::StaticOrder>(C.lds, g, S, E); }
        fast_indexer<15>(C, (int*)(ws + WS_IDX));
        __syncthreads();
        fast_swa(C);
        __syncthreads();
        fast_mem(C);
    }
    SEAM(2);
    if (IN(3)) { fast_dsa(C); }
    SEAM(3);
    if (IN(4)) {
        pg8::Gemm g{(const bf16_t*)(ws + WS_PC), (const bf16_t*)(ws + WS_WVBD), M, 768, 512, 1536, 512, 512}; pg8::StaticOrder S; S.init(M, 768, C.G, bx);
        EpiGateMul E{(bf16_t*)(ws + WS_OP), (const bf16_t*)((unsigned char*)C.out + DO_GATE)};
        pg8::gemm_phase<EpiGateMul, pg8::StaticOrder>(C.lds, g, S, E);
    }
    SEAM(4);
    if (IN(5)) {
        pg8::Gemm g{(const bf16_t*)(ws + WS_OP), (const bf16_t*)(ws + WS_WUPT), M, 2048, 2048, 2048, 2048, 0, 0x7b7b7b7b, 0x7a7a7a7a}; pg8::StaticOrder S; S.init(M, 2048, C.G, bx);
        EpiMerge E{(bf16_t*)(ws + WS_MERGED), (const bf16_t*)(ws + WS_BIG), 6, 12};
        pg8::gemm_phase<EpiMerge, pg8::StaticOrder, true, true, true>(C.lds, g, S, E);
    }
    SEAM(5);
    if (IN(6)) {
        pg8::Gemm g{(const bf16_t*)(ws + WS_MERGED), (const bf16_t*)(ws + WS_WOT), M, 2048, 2048, 2048, 2048, 0, 0x7b7b7b7b, 0x79797979}; pg8::StaticOrder S; S.init(M, 2048, C.G, bx);
        EpiOut E{C.out, C.in[0]};
        pg8::gemm_phase<EpiOut, pg8::StaticOrder, true, true, true>(C.lds, g, S, E);
    }
#undef IN
#undef SEAM
}

extern "C" void kernel_launch(void* const* d_in, const int* in_sizes, int n_in, void* d_out, int out_size, void* d_ws, size_t ws_size, hipStream_t stream) {
    static int grid = 0;
    if (grid == 0) {
        if (n_in != 23 || out_size != M * DM || ws_size < WS_END) { fprintf(stderr, "kernel_launch: unexpected shapes (n_in %d out %d ws %zu)\n", n_in, out_size, ws_size); grid = -1; return; }
        int dev = 0, cus = 0, per_cu = 0;
        hipGetDevice(&dev); hipDeviceGetAttribute(&cus, hipDeviceAttributeMultiprocessorCount, dev);
        hipFuncSetAttribute((const void*)mk_fwd, hipFuncAttributeMaxDynamicSharedMemorySize, LDS_BYTES);
        hipOccupancyMaxActiveBlocksPerMultiprocessor(&per_cu, (const void*)mk_fwd, NTHREADS, LDS_BYTES);
        if (per_cu < 1) { fprintf(stderr, "kernel_launch: occupancy query says %d blocks/CU\n", per_cu); per_cu = 1; }
        (void)hipGetLastError();
        grid = cus;
    }
    if (grid < 0) return;
    Args a{};
    for (int i = 0; i < 23; ++i) a.in[i] = (const float*)d_in[i];
    a.out = (float*)d_out; a.ws = (unsigned char*)d_ws;
#if MK_SINGLE
    a.ph_lo = 0; a.ph_hi = 7; a.single = 1;
    void* kargs[] = {&a};
    hipError_t e = hipLaunchCooperativeKernel((const void*)mk_fwd, dim3(grid), dim3(NTHREADS), kargs, LDS_BYTES, stream);
    if (e != hipSuccess) fprintf(stderr, "cooperative launch failed: %s (grid %d)\n", hipGetErrorString(e), grid);
#else
    for (int p = 0; p < 7; ++p) { a.ph_lo = p; a.ph_hi = p + 1; a.single = 0;
        hipLaunchKernelGGL(mk_fwd, dim3(grid), dim3(NTHREADS), LDS_BYTES, stream, a); }
#endif
}
```

```cpp
#include <hip/hip_runtime.h>
#include <hip/hip_cooperative_groups.h>
#include <cstdio>
#include <cstdint>
namespace cg = cooperative_groups;

#ifndef MK_SINGLE
#define MK_SINGLE 1
#endif

namespace pg8 {
#define PG8_LAS __attribute__((address_space(3)))
typedef unsigned short bf16_t;
typedef short bf16x8 __attribute__((ext_vector_type(8)));
typedef float f32x4 __attribute__((ext_vector_type(4)));
typedef unsigned u32x4 __attribute__((ext_vector_type(4)));
typedef unsigned u32x2 __attribute__((ext_vector_type(2)));
constexpr int BM = 256, BK = 64, HALF = 128, HTB = HALF * BK * 2, STAGE_BYTES = 8 * HTB, NXCD = 8, WGM = 2;

__host__ __device__ __forceinline__ int lds_byte(int r, int c) { const int st = (r >> 4) * 2 + (c >> 5), rr = r & 15, cc = c & 31, ob = rr * 64 + cc * 2; return st * 1024 + (ob ^ (((ob >> 9) & 1) << 5)); }
__host__ __device__ __forceinline__ void stage_rc(int b, int& R, int& C) { const int st = b / 1024, sb = b % 1024, swz = sb ^ (((sb >> 9) & 1) << 5); R = (st >> 1) * 16 + swz / 64; C = (st & 1) * 32 + (swz % 64) / 2; }
__host__ __device__ __forceinline__ int perm32(int rho) { const int n = rho >> 4, i = rho & 15; return 8 * (i >> 2) + 4 * n + (i & 3); }

struct Unit { int pm, pn; };
struct Gemm { const bf16_t* A; const bf16_t* Bt; int M, N, K, lda, ldb, akoff; int sca = 0x7f7f7f7f, scb = 0x79797979; };

struct StaticOrder {
    int nM, nN, nwg, G, c;
    __host__ __device__ void init(int M, int N, int G_, int c_) { nM = M / BM; nN = N / BM; nwg = nM * nN; G = G_; c = c_; }
    __host__ __device__ bool next(int i, Unit& u) const {
        const long L = (long)i * G + c; if (L >= nwg) return false;
        int wgid = (int)L; { const int q = nwg / NXCD, r = nwg % NXCD, xcd = wgid % NXCD, off = wgid / NXCD; wgid = (xcd < r ? xcd * (q + 1) : r * (q + 1) + (xcd - r) * q) + off; }
        const int nig = WGM * nN, gid = wgid / nig, fm = gid * WGM, gsz = (nM - fm) < WGM ? (nM - fm) : WGM;
        u.pm = fm + ((wgid % nig) % gsz); u.pn = (wgid % nig) / gsz; return true;
    }
    __device__ __forceinline__ void a_ready(const Unit&) const {}
    __device__ __forceinline__ void done(const Unit&) const {}
};

typedef int i32x8 __attribute__((ext_vector_type(8)));
typedef int i32x4v __attribute__((ext_vector_type(4)));
__device__ __forceinline__ unsigned cvt_pk_bf16(float lo, float hi) { unsigned r; asm volatile("v_cvt_pk_bf16_f32 %0, %1, %2" : "=v"(r) : "v"(lo), "v"(hi)); return r; }

template <class Epi, class Sched, bool ALIGN_EPI = true, bool SP2 = true, bool F8 = false>
__device__ __forceinline__ void gemm_phase(PG8_LAS unsigned char* lds, const Gemm g, const Sched& S, const Epi& E) {
    const int tid = threadIdx.x, wid = __builtin_amdgcn_readfirstlane(tid >> 6), lane = tid & 63, wr = wid >> 2, wc = wid & 3, fr = lane & 15, fq = lane >> 4;
    constexpr int ES = F8 ? 1 : 2;
    const int nt = g.K / (F8 ? 2 * BK : BK);
    unsigned voffA[2], voffB[2];
#pragma unroll
    for (int i = 0; i < 2; ++i) { int R, C; stage_rc(tid * 16 + i * 8192, R, C); const int Rb = Epi::PERM ? ((R & ~31) + perm32(R & 31)) : R;
        voffA[i] = (unsigned)(R * g.lda * ES + C * 2); voffB[i] = (unsigned)(Rb * g.ldb * ES + C * 2); }
    const size_t kstep = (size_t)(BK * 2);
    const size_t hstepA = (size_t)HALF * g.lda * ES, hstepB = (size_t)HALF * g.ldb * ES;
    const size_t tstepA = 2 * hstepA, tstepB = 2 * hstepB;
    const unsigned ldsw = (unsigned)wid * 1024u;
    const int aoff = F8 ? lds_byte(wr * 64 + fr, (fq >> 1) * 32 + (fq & 1) * 16) : lds_byte(wr * 64 + fr, fq * 8), boff = F8 ? lds_byte(wc * 32 + fr, (fq >> 1) * 32 + (fq & 1) * 16) : lds_byte(wc * 32 + fr, fq * 8);
#define PG8_SA(b, h) (((b) * 2 + (h)) * HTB)
#define PG8_SB(b, h) ((4 + (b) * 2 + (h)) * HTB)
#define PG8_STAGE(bufoff, gbase, voff) do { _Pragma("unroll") for (int _i = 0; _i < 2; ++_i) \
        __builtin_amdgcn_global_load_lds((const unsigned*)((const char*)(gbase) + (voff)[_i]), (PG8_LAS unsigned*)(lds + (bufoff) + ldsw + _i * 8192), 16, 0, 0); } while (0)
#define PG8_LD8(p) __builtin_shufflevector(*(const PG8_LAS i32x4v*)(p), *(const PG8_LAS i32x4v*)((p) + 16), 0, 1, 2, 3, 4, 5, 6, 7)
#define PG8_LDA(dst, b, h) do { _Pragma("unroll") for (int m = 0; m < 4; ++m) { if constexpr (F8) dst##8[m] = PG8_LD8(lds + PG8_SA(b, h) + aoff + m * 2048); else { _Pragma("unroll") for (int k = 0; k < 2; ++k) dst[m][k] = *(const PG8_LAS bf16x8*)(lds + PG8_SA(b, h) + aoff + m * 2048 + k * 1024); } } } while (0)
#define PG8_LDB(dst, b, h) do { _Pragma("unroll") for (int n = 0; n < 2; ++n) { if constexpr (F8) dst##8[n] = PG8_LD8(lds + PG8_SB(b, h) + boff + n * 2048); else { _Pragma("unroll") for (int k = 0; k < 2; ++k) dst[n][k] = *(const PG8_LAS bf16x8*)(lds + PG8_SB(b, h) + boff + n * 2048 + k * 1024); } } } while (0)
#define PG8_MMA(ai, bj, At, Bt) do { __builtin_amdgcn_s_setprio(1); _Pragma("unroll") for (int m = 0; m < 4; ++m) _Pragma("unroll") for (int n = 0; n < 2; ++n) { \
        if constexpr (F8) { asm volatile("s_nop 1\n\tv_mfma_scale_f32_16x16x128_f8f6f4 %0, %1, %2, %0, %3, %4 op_sel_hi:[0,0,0]" : "+v"(acc[ai][bj][m][n]) : "v"(Bt##8[n]), "v"(At##8[m]), "v"(sc_b), "v"(sc_a)); } \
        else { _Pragma("unroll") for (int k = 0; k < 2; ++k) acc[ai][bj][m][n] = __builtin_amdgcn_mfma_f32_16x16x32_bf16(Bt[n][k], At[m][k], acc[ai][bj][m][n], 0, 0, 0); } } \
        if constexpr (F8) asm volatile("s_nop 7" ::: "memory"); __builtin_amdgcn_s_setprio(0); } while (0)
#define PG8_WAIT_V(n) asm volatile("s_waitcnt vmcnt(" #n ")" ::: "memory")
#define PG8_WAIT_L(n) asm volatile("s_waitcnt lgkmcnt(" #n ")" ::: "memory")
#define PG8_BAR __builtin_amdgcn_s_barrier()
#define PG8_SCHED __builtin_amdgcn_sched_barrier(0)
    Unit cur, nxt; int ui = 0;
    if (!S.next(0, cur)) return;
    f32x4 acc[2][2][4][2];
#pragma unroll
    for (int a = 0; a < 2; ++a)
#pragma unroll
        for (int b = 0; b < 2; ++b)
#pragma unroll
            for (int m = 0; m < 4; ++m)
#pragma unroll
                for (int n = 0; n < 2; ++n) acc[a][b][m][n] = (f32x4){0.f, 0.f, 0.f, 0.f};
    if constexpr (F8) { _Pragma("unroll") for (int a = 0; a < 2; ++a) _Pragma("unroll") for (int b = 0; b < 2; ++b)
        asm volatile("s_nop 7" : "+v"(acc[a][b][0][0]), "+v"(acc[a][b][0][1]), "+v"(acc[a][b][1][0]), "+v"(acc[a][b][1][1]), "+v"(acc[a][b][2][0]), "+v"(acc[a][b][2][1]), "+v"(acc[a][b][3][0]), "+v"(acc[a][b][3][1])); }
    bf16x8 At[4][2], B0[2][2], B1[2][2]; i32x8 At8[4], B08[2], B18[2];
    int sc_a = g.sca, sc_b = g.scb;
    asm volatile("" : "+v"(sc_a), "+v"(sc_b));
    const char* cA = (const char*)g.A + (size_t)cur.pm * tstepA + (size_t)cur.pn * g.akoff * ES; const char* cB = (const char*)g.Bt + (size_t)cur.pn * tstepB;
    S.a_ready(cur);
    if constexpr (SP2) {
        PG8_STAGE(PG8_SB(0, 0), cB, voffB); PG8_STAGE(PG8_SB(0, 1), cB + hstepB, voffB); PG8_STAGE(PG8_SA(0, 0), cA, voffA); PG8_STAGE(PG8_SA(0, 1), cA + hstepA, voffA);
        if (wr == 1) PG8_BAR;
        PG8_WAIT_V(2); PG8_BAR;
        PG8_STAGE(PG8_SB(1, 0), cB + kstep, voffB); PG8_STAGE(PG8_SA(1, 0), cA + kstep, voffA); PG8_STAGE(PG8_SB(1, 1), cB + hstepB + kstep, voffB);
        PG8_WAIT_V(6); PG8_BAR;
    } else {
        PG8_STAGE(PG8_SB(0, 0), cB, voffB); PG8_STAGE(PG8_SA(0, 0), cA, voffA); PG8_STAGE(PG8_SB(0, 1), cB + hstepB, voffB); PG8_STAGE(PG8_SA(0, 1), cA + hstepA, voffA);
        if (wr == 1) PG8_BAR;
        PG8_WAIT_V(4); PG8_BAR;
        PG8_STAGE(PG8_SB(1, 0), cB + kstep, voffB); PG8_STAGE(PG8_SA(1, 0), cA + kstep, voffA); PG8_STAGE(PG8_SB(1, 1), cB + hstepB + kstep, voffB);
        PG8_WAIT_V(6); PG8_BAR;
    }
    for (;;) {
        const bool has_next = S.next(ui + 1, nxt);
        const char* nA = has_next ? (const char*)g.A + (size_t)nxt.pm * tstepA + (size_t)nxt.pn * g.akoff * ES : cA; const char* nB = has_next ? (const char*)g.Bt + (size_t)nxt.pn * tstepB : cB;
#pragma unroll 1
        for (int t = 0; t < nt; t += 2) {
            const bool last = (t == nt - 2);
            const char* a1 = cA + (size_t)(t + 1) * kstep;
            const char* a2 = last ? nA : cA + (size_t)(t + 2) * kstep; const char* b2 = last ? nB : cB + (size_t)(t + 2) * kstep;
            const char* a3 = a2 + kstep; const char* b3 = b2 + kstep;
            if (last && has_next) S.a_ready(nxt);
            if constexpr (Epi::HAS_MID) { if (t == E.mid_t0 || t == E.mid_t1) E.mid(acc, cur, t, wr, wc, fr, fq); }
            if constexpr (SP2) {
            PG8_LDB(B0, 0, 0); PG8_LDB(B1, 0, 1); PG8_SCHED; PG8_LDA(At, 0, 0); PG8_STAGE(PG8_SA(1, 1), a1 + hstepA, voffA);
            PG8_WAIT_V(8); PG8_WAIT_L(0); PG8_BAR; PG8_MMA(0, 0, At, B0); PG8_MMA(0, 1, At, B1); PG8_BAR; PG8_SCHED;
            PG8_LDA(At, 0, 1); PG8_STAGE(PG8_SB(0, 0), b2, voffB); PG8_STAGE(PG8_SB(0, 1), b2 + hstepB, voffB); PG8_STAGE(PG8_SA(0, 0), a2, voffA);
            PG8_WAIT_V(8); PG8_WAIT_L(0); PG8_BAR; PG8_MMA(1, 0, At, B0); PG8_MMA(1, 1, At, B1); PG8_BAR; PG8_SCHED;
            PG8_LDB(B0, 1, 0); PG8_LDB(B1, 1, 1); PG8_SCHED; PG8_LDA(At, 1, 0); PG8_STAGE(PG8_SA(0, 1), a2 + hstepA, voffA);
            PG8_WAIT_V(8); PG8_WAIT_L(0); PG8_BAR; PG8_MMA(0, 0, At, B0); PG8_MMA(0, 1, At, B1); PG8_BAR; PG8_SCHED;
            PG8_LDA(At, 1, 1); PG8_STAGE(PG8_SB(1, 0), b3, voffB); PG8_STAGE(PG8_SB(1, 1), b3 + hstepB, voffB); PG8_STAGE(PG8_SA(1, 0), a3, voffA);
            PG8_WAIT_V(8); PG8_WAIT_L(0); PG8_BAR; PG8_MMA(1, 0, At, B0); PG8_MMA(1, 1, At, B1); PG8_BAR; PG8_SCHED;
            } else {
            PG8_LDB(B0, 0, 0); PG8_SCHED; PG8_LDA(At, 0, 0); PG8_STAGE(PG8_SA(1, 1), a1 + hstepA, voffA);
            PG8_WAIT_L(8); PG8_BAR; PG8_WAIT_L(0); PG8_MMA(0, 0, At, B0); PG8_BAR; PG8_SCHED;
            PG8_LDB(B1, 0, 1); PG8_STAGE(PG8_SB(0, 0), b2, voffB);
            PG8_BAR; PG8_WAIT_L(0); PG8_MMA(0, 1, At, B1); PG8_BAR;
            PG8_LDA(At, 0, 1); PG8_STAGE(PG8_SA(0, 0), a2, voffA);
            PG8_BAR; PG8_WAIT_L(0); PG8_MMA(1, 0, At, B0); PG8_BAR; PG8_SCHED;
            PG8_STAGE(PG8_SB(0, 1), b2 + hstepB, voffB);
            PG8_WAIT_V(6); PG8_BAR; PG8_MMA(1, 1, At, B1); PG8_BAR;
            PG8_LDB(B0, 1, 0); PG8_SCHED; PG8_LDA(At, 1, 0); PG8_STAGE(PG8_SA(0, 1), a2 + hstepA, voffA);
            PG8_WAIT_L(8); PG8_BAR; PG8_WAIT_L(0); PG8_MMA(0, 0, At, B0); PG8_BAR; PG8_SCHED;
            PG8_LDB(B1, 1, 1); PG8_STAGE(PG8_SB(1, 0), b3, voffB);
            PG8_BAR; PG8_WAIT_L(0); PG8_MMA(0, 1, At, B1); PG8_BAR;
            PG8_LDA(At, 1, 1); PG8_STAGE(PG8_SA(1, 0), a3, voffA);
            PG8_BAR; PG8_WAIT_L(0); PG8_MMA(1, 0, At, B0); PG8_BAR; PG8_SCHED;
            PG8_STAGE(PG8_SB(1, 1), b3 + hstepB, voffB);
            PG8_WAIT_V(6); PG8_BAR; PG8_MMA(1, 1, At, B1); PG8_BAR;
            }
        }
        if constexpr (ALIGN_EPI) { if (wr == 0) PG8_BAR; }
        if constexpr (F8) { _Pragma("unroll") for (int a = 0; a < 2; ++a) _Pragma("unroll") for (int b = 0; b < 2; ++b)
            asm volatile("s_nop 15\n\ts_nop 15" : "+v"(acc[a][b][0][0]), "+v"(acc[a][b][0][1]), "+v"(acc[a][b][1][0]), "+v"(acc[a][b][1][1]), "+v"(acc[a][b][2][0]), "+v"(acc[a][b][2][1]), "+v"(acc[a][b][3][0]), "+v"(acc[a][b][3][1])); }
        E(acc, cur, wr, wc, fr, fq);
        if (!has_next) break;
#pragma unroll
        for (int a = 0; a < 2; ++a)
#pragma unroll
            for (int b = 0; b < 2; ++b)
#pragma unroll
                for (int m = 0; m < 4; ++m)
#pragma unroll
                    for (int n = 0; n < 2; ++n) acc[a][b][m][n] = (f32x4){0.f, 0.f, 0.f, 0.f};
        if constexpr (F8) { _Pragma("unroll") for (int a = 0; a < 2; ++a) _Pragma("unroll") for (int b = 0; b < 2; ++b)
        asm volatile("s_nop 7" : "+v"(acc[a][b][0][0]), "+v"(acc[a][b][0][1]), "+v"(acc[a][b][1][0]), "+v"(acc[a][b][1][1]), "+v"(acc[a][b][2][0]), "+v"(acc[a][b][2][1]), "+v"(acc[a][b][3][0]), "+v"(acc[a][b][3][1])); }
        cur = nxt; cA = nA; cB = nB; ++ui;
        if constexpr (ALIGN_EPI) { if (wr == 1) PG8_BAR; }
    }
    PG8_WAIT_V(0);
    if constexpr (!ALIGN_EPI) { if (wr == 0) PG8_BAR; }
    PG8_BAR;
#undef PG8_SA
#undef PG8_SB
#undef PG8_STAGE
#undef PG8_LDA
#undef PG8_LDB
#undef PG8_MMA
#undef PG8_WAIT_V
#undef PG8_WAIT_L
#undef PG8_BAR
#undef PG8_SCHED
}
}

using pg8::bf16_t; using pg8::f32x4; using pg8::u32x4; using pg8::u32x2;
#define LAS __attribute__((address_space(3)))
constexpr int BATCH = 2, SEQ = 8192, DM = 2048, M = BATCH * SEQ, MEMLEN = 256;
constexpr int IN_COLS = 11856, NWIN = 12032, NWIN_A = 1792, NWIN_B = 10240;
constexpr int RAWW = 2816;
constexpr int TOPK = 256;
constexpr float EPS = 1e-6f;
constexpr int NWAVES = 8, NTHREADS = 512;
constexpr int LDS_BYTES = 163840;
constexpr int NPH = 8;

constexpr size_t MiB = 1u << 20;
constexpr size_t WS_CTL = 0;
constexpr size_t WS_WMEMT = 1 * MiB, WS_WKT = 5 * MiB, WS_WQBD = 6 * MiB, WS_WVBD = 9 * MiB, WS_WUPT = 12 * MiB, WS_WOT = 20 * MiB;
constexpr size_t WS_WINT = 28 * MiB;
constexpr size_t WS_QABS = WS_WINT;
constexpr size_t WS_WMIX8 = WS_WINT + 16 * MiB;
constexpr size_t WS_H = 76 * MiB;
constexpr size_t WS_OP = WS_H;
constexpr size_t WS_BIG = 140 * MiB;
constexpr size_t WS_QA = 332 * MiB, WS_CKV = 356 * MiB, WS_IK = 364 * MiB, WS_IW = 366 * MiB, WS_BQ = 367 * MiB, WS_BK = 391 * MiB, WS_BV = 395 * MiB, WS_CQ = 399 * MiB;
constexpr size_t WS_KC = 415 * MiB, WS_VC = 416 * MiB, WS_KSS = 417 * MiB;
constexpr size_t WS_MERGED = 332 * MiB;
constexpr size_t WS_H8 = 438 * MiB;
constexpr size_t WS_MEMN = 418 * MiB, WS_RAWM = 420 * MiB, WS_IDX = 422 * MiB, WS_PC = 438 * MiB, WS_END = 486 * MiB;
constexpr size_t DO_GATE = 0, DO_IQ = 64 * MiB;

__device__ const unsigned char T5_BUCKET[128] = {
0,1,2,3,4,5,6,7,8,9,10,11,12,13,14,15,16,16,16,17,17,18,18,18,19,19,19,20,20,20,20,21,21,21,21,22,22,22,22,22,23,23,23,23,23,23,24,24,24,24,24,24,25,25,25,25,25,25,25,26,26,26,26,26,26,26,26,27,27,27,27,27,27,27,27,27,27,28,28,28,28,28,28,28,28,28,28,29,29,29,29,29,29,29,29,29,29,29,29,30,30,30,30,30,30,30,30,30,30,30,30,30,30,31,31,31,31,31,31,31,31,31,31,31,31,31,31,31};

__device__ __forceinline__ float bf2f(unsigned short b) { return __uint_as_float(((unsigned)b) << 16); }
__device__ __forceinline__ unsigned f2bf(float f) { unsigned u = __float_as_uint(f); return (u + 0x7fffu + ((u >> 16) & 1u)) >> 16; }
__device__ __forceinline__ unsigned pk2(float lo, float hi) { return pg8::cvt_pk_bf16(lo, hi); }
__device__ __forceinline__ float wave_sum(float v) {
#pragma unroll
    for (int o = 1; o < 64; o <<= 1) v += __shfl_xor(v, o);
    return v;
}
__device__ __forceinline__ unsigned wave_iscan(unsigned v) {
    int x = (int)v;
    x += __builtin_amdgcn_update_dpp(0, x, 0x111, 0xf, 0xf, false);
    x += __builtin_amdgcn_update_dpp(0, x, 0x112, 0xf, 0xf, false);
    x += __builtin_amdgcn_update_dpp(0, x, 0x114, 0xf, 0xf, false);
    x += __builtin_amdgcn_update_dpp(0, x, 0x118, 0xf, 0xf, false);
    x += __builtin_amdgcn_update_dpp(0, x, 0x142, 0xa, 0xf, false);
    x += __builtin_amdgcn_update_dpp(0, x, 0x143, 0xc, 0xf, false);
    return (unsigned)x;
}
__device__ __forceinline__ float wave_max(float v) {
#pragma unroll
    for (int o = 1; o < 64; o <<= 1) v = fmaxf(v, __shfl_xor(v, o));
    return v;
}
__device__ __forceinline__ int opaque_v(int v) { asm volatile("" : "+v"(v)); return v; }
__device__ __forceinline__ float sigmoid_f(float v) { return __builtin_amdgcn_rcpf(1.f + __builtin_amdgcn_exp2f(v * -1.4426950408889634f)); }
__device__ __forceinline__ float silu_f(float v) { return v * sigmoid_f(v); }
__device__ __forceinline__ float einv_f(float v) { return fminf(1.f + __builtin_amdgcn_exp2f(v * -1.4426950408889634f), 1e20f); }
__device__ __forceinline__ float rsqrt_f(float v) { return __builtin_amdgcn_rsqf(v); }

struct Args { const float* in[23]; float* out; unsigned char* ws; int ph_lo, ph_hi, single, pad; };
struct Ctx {
    const float* const* in; float* out; unsigned char* ws;
    LAS unsigned char* lds; int tid, lane, wave, vcu, G;
};

#define GAS __attribute__((address_space(1)))
#define XB_TMO      128
#define XB_XCNT(j)  (256  + 64 * (j))
#define XB_XSUB(j)  (1280 + 64 * (j))
#define XB_XGEN(j)  (2304 + 64 * (j))
#define XB_TOP      3328
#define XB_TOPGEN   3392
#define XCD_BAR_WORDS 3456
#define XB_SPIN_CAP (1u << 22)
__device__ __forceinline__ unsigned xb_ld(unsigned* p)              { return __hip_atomic_load(p, __ATOMIC_RELAXED, __HIP_MEMORY_SCOPE_AGENT); }
__device__ __forceinline__ unsigned xb_add(unsigned* p, unsigned v) { return __hip_atomic_fetch_add(p, v, __ATOMIC_RELAXED, __HIP_MEMORY_SCOPE_AGENT); }
__device__ __forceinline__ unsigned xb_xcc_id() { return (unsigned)__builtin_amdgcn_s_getreg((3 << 11) | 20) & 0xFu; }
#define XB_SPIN(cond, bar) do { unsigned _sp = 0; while (cond) { __builtin_amdgcn_s_sleep(1); \
    if ((++_sp & 255u) == 0u) { if (xb_ld(&(bar)[XB_TMO])) break; if (_sp > XB_SPIN_CAP) { atomicAdd(&(bar)[XB_TMO], 1u); break; } } } } while (0)
struct XcdBarrier { unsigned* bar; unsigned x; volatile LAS unsigned* st; };
__device__ __forceinline__ XcdBarrier xcd_barrier_post(unsigned* bar, volatile LAS unsigned* st) {
    XcdBarrier b; b.bar = bar; b.x = xb_xcc_id(); b.st = st;
    if (threadIdx.x == 0) (void)xb_add(&bar[XB_XCNT(b.x)], 1u);
    return b;
}
__device__ __forceinline__ void xcd_barrier_complete(unsigned* bar, unsigned x, unsigned& nloc, unsigned& nx) {
    const unsigned G = gridDim.x * gridDim.y * gridDim.z;
    unsigned sum, cnt, mine, sp = 0u;
    for (;;) {
        sum = 0u; cnt = 0u; mine = 0u;
#pragma unroll
        for (unsigned j = 0; j < 16; ++j) { const unsigned c = xb_ld(&bar[XB_XCNT(j)]); sum += c; cnt += (c > 0u) ? 1u : 0u; mine = (j == x) ? c : mine; }
        if (sum == G) break;
        __builtin_amdgcn_s_sleep(1);
        if ((++sp & 255u) == 0u) { if (xb_ld(&bar[XB_TMO])) break; if (sp > XB_SPIN_CAP) { atomicAdd(&bar[XB_TMO], 1u); break; } }
    }
    nloc = mine > 0u ? mine : 1u; nx = cnt > 0u ? cnt : 1u;
}
__device__ __forceinline__ void xcd_barrier(const XcdBarrier& b) {
    asm volatile("s_waitcnt vmcnt(0)" ::: "memory");
    __syncthreads();
    if (threadIdx.x == 0) {
        unsigned* bar = b.bar;
        __builtin_amdgcn_s_waitcnt(0);
        unsigned nloc = b.st[0], nx = b.st[1];
        if (nloc == 0u) { xcd_barrier_complete(bar, b.x, nloc, nx); b.st[0] = nloc; b.st[1] = nx; }
        const unsigned old = xb_add(&bar[XB_XSUB(b.x)], 1u);
        const unsigned gen = old / nloc;
        if (old + 1u == (gen + 1u) * nloc) {
            __builtin_amdgcn_fence(__ATOMIC_RELEASE, "agent");
            asm volatile("s_waitcnt vmcnt(0)" ::: "memory");
            const unsigned og = xb_add(&bar[XB_TOP], 1u);
            const unsigned tg = og / nx;
            if (og + 1u == (tg + 1u) * nx) xb_add(&bar[XB_TOPGEN], 1u);
            else XB_SPIN(xb_ld(&bar[XB_TOPGEN]) == tg, bar);
            __builtin_amdgcn_fence(__ATOMIC_ACQUIRE, "agent");
            xb_add(&bar[XB_XGEN(b.x)], 1u);
            asm volatile("s_waitcnt vmcnt(0)" ::: "memory");
        } else {
            XB_SPIN(xb_ld(&bar[XB_XGEN(b.x)]) == gen, bar);
            __builtin_amdgcn_fence(__ATOMIC_ACQUIRE, "agent");
            asm volatile("s_waitcnt vmcnt(0)" ::: "memory");
        }
    }
    __syncthreads();
}

__device__ __forceinline__ unsigned pk4_fp8(float a, float b, float c, float d);
#define EPI_ROWS(ai, m) (u.pm * 256 + (ai) * 128 + wr * 64 + (m) * 16 + fr)
#define EPI_COLT(bj, n) ((bj) * 128 + wc * 32 + (n) * 16 + 4 * fq)
#define EPI_COLP(bj) ((bj) * 128 + wc * 32 + 8 * fq)

constexpr int EPX_OFF = 131072, EPY_OFF = 131072 + 8192;
struct EpiIn {
    static constexpr bool PERM = true, HAS_MID = false;
    LAS unsigned char* lds; unsigned char* ws; unsigned char* dout; const float* const* in;
    int memkv, pnoff;
    __device__ __forceinline__ void store4(bf16_t* p, const f32x4 v) const { u32x2 w; w.x = pk2(v[0], v[1]); w.y = pk2(v[2], v[3]); *(u32x2*)p = w; }
    __device__ __forceinline__ void store8(bf16_t* p, const f32x4 a, const f32x4 b) const { u32x4 w; w.x = pk2(a[0], a[1]); w.y = pk2(a[2], a[3]); w.z = pk2(b[0], b[1]); w.w = pk2(b[2], b[3]); *(u32x4*)p = w; }
    __device__ __forceinline__ void operator()(const f32x4 (&acc)[2][2][4][2], const pg8::Unit& u, int wr, int wc, int fr_, int fq_) const {
        int pn = u.pn;
        if (pnoff == 1) pn = pn < 6 ? pn + 3 : 12; else if (pnoff == 2) pn = pn < 3 ? pn : (pn < 6 ? pn + 6 : pn + 7);
        const int fr = opaque_v(fr_), fq = opaque_v(fq_);
        bf16_t* const QA = (bf16_t*)(ws + WS_QA); bf16_t* const CKV = (bf16_t*)(ws + WS_CKV); bf16_t* const IQ = (bf16_t*)(dout + DO_IQ); bf16_t* const IK = (bf16_t*)(ws + WS_IK);
        bf16_t* const BQ = (bf16_t*)(ws + WS_BQ); bf16_t* const BK = (bf16_t*)(ws + WS_BK); bf16_t* const BV = (bf16_t*)(ws + WS_BV); bf16_t* const CQ = (bf16_t*)(ws + WS_CQ);
        bf16_t* const GATE = (bf16_t*)(dout + DO_GATE); bf16_t* const MIX = (bf16_t*)(ws + WS_BIG); bf16_t* const KC = (bf16_t*)(ws + WS_KC); bf16_t* const VC = (bf16_t*)(ws + WS_VC); float* const IW = (float*)(ws + WS_IW);
        int kind; bf16_t* dst; int ld, cb; int gi = 0; float gsc = 1.f;
        if (memkv) { if (pn < 2) { kind = 3; dst = KC; ld = 512; cb = pn * 256; gi = 16; } else { kind = 0; dst = VC; ld = 512; cb = (pn - 2) * 256; } }
        else if (pn <= 2) { kind = 3; dst = QA; ld = 768; cb = pn * 256; gi = 8; }
        else if (pn == 3) { kind = 4; dst = CKV; ld = 256; cb = 0; gi = 4; }
        else if (pn <= 7) { kind = 0; dst = IQ; ld = 1024; cb = (pn - 4) * 256; }
        else if (pn == 8) { kind = 6; dst = IK; ld = 64; cb = 0; }
        else if (pn <= 11) { kind = 5; dst = BQ; ld = 768; cb = (pn - 9) * 256; gi = 10; gsc = 0.125f; }
        else if (pn == 12) { kind = 7; dst = BK; ld = 128; cb = 0; gi = 11; }
        else if (pn <= 14) { kind = 3; dst = CQ; ld = 512; cb = (pn - 13) * 256; gi = 15; gsc = 0.08838834764831845f; }
        else if (pn <= 17) { kind = 1; dst = GATE; ld = 2048; cb = (pn - 15) * 256; }
        else if (pn <= 20) { kind = 1; dst = GATE; ld = 2048; cb = 768 + (pn - 18) * 256; }
        else if (pn <= 22) { kind = 1; dst = GATE; ld = 2048; cb = 1536 + (pn - 21) * 256; }
        else { kind = 2; dst = MIX; ld = 6144; cb = (pn - 23) * 256; }
        if (kind <= 2) {
#pragma unroll
            for (int bj = 0; bj < 2; ++bj) { const int c = cb + EPI_COLP(bj); f32x4 b0 = (f32x4){0.f, 0.f, 0.f, 0.f}, b1 = b0; if (kind == 2) { b0 = *(const f32x4*)(in[20] + c); b1 = *(const f32x4*)(in[20] + c + 4); }
#pragma unroll
                for (int ai = 0; ai < 2; ++ai)
#pragma unroll
                    for (int m = 0; m < 4; ++m) { const size_t row = EPI_ROWS(ai, m); f32x4 v = acc[ai][bj][m][0] + b0, w = acc[ai][bj][m][1] + b1;
                        if (kind == 1) { v[0] = silu_f(v[0]); v[1] = silu_f(v[1]); v[2] = silu_f(v[2]); v[3] = silu_f(v[3]); w[0] = silu_f(w[0]); w[1] = silu_f(w[1]); w[2] = silu_f(w[2]); w[3] = silu_f(w[3]); }
                        if (kind == 2) { v[0] = einv_f(v[0]); v[1] = einv_f(v[1]); v[2] = einv_f(v[2]); v[3] = einv_f(v[3]); w[0] = einv_f(w[0]); w[1] = einv_f(w[1]); w[2] = einv_f(w[2]); w[3] = einv_f(w[3]); }
                        store8(dst + row * ld + c, v, w); asm volatile("" ::: "memory"); } }
            return;
        }
        LAS float* X = (LAS float*)(lds + EPX_OFF); LAS float* Y = (LAS float*)(lds + EPY_OFF);
        const float* gain = in[gi]; const float* ln_g = in[6]; const float* ln_b = in[7];
#pragma unroll
        for (int ai = 0; ai < 2; ++ai)
#pragma unroll
            for (int m = 0; m < 4; ++m) { const int rl = ai * 128 + wr * 64 + m * 16 + fr;
#pragma unroll
                for (int bj = 0; bj < 2; ++bj) { const f32x4 a0 = acc[ai][bj][m][0], a1 = acc[ai][bj][m][1];
                    float sq = (a0[0] * a0[0] + a0[1] * a0[1]) + (a0[2] * a0[2] + a0[3] * a0[3]) + (a1[0] * a1[0] + a1[1] * a1[1]) + (a1[2] * a1[2] + a1[3] * a1[3]);
                    sq += __shfl_xor(sq, 16); sq += __shfl_xor(sq, 32);
                    if (fq == 0) X[(rl * 2 + bj) * 4 + wc] = sq;
                    if (kind == 6) { float sm = (a0[0] + a0[1]) + (a0[2] + a0[3]) + (a1[0] + a1[1]) + (a1[2] + a1[3]); sm += __shfl_xor(sm, 16); sm += __shfl_xor(sm, 32); if (fq == 0) Y[(rl * 2 + bj) * 4 + wc] = sm; } } }
        asm volatile("s_waitcnt lgkmcnt(0)" ::: "memory"); __builtin_amdgcn_s_barrier(); asm volatile("" ::: "memory");
#pragma unroll
        for (int ai = 0; ai < 2; ++ai)
#pragma unroll
            for (int m = 0; m < 4; ++m) { const int rl = ai * 128 + wr * 64 + m * 16 + fr; const size_t row = EPI_ROWS(ai, m);
                const f32x4 x0 = *(const LAS f32x4*)(X + (rl * 2 + 0) * 4), x1 = *(const LAS f32x4*)(X + (rl * 2 + 1) * 4);
                float rs0, rs1;
                if (kind == 3) { rs0 = rsqrt_f(((x0[0] + x0[1]) + (x0[2] + x0[3])) * (1.f / 128.f) + EPS); rs1 = rsqrt_f(((x1[0] + x1[1]) + (x1[2] + x1[3])) * (1.f / 128.f) + EPS); }
                else if (kind == 4) { rs0 = rs1 = rsqrt_f((((x0[0] + x0[1]) + (x0[2] + x0[3])) + ((x1[0] + x1[1]) + (x1[2] + x1[3]))) * (1.f / 256.f) + EPS); }
                else { const int w2 = wc & 2; rs0 = rsqrt_f((w2 ? x0[2] + x0[3] : x0[0] + x0[1]) * (1.f / 64.f) + EPS); rs1 = rsqrt_f((w2 ? x1[2] + x1[3] : x1[0] + x1[1]) * (1.f / 64.f) + EPS); }
                if (kind == 6) {
                    if (wc < 2) { const f32x4 y0 = *(const LAS f32x4*)(Y + (rl * 2 + 0) * 4); const float mean = (y0[0] + y0[1]) * (1.f / 64.f); const float var = fmaxf((x0[0] + x0[1]) * (1.f / 64.f) - mean * mean, 0.f); const float rstd = rsqrt_f(var + EPS);
                        const int c = wc * 32 + 8 * fq; const f32x4 g0 = *(const f32x4*)(ln_g + c), g1 = *(const f32x4*)(ln_g + c + 4), e0 = *(const f32x4*)(ln_b + c), e1 = *(const f32x4*)(ln_b + c + 4);
                        store8(IK + row * 64 + c, (acc[ai][0][m][0] - mean) * rstd * g0 + e0, (acc[ai][0][m][1] - mean) * rstd * g1 + e1); }
                    else if (wc == 2 && fq < 2) { *(f32x4*)(IW + row * 16 + 8 * fq) = acc[ai][0][m][0] * 0.03125f; *(f32x4*)(IW + row * 16 + 8 * fq + 4) = acc[ai][0][m][1] * 0.03125f; }
                } else if (kind == 7) {
                    const int c = wc * 32 + 8 * fq; const f32x4 g0 = *(const f32x4*)(gain + (c & 63)), g1 = *(const f32x4*)(gain + (c & 63) + 4);
                    store8(BK + row * 128 + c, acc[ai][0][m][0] * rs0 * g0, acc[ai][0][m][1] * rs0 * g1); store8(BV + row * 128 + c, acc[ai][1][m][0], acc[ai][1][m][1]);
                } else {
#pragma unroll
                    for (int bj = 0; bj < 2; ++bj) { const int ct = EPI_COLP(bj); const int go = kind == 4 ? ct : (kind == 3 ? (ct & 127) : (ct & 63)); const f32x4 g0 = *(const f32x4*)(gain + go), g1 = *(const f32x4*)(gain + go + 4);
                        const float rr = (bj ? rs1 : rs0) * gsc;
                        store8(dst + row * ld + cb + ct, acc[ai][bj][m][0] * rr * g0, acc[ai][bj][m][1] * rr * g1); } }
                asm volatile("" ::: "memory"); }
    }
};
struct EpiMix {
    static constexpr bool PERM = true, HAS_MID = false;
    bf16_t* MIX; const float* gb;
    __device__ __forceinline__ void operator()(const f32x4 (&acc)[2][2][4][2], const pg8::Unit& u, int wr, int wc, int fr_, int fq_) const {
        const int fr = opaque_v(fr_), fq = opaque_v(fq_);
#pragma unroll
        for (int bj = 0; bj < 2; ++bj) { const int c = u.pn * 256 + EPI_COLP(bj); const f32x4 b0 = *(const f32x4*)(gb + c), b1 = *(const f32x4*)(gb + c + 4);
#pragma unroll
            for (int ai = 0; ai < 2; ++ai)
#pragma unroll
                for (int m = 0; m < 4; ++m) { const size_t row = EPI_ROWS(ai, m); const f32x4 v = acc[ai][bj][m][0] + b0, w = acc[ai][bj][m][1] + b1;
                    u32x4 o; o.x = pk2(sigmoid_f(v[0]), sigmoid_f(v[1])); o.y = pk2(sigmoid_f(v[2]), sigmoid_f(v[3])); o.z = pk2(sigmoid_f(w[0]), sigmoid_f(w[1])); o.w = pk2(sigmoid_f(w[2]), sigmoid_f(w[3]));
                    *(u32x4*)(MIX + row * 6144 + c) = o; asm volatile("" ::: "memory"); } }
    }
};
struct EpiF32 {
    static constexpr bool PERM = false, HAS_MID = false;
    float* C; int ldc;
    __device__ __forceinline__ void operator()(const f32x4 (&acc)[2][2][4][2], const pg8::Unit& u, int wr, int wc, int fr, int fq) const {
#pragma unroll
        for (int ai = 0; ai < 2; ++ai)
#pragma unroll
            for (int m = 0; m < 4; ++m) { const size_t row = EPI_ROWS(ai, m);
#pragma unroll
                for (int bj = 0; bj < 2; ++bj)
#pragma unroll
                    for (int n = 0; n < 2; ++n) *(f32x4*)(C + row * ldc + u.pn * 256 + EPI_COLT(bj, n)) = acc[ai][bj][m][n]; }
    }
};
struct EpiBf {
    static constexpr bool PERM = false, HAS_MID = false;
    bf16_t* O; int ldc;
    __device__ __forceinline__ void operator()(const f32x4 (&acc)[2][2][4][2], const pg8::Unit& u, int wr, int wc, int fr, int fq) const {
#pragma unroll
        for (int ai = 0; ai < 2; ++ai)
#pragma unroll
            for (int m = 0; m < 4; ++m) { const size_t row = EPI_ROWS(ai, m);
#pragma unroll
                for (int bj = 0; bj < 2; ++bj)
#pragma unroll
                    for (int n = 0; n < 2; ++n) { const f32x4 v = acc[ai][bj][m][n]; u32x2 w; w.x = pk2(v[0], v[1]); w.y = pk2(v[2], v[3]);
                        *(u32x2*)(O + row * ldc + u.pn * 256 + EPI_COLT(bj, n)) = w; } }
    }
};
struct EpiKss {
    static constexpr bool PERM = false, HAS_MID = false;
    float* KSS;
    __device__ __forceinline__ void operator()(const f32x4 (&acc)[2][2][4][2], const pg8::Unit& u, int wr, int wc, int fr, int fq) const {
#pragma unroll
        for (int ai = 0; ai < 2; ++ai)
#pragma unroll
            for (int m = 0; m < 4; ++m) { const size_t row = EPI_ROWS(ai, m);
#pragma unroll
                for (int bj = 0; bj < 2; ++bj) { float s = 0.f;
#pragma unroll
                    for (int n = 0; n < 2; ++n) { const f32x4 v = acc[ai][bj][m][n]; s += (v[0] * v[0] + v[1] * v[1]) + (v[2] * v[2] + v[3] * v[3]); }
                    atomicAdd(KSS + row * 8 + 2 * u.pn + bj, s); }
                asm volatile("" ::: "memory"); }
    }
};
struct EpiGateMul {
    static constexpr bool PERM = false, HAS_MID = false;
    bf16_t* OP; const bf16_t* GATE;
    __device__ __forceinline__ void operator()(const f32x4 (&acc)[2][2][4][2], const pg8::Unit& u, int wr, int wc, int fr, int fq) const {
#pragma unroll
        for (int ai = 0; ai < 2; ++ai)
#pragma unroll
            for (int m = 0; m < 4; ++m) { const size_t row = EPI_ROWS(ai, m);
#pragma unroll
                for (int bj = 0; bj < 2; ++bj)
#pragma unroll
                    for (int n = 0; n < 2; ++n) { const int c = u.pn * 256 + EPI_COLT(bj, n); const f32x4 v = acc[ai][bj][m][n];
                        const u32x2 gw = *(const u32x2*)(GATE + row * 2048 + c);
                        *(unsigned*)((unsigned char*)OP + row * 2048 + c) = pk4_fp8(16.f * v[0] * bf2f(gw.x & 0xffff), 16.f * v[1] * bf2f(gw.x >> 16), 16.f * v[2] * bf2f(gw.y & 0xffff), 16.f * v[3] * bf2f(gw.y >> 16)); }
                asm volatile("" ::: "memory"); }
    }
};
struct EpiMerge {
    static constexpr bool PERM = true, HAS_MID = true;
    bf16_t* MERGED; const bf16_t* MIX; int mid_t0, mid_t1;
    __device__ __forceinline__ void gate8(const bf16_t* p, f32x4& a, f32x4& b) const { const u32x4 w = *(const u32x4*)p;
        a[0] = bf2f(w.x & 0xffff); a[1] = bf2f(w.x >> 16); a[2] = bf2f(w.y & 0xffff); a[3] = bf2f(w.y >> 16); b[0] = bf2f(w.z & 0xffff); b[1] = bf2f(w.z >> 16); b[2] = bf2f(w.w & 0xffff); b[3] = bf2f(w.w >> 16);
#pragma unroll
        for (int j = 0; j < 4; ++j) { a[j] = fmaxf(a[j], 1e-20f); b[j] = fmaxf(b[j], 1e-20f); } }
    __device__ __forceinline__ void unpack8(const u32x4 w, f32x4& a, f32x4& b) const {
        a[0] = bf2f(w.x & 0xffff); a[1] = bf2f(w.x >> 16); a[2] = bf2f(w.y & 0xffff); a[3] = bf2f(w.y >> 16); b[0] = bf2f(w.z & 0xffff); b[1] = bf2f(w.z >> 16); b[2] = bf2f(w.w & 0xffff); b[3] = bf2f(w.w >> 16); }
    __device__ __forceinline__ void mid(f32x4 (&acc)[2][2][4][2], const pg8::Unit& u, int t, int wr, int wc, int fr_, int fq_) const {
        const int fr = opaque_v(fr_), fq = opaque_v(fq_); const int gprev = t == mid_t0 ? 0 : 2048;
        u32x4 wp[4][2][2], wn[4][2][2];
#define MID_LOAD(bt) do { _Pragma("unroll") for (int mm = 0; mm < 2; ++mm) { const size_t row = EPI_ROWS((bt) >> 1, 2 * ((bt) & 1) + mm); \
            _Pragma("unroll") for (int bj = 0; bj < 2; ++bj) { const int c = u.pn * 256 + EPI_COLP(bj); wp[bt][mm][bj] = *(const u32x4*)(MIX + row * 6144 + gprev + c); wn[bt][mm][bj] = *(const u32x4*)(MIX + row * 6144 + gprev + 2048 + c); } } } while (0)
#define MID_USE(bt) do { _Pragma("unroll") for (int mm = 0; mm < 2; ++mm) { const int ai = (bt) >> 1, m = 2 * ((bt) & 1) + mm; \
            _Pragma("unroll") for (int bj = 0; bj < 2; ++bj) { f32x4 p0, p1, n0, n1; unpack8(wp[bt][mm][bj], p0, p1); unpack8(wn[bt][mm][bj], n0, n1); \
                _Pragma("unroll") for (int j = 0; j < 4; ++j) { acc[ai][bj][m][0][j] *= n0[j] * __builtin_amdgcn_rcpf(p0[j]); acc[ai][bj][m][1][j] *= n1[j] * __builtin_amdgcn_rcpf(p1[j]); } } } } while (0)
        MID_LOAD(0); MID_LOAD(1); asm volatile("" ::: "memory");
        MID_USE(0); asm volatile("" ::: "memory"); MID_LOAD(2); asm volatile("" ::: "memory");
        MID_USE(1); asm volatile("" ::: "memory"); MID_LOAD(3); asm volatile("" ::: "memory");
        MID_USE(2); asm volatile("" ::: "memory");
        MID_USE(3); asm volatile("" ::: "memory");
#undef MID_LOAD
#undef MID_USE
    }
    __device__ __forceinline__ void operator()(const f32x4 (&acc)[2][2][4][2], const pg8::Unit& u, int wr, int wc, int fr_, int fq_) const {
        const int fr = opaque_v(fr_), fq = opaque_v(fq_);
#pragma unroll
        for (int ai = 0; ai < 2; ++ai) { u32x4 wg[4][2];
#pragma unroll
            for (int m = 0; m < 4; ++m) { const size_t row = EPI_ROWS(ai, m);
#pragma unroll
                for (int bj = 0; bj < 2; ++bj) wg[m][bj] = *(const u32x4*)(MIX + row * 6144 + 4096 + u.pn * 256 + EPI_COLP(bj)); }
            asm volatile("" ::: "memory");
#pragma unroll
            for (int m = 0; m < 4; ++m) { const size_t row = EPI_ROWS(ai, m);
#pragma unroll
                for (int bj = 0; bj < 2; ++bj) { const int c = u.pn * 256 + EPI_COLP(bj); f32x4 g0, g1; unpack8(wg[m][bj], g0, g1);
                    f32x4 v, w;
#pragma unroll
                    for (int j = 0; j < 4; ++j) { v[j] = acc[ai][bj][m][0][j] * __builtin_amdgcn_rcpf(g0[j]); w[j] = acc[ai][bj][m][1][j] * __builtin_amdgcn_rcpf(g1[j]); }
                    u32x2 o; o.x = pk4_fp8(16.f * v[0], 16.f * v[1], 16.f * v[2], 16.f * v[3]); o.y = pk4_fp8(16.f * w[0], 16.f * w[1], 16.f * w[2], 16.f * w[3]); *(u32x2*)((unsigned char*)MERGED + row * 2048 + c) = o; } }
            asm volatile("" ::: "memory"); }
    }
};
struct EpiOut {
    static constexpr bool PERM = false, HAS_MID = false;
    float* out; const float* x;
    __device__ __forceinline__ void operator()(const f32x4 (&acc)[2][2][4][2], const pg8::Unit& u, int wr, int wc, int fr, int fq) const {
#pragma unroll
        for (int ai = 0; ai < 2; ++ai)
#pragma unroll
            for (int mh = 0; mh < 2; ++mh) { f32x4 xv[2][2][2];
#pragma unroll
                for (int mm = 0; mm < 2; ++mm) { const size_t row = EPI_ROWS(ai, 2 * mh + mm);
#pragma unroll
                    for (int bj = 0; bj < 2; ++bj)
#pragma unroll
                        for (int n = 0; n < 2; ++n) xv[mm][bj][n] = *(const f32x4*)(x + row * 2048 + u.pn * 256 + EPI_COLT(bj, n)); }
                asm volatile("" ::: "memory");
#pragma unroll
                for (int mm = 0; mm < 2; ++mm) { const size_t row = EPI_ROWS(ai, 2 * mh + mm);
#pragma unroll
                    for (int bj = 0; bj < 2; ++bj)
#pragma unroll
                        for (int n = 0; n < 2; ++n) *(f32x4*)(out + row * 2048 + u.pn * 256 + EPI_COLT(bj, n)) = xv[mm][bj][n] + acc[ai][bj][2 * mh + mm][n]; }
                asm volatile("" ::: "memory"); }
    }
};

template <class F>
__device__ __forceinline__ void cvt_matrix(Ctx& C, bf16_t* dst, int dld, int Nn, int K, const F& f) {
    const long total = (long)Nn * (K / 8);
    for (long it = (long)C.vcu * NTHREADS + C.tid; it < total; it += (long)C.G * NTHREADS) {
        const int n = (int)(it % Nn), k0 = (int)(it / Nn) * 8;
        u32x4 w; w.x = pk2(f(n, k0), f(n, k0 + 1)); w.y = pk2(f(n, k0 + 2), f(n, k0 + 3)); w.z = pk2(f(n, k0 + 4), f(n, k0 + 5)); w.w = pk2(f(n, k0 + 6), f(n, k0 + 7));
        *(u32x4*)(dst + (size_t)n * dld + k0) = w;
    }
}
__device__ __forceinline__ unsigned pk4_fp8(float a, float b, float c, float d);
__device__ __forceinline__ void rms_rows2_to_bf16(const float* xrow, const float* g, bf16_t* orow, size_t rstride, int lane, unsigned char* o8row = nullptr) {
    const f32x4* xr0 = (const f32x4*)xrow + lane; const f32x4* xr1 = (const f32x4*)(xrow + rstride) + lane; const f32x4* gr = (const f32x4*)g + lane;
    f32x4 v0[8], v1[8]; float s0 = 0.f, s1 = 0.f;
#pragma unroll
    for (int j = 0; j < 8; ++j) { v0[j] = xr0[64 * j]; v1[j] = xr1[64 * j]; }
#pragma unroll
    for (int j = 0; j < 8; ++j) { s0 += (v0[j][0] * v0[j][0] + v0[j][1] * v0[j][1]) + (v0[j][2] * v0[j][2] + v0[j][3] * v0[j][3]); s1 += (v1[j][0] * v1[j][0] + v1[j][1] * v1[j][1]) + (v1[j][2] * v1[j][2] + v1[j][3] * v1[j][3]); }
    const float r0 = rsqrt_f(wave_sum(s0) * (1.f / 2048.f) + EPS), r1 = rsqrt_f(wave_sum(s1) * (1.f / 2048.f) + EPS);
    u32x2* o0 = (u32x2*)orow + lane; u32x2* o1 = (u32x2*)(orow + rstride) + lane;
#pragma unroll
    for (int j = 0; j < 8; ++j) { const f32x4 gg = gr[64 * j]; u32x2 w;
        w.x = pk2(v0[j][0] * r0 * gg[0], v0[j][1] * r0 * gg[1]); w.y = pk2(v0[j][2] * r0 * gg[2], v0[j][3] * r0 * gg[3]); o0[64 * j] = w;
        w.x = pk2(v1[j][0] * r1 * gg[0], v1[j][1] * r1 * gg[1]); w.y = pk2(v1[j][2] * r1 * gg[2], v1[j][3] * r1 * gg[3]); o1[64 * j] = w;
        if (o8row) { ((unsigned*)o8row)[lane + 64 * j] = pk4_fp8(v0[j][0] * r0 * gg[0], v0[j][1] * r0 * gg[1], v0[j][2] * r0 * gg[2], v0[j][3] * r0 * gg[3]);
            ((unsigned*)(o8row + rstride))[lane + 64 * j] = pk4_fp8(v1[j][0] * r1 * gg[0], v1[j][1] * r1 * gg[1], v1[j][2] * r1 * gg[2], v1[j][3] * r1 * gg[3]); } }
}
template <class F>
__device__ __forceinline__ void transpose_item(const F& f, bf16_t* dst, int dld, int k0, int n0, LAS float* scr, int lane) {
    float tv[32];
#pragma unroll
    for (int i = 0; i < 32; ++i) tv[i] = f(k0 + 2 * i + (lane >> 5), n0 + (lane & 31));
#pragma unroll
    for (int i = 0; i < 32; ++i) scr[(2 * i + (lane >> 5)) * 33 + (lane & 31)] = tv[i];
    asm volatile("s_waitcnt lgkmcnt(0)" ::: "memory");
    const int c = lane & 7;
#pragma unroll
    for (int j = 0; j < 4; ++j) { const int n = (lane >> 3) + 8 * j; const LAS float* sp = scr + (8 * c) * 33 + n;
        u32x4 o; o.x = pk2(sp[0 * 33], sp[1 * 33]); o.y = pk2(sp[2 * 33], sp[3 * 33]); o.z = pk2(sp[4 * 33], sp[5 * 33]); o.w = pk2(sp[6 * 33], sp[7 * 33]);
        *(u32x4*)(dst + (size_t)(n0 + n) * dld + k0 + 8 * c) = o; }
    asm volatile("s_waitcnt lgkmcnt(0)" ::: "memory");
}
__device__ __forceinline__ unsigned pk4_fp8(float a, float b, float c, float d) { int w = 0; w = __builtin_amdgcn_cvt_pk_fp8_f32(a, b, w, false); w = __builtin_amdgcn_cvt_pk_fp8_f32(c, d, w, true); return (unsigned)w; }
template <class F>
__device__ __forceinline__ void transpose_item8(const F& f, unsigned char* dst, int dld, int k0, int n0, LAS float* scr, int lane) {
    float tv[32];
#pragma unroll
    for (int i = 0; i < 32; ++i) tv[i] = f(k0 + 2 * i + (lane >> 5), n0 + (lane & 31));
#pragma unroll
    for (int i = 0; i < 32; ++i) scr[(2 * i + (lane >> 5)) * 33 + (lane & 31)] = tv[i];
    asm volatile("s_waitcnt lgkmcnt(0)" ::: "memory");
    const int c = lane & 7;
#pragma unroll
    for (int j = 0; j < 4; ++j) { const int n = (lane >> 3) + 8 * j; const LAS float* sp = scr + (8 * c) * 33 + n;
        u32x2 o; o.x = pk4_fp8(sp[0 * 33], sp[1 * 33], sp[2 * 33], sp[3 * 33]); o.y = pk4_fp8(sp[4 * 33], sp[5 * 33], sp[6 * 33], sp[7 * 33]);
        *(u32x2*)(dst + (size_t)(n0 + n) * dld + k0 + 8 * c) = o; }
    asm volatile("s_waitcnt lgkmcnt(0)" ::: "memory");
}
__device__ __forceinline__ void p0_prologue(Ctx& C) {
    unsigned char* ws = C.ws;
    const float* w_in = C.in[3]; const float* w_kv_up = C.in[5]; const float* k_norm_a = C.in[9]; const float* w_mem_kv = C.in[14];
    const float* w_up_a = C.in[17]; const float* w_up_b = C.in[18]; const float* w_up_c = C.in[19]; const float* w_o = C.in[21];
    const int lane = C.lane;
    const int gw = C.vcu * NWAVES + C.wave, NGW = C.G * NWAVES;
    LAS float* scr = (LAS float*)(C.lds + C.wave * 8704);
    constexpr int I_WIN = 32 * (NWIN_A / 32), I_MIX = 32 * (NWIN_B / 32), I_UP = 32 * 64, I_O = 32 * 64, I_MEM = 32 * 32;
    for (int it = gw; it < I_WIN + I_MIX + I_UP + I_O + I_MEM; it += NGW) {
        int r = it;
        if (r < I_WIN) { const int nb = r % (NWIN_A / 32), kb = r / (NWIN_A / 32);
            transpose_item([=](int k, int n) -> float { if (n >= 1360 && n < 1536) return 0.f;
                const int c = n < 1360 ? 768 + n : 3664 + (n - 1536); return w_in[(size_t)k * IN_COLS + c]; }, (bf16_t*)(ws + WS_WINT), 2048, 64 * kb, 32 * nb, scr, lane); continue; }
        r -= I_WIN;
        if (r < I_MIX) { const int nb = r % (NWIN_B / 32), kb = r / (NWIN_B / 32);
            transpose_item8([=](int k, int n) -> float { int c;
                if (n < 768) c = n; else if (n < 1536) c = 2896 + (n - 768); else if (n < 2048) c = 4688 + (n - 1536);
                else { const int m = n - 2048; c = m < 768 ? 2128 + m : (m < 1536 ? 3920 + (m - 768) : (m < 2048 ? 5200 + (m - 1536) : 5712 + (m - 2048))); }
                return 64.0f * w_in[(size_t)k * IN_COLS + c]; }, ws + WS_WMIX8, 2048, 64 * kb, 32 * nb, scr, lane); continue; }
        r -= I_MIX;
        if (r < I_UP) { const int nb = r % 64, kb = r / 64; const int k0 = 64 * kb;
            const float* src = k0 < 768 ? w_up_a : (k0 < 1536 ? w_up_b - (size_t)768 * 2048 : w_up_c - (size_t)1536 * 2048);
            transpose_item8([=](int k, int n) -> float { return 32.0f * src[(size_t)k * 2048 + n]; }, ws + WS_WUPT, 2048, k0, 32 * nb, scr, lane); continue; }
        r -= I_UP;
        if (r < I_O) { const int nb = r % 64, kb = r / 64;
            transpose_item8([=](int k, int n) -> float { return 64.0f * w_o[(size_t)k * 2048 + n]; }, ws + WS_WOT, 2048, 64 * kb, 32 * nb, scr, lane); continue; }
        r -= I_O;
        { const int nb = r % 32, kb = r / 32;
            transpose_item([=](int k, int n) -> float { return w_mem_kv[(size_t)k * 1024 + n]; }, (bf16_t*)(ws + WS_WMEMT), 2048, 64 * kb, 32 * nb, scr, lane); }
    }
    cvt_matrix(C, (bf16_t*)(ws + WS_WKT), 256, 768, 256, [=](int n, int k) -> float { return w_kv_up[(size_t)k * 1536 + n]; });
    cvt_matrix(C, (bf16_t*)(ws + WS_WVBD), 512, 768, 512, [=](int n, int k) -> float { return (k >> 8) == ((n >> 7) & 1) ? w_kv_up[(size_t)(k & 255) * 1536 + 768 + n] : 0.f; });
    cvt_matrix(C, (bf16_t*)(ws + WS_WQBD), 128, 1536, 128, [=](int n, int k) -> float {
        return w_kv_up[(size_t)(n & 255) * 1536 + (n >> 8) * 128 + k] * k_norm_a[k] * 0.08838834764831845f; });
    for (int m = gw; m < M / 2; m += NGW) rms_rows2_to_bf16(C.in[0] + (size_t)m * DM, C.in[2], (bf16_t*)(ws + WS_H) + (size_t)m * DM, (size_t)(M / 2) * DM, C.lane, ws + WS_H8 + (size_t)m * DM);
    for (int m = gw; m < BATCH * MEMLEN / 2; m += NGW) rms_rows2_to_bf16(C.in[1] + (size_t)m * DM, C.in[13], (bf16_t*)(ws + WS_MEMN) + (size_t)m * DM, (size_t)(BATCH * MEMLEN / 2) * DM, C.lane);
    float* kss = (float*)(ws + WS_KSS);
    for (int i = C.vcu * NTHREADS + C.tid; i < M * 8; i += C.G * NTHREADS) kss[i] = 0.f;
}

typedef __bf16 bf8v __attribute__((ext_vector_type(8)));
typedef int i32x4 __attribute__((ext_vector_type(4)));
typedef float f32x16 __attribute__((ext_vector_type(16)));
#define MFMA32(a, b, c) __builtin_amdgcn_mfma_f32_32x32x16_bf16(__builtin_bit_cast(bf8v, (a)), __builtin_bit_cast(bf8v, (b)), (c), 0, 0, 0)
constexpr int IX_NB = 256, IX_CAP = 128, IX_QROW = 144;
constexpr int IX_Q = 0, IX_HIST = 78848, IX_CAND = IX_HIST + 32768, IX_PAR = IX_CAND + 32768, IX_STAT = IX_PAR + 1024;
static_assert(IX_STAT + 3072 <= LDS_BYTES, "indexer LDS map");
#define LDS_ADD(p, v) __hip_atomic_fetch_add((p), (v), __ATOMIC_RELAXED, __HIP_MEMORY_SCOPE_WORKGROUP)
#define LDS_OR(p, v) __hip_atomic_fetch_or((p), (v), __ATOMIC_RELAXED, __HIP_MEMORY_SCOPE_WORKGROUP)

__device__ __forceinline__ float inv_norm_top(float p) {
    const bool flip = p > 0.5f; float pp = flip ? 1.f - p : p; pp = fmaxf(pp, 1e-6f);
    const float t = sqrtf(-2.f * __logf(pp));
    const float z = t - (2.515517f + 0.802853f * t + 0.010328f * t * t) / (1.f + 1.432788f * t + 0.189269f * t * t + 0.001308f * t * t * t);
    return flip ? -z : z;
}
constexpr int IX_W = IX_STAT + 8192;
#define MFMA16I(a, b, c) __builtin_amdgcn_mfma_f32_16x16x32_bf16(__builtin_bit_cast(bf8v, (a)), __builtin_bit_cast(bf8v, (b)), (c), 0, 0, 0)
__device__ __forceinline__ void ix_load_k(const bf16_t* IKb, int p, int lane, u32x4 (&ka)[4][2]) {
#pragma unroll
    for (int kt = 0; kt < 4; ++kt) { int key = 64 * p + 16 * kt + (lane & 15); key = key < SEQ ? key : SEQ - 1;
        const u32x4* kp = (const u32x4*)(IKb + (size_t)key * 64) + (lane >> 4);
#pragma unroll
        for (int s = 0; s < 2; ++s) ka[kt][s] = kp[4 * s]; }
}
template <bool PREF>
__device__ __forceinline__ void ix_scores(const u32x4 (&ka)[4][2], const LAS unsigned char* Qs, int lane, f32x4 (&sacc)[2][4], const bf16_t* IKb, int pn, u32x4 (&kn)[4][2]) {
    const LAS unsigned char* qb = Qs + (lane & 15) * IX_QROW + (lane >> 4) * 16;
    const LAS float* wl = (const LAS float*)(Qs - IX_Q + IX_W) + (lane & 15);
    u32x4 qc[2][2], qn[2][2]; float wc0, wc1, wn0, wn1, wp1 = 0.f;
#pragma unroll
    for (int qt = 0; qt < 2; ++qt)
#pragma unroll
        for (int s = 0; s < 2; ++s) qc[qt][s] = *(const LAS u32x4*)(qb + (16 * 32 + 16 * qt) * IX_QROW + 64 * s);
#pragma unroll
    for (int qt = 0; qt < 2; ++qt)
#pragma unroll
        for (int s = 0; s < 2; ++s) qn[qt][s] = *(const LAS u32x4*)(qb + (16 * qt) * IX_QROW + 64 * s);
    wn0 = wl[0]; wn1 = wl[16];
    asm volatile("" ::: "memory");
#pragma unroll
    for (int qt = 0; qt < 2; ++qt)
#pragma unroll
        for (int kt = 0; kt < 4; ++kt) sacc[qt][kt] = (f32x4){0.f, 0.f, 0.f, 0.f};
#pragma unroll
    for (int s = 0; s < 2; ++s)
#pragma unroll
        for (int qt = 0; qt < 2; ++qt)
#pragma unroll
            for (int kt = 0; kt < 4; ++kt) sacc[qt][kt] = MFMA16I(ka[kt][s], qc[qt][s], sacc[qt][kt]);
    f32x4 z0[4], z1[4];
#pragma unroll
    for (int kt = 0; kt < 4; ++kt) z1[kt] = (f32x4){0.f, 0.f, 0.f, 0.f};
#pragma unroll
    for (int hh = 0; hh < 16; ++hh) {
#pragma unroll
        for (int qt = 0; qt < 2; ++qt)
#pragma unroll
            for (int s = 0; s < 2; ++s) qc[qt][s] = qn[qt][s];
        wc0 = wn0; wc1 = wn1;
#pragma unroll
        for (int kt = 0; kt < 4; ++kt) z0[kt] = (f32x4){0.f, 0.f, 0.f, 0.f};
#pragma unroll
        for (int s = 0; s < 2; ++s)
#pragma unroll
            for (int kt = 0; kt < 4; ++kt) z0[kt] = MFMA16I(ka[kt][s], qc[0][s], z0[kt]);
        if (hh > 0) {
#pragma unroll
            for (int kt = 0; kt < 4; ++kt)
#pragma unroll
                for (int i = 0; i < 4; ++i) { float t1 = __builtin_fmaf(__builtin_fabsf(z1[kt][i]), wp1, sacc[1][kt][i]); asm volatile("" : "+v"(t1)); sacc[1][kt][i] = t1; }
#pragma unroll
            for (int i = 0; i < 8; ++i) { __builtin_amdgcn_sched_group_barrier(0x008, 1, 0); __builtin_amdgcn_sched_group_barrier(0x002, 2, 0); }
            asm volatile("" : "+v"(sacc[1][0]), "+v"(sacc[1][1]), "+v"(sacc[1][2]), "+v"(sacc[1][3]));
        }
        __builtin_amdgcn_sched_barrier(0);
#pragma unroll
        for (int kt = 0; kt < 4; ++kt) z1[kt] = (f32x4){0.f, 0.f, 0.f, 0.f};
#pragma unroll
        for (int s = 0; s < 2; ++s)
#pragma unroll
            for (int kt = 0; kt < 4; ++kt) z1[kt] = MFMA16I(ka[kt][s], qc[1][s], z1[kt]);
        if (hh < 15) {
#pragma unroll
            for (int qt = 0; qt < 2; ++qt)
#pragma unroll
                for (int s = 0; s < 2; ++s) qn[qt][s] = *(const LAS u32x4*)(qb + ((hh + 1) * 32 + 16 * qt) * IX_QROW + 64 * s);
            wn0 = wl[(hh + 1) * 32]; wn1 = wl[(hh + 1) * 32 + 16]; }
#pragma unroll
        for (int kt = 0; kt < 4; ++kt)
#pragma unroll
            for (int i = 0; i < 4; ++i) { float t0 = __builtin_fmaf(__builtin_fabsf(z0[kt][i]), wc0, sacc[0][kt][i]); asm volatile("" : "+v"(t0)); sacc[0][kt][i] = t0; }
#pragma unroll
        for (int i = 0; i < 8; ++i) { __builtin_amdgcn_sched_group_barrier(0x008, 1, 0); __builtin_amdgcn_sched_group_barrier(0x002, 2, 0); if (hh < 15 && i < 6) __builtin_amdgcn_sched_group_barrier(0x100, 1, 0); }
        asm volatile("" : "+v"(sacc[0][0]), "+v"(sacc[0][1]), "+v"(sacc[0][2]), "+v"(sacc[0][3]));
        __builtin_amdgcn_sched_barrier(0);
        wp1 = wc1;
        if (PREF && hh == 5) { ix_load_k(IKb, pn, lane, kn); asm volatile("" ::: "memory"); }
    }
#pragma unroll
    for (int kt = 0; kt < 4; ++kt)
#pragma unroll
        for (int i = 0; i < 4; ++i) { float t1 = __builtin_fmaf(__builtin_fabsf(z1[kt][i]), wp1, sacc[1][kt][i]); asm volatile("" : "+v"(t1)); sacc[1][kt][i] = t1; }
    asm volatile("" : "+v"(sacc[1][0]), "+v"(sacc[1][1]), "+v"(sacc[1][2]), "+v"(sacc[1][3]));
}
typedef __bf16 bf16x2v __attribute__((ext_vector_type(2)));
__device__ __forceinline__ float dot2_bf16(unsigned w, unsigned x, float acc) { return __builtin_amdgcn_fdot2_f32_bf16(__builtin_bit_cast(bf16x2v, w), __builtin_bit_cast(bf16x2v, x), acc, false); }
__device__ __forceinline__ int ix_bin(float sv, float scale, float nls) { int bb = (int)__builtin_fmaf(sv, scale, nls); return bb < 0 ? 0 : (bb > IX_NB - 1 ? IX_NB - 1 : bb); }
__device__ __forceinline__ float f_next(float x) { int i = __float_as_int(x); if (x == 0.f) return __int_as_float(1); i += (i >= 0) ? 1 : -1; return __int_as_float(i); }
__device__ __forceinline__ float f_prev(float x) { int i = __float_as_int(x); if (x == 0.f) return __int_as_float((int)0x80000001u); i += (i >= 0) ? -1 : 1; return __int_as_float(i); }
__device__ __forceinline__ float ix_threshold(int k, float scale, float nls) {
    float gs = ((float)k - nls) / scale;
    for (int i = 0; i < 64 && ix_bin(gs, scale, nls) >= k; ++i) gs = f_prev(gs);
    for (int i = 0; i < 64 && ix_bin(gs, scale, nls) < k; ++i) gs = f_next(gs);
    return gs;
}
constexpr int IX_LIST = IX_STAT;
static_assert(IX_STAT + 8 * 1024 <= LDS_BYTES - 64, "indexer LDS map");
template <int MODE>
__device__ __forceinline__ void fast_indexer(Ctx& C, int* IDX) {
    unsigned char* ws = C.ws; const int wave = C.wave;
    const bf16_t* IQ = (const bf16_t*)((unsigned char*)C.out + DO_IQ); const bf16_t* IK = (const bf16_t*)(ws + WS_IK); const float* IW = (const float*)(ws + WS_IW);
    LAS unsigned char* Qs = C.lds + IX_Q;
    LAS unsigned* hist = (LAS unsigned*)(C.lds + IX_HIST);
    LAS unsigned* cmask = (LAS unsigned*)(C.lds + IX_CAND);
    LAS float* p_nls = (LAS float*)(C.lds + IX_PAR);
    LAS float* p_scale = p_nls + 32;
    LAS int* p_bst = (LAS int*)(p_nls + 64);
    LAS int* p_above = (LAS int*)(p_nls + 96);
    LAS float* p_tlo = p_nls + 128;
    LAS float* p_thi = p_nls + 160;
    LAS unsigned* p_notok = (LAS unsigned*)(p_nls + 192);
    LAS float* stat = (LAS float*)(C.lds + IX_STAT);
#pragma unroll 1
    for (int uu = 0; uu < 2; ++uu) {
        const int tid = opaque_v(C.tid), lane = tid & 63, c16 = lane & 15, g4 = lane >> 4;
        const int b = uu, qblk = uu == 0 ? C.vcu : (255 - C.vcu);
        if (qblk < 0 || qblk > 255) continue;
        const int t0 = 32 * qblk, npairs = (qblk + 2) >> 1;
        const size_t qrow0 = (size_t)b * SEQ + t0;
        const bf16_t* IKb = IK + (size_t)b * SEQ * 64;
        unsigned char* const bins = C.vcu < 192 ? ws + WS_H8 + (size_t)C.vcu * 262144 : ws + WS_H + 32 * MiB + (size_t)(C.vcu - 192) * 262144;
        __syncthreads();
        { u32x4 qv[8];
#pragma unroll
            for (int i = 0; i < 8; ++i) { const int c = tid + NTHREADS * i, r = c >> 7, ch = c & 127; qv[i] = *((const u32x4*)(IQ + (qrow0 + r) * 1024) + ch); }
#pragma unroll
            for (int i = 0; i < 8; ++i) { const int c = tid + NTHREADS * i, r = c >> 7, ch = c & 127, hh = ch >> 3, c8 = ch & 7; *(LAS u32x4*)(Qs + (hh * 32 + r) * IX_QROW + c8 * 16) = qv[i]; } }
        for (int i = tid; i < 8192; i += NTHREADS) { hist[i] = 0u; cmask[i] = 0u; }
        if (tid < 32) { p_bst[tid] = -1; p_above[tid] = 0; p_nls[tid] = 0.f; p_scale[tid] = 0.f; p_tlo[tid] = -INFINITY; p_thi[tid] = -INFINITY; }
        if (tid == 32) p_notok[0] = 0u;
        if (tid < 512) { LAS float* wt = (LAS float*)(C.lds + IX_W); wt[tid] = 0.5f * IW[(qrow0 + (tid & 31)) * 16 + (tid >> 5)]; }
        __syncthreads();
        for (int e = tid; e < 32 * 64; e += NTHREADS) { const int r = e >> 6, d = e & 63; float a = 0.f;
#pragma unroll
            for (int hh = 0; hh < 16; ++hh) a += ((const LAS float*)(C.lds + IX_W))[hh * 32 + r] * bf2f(*(const LAS bf16_t*)(Qs + (hh * 32 + r) * IX_QROW + d * 2));
            *(LAS bf16_t*)(Qs + (16 * 32 + r) * IX_QROW + d * 2) = (bf16_t)f2bf(a); }
        __syncthreads();
        if (MODE & 1) { float sn[2] = {0.f, 0.f}, ss[2] = {0.f, 0.f}, sq[2] = {0.f, 0.f};
            const int ps = npairs <= 8 ? wave : (wave * npairs) >> 3;
            if (ps < npairs) { f32x4 sacc[2][4]; u32x4 ka[4][2]; ix_load_k(IKb, ps, lane, ka); ix_scores<false>(ka, Qs, lane, sacc, IKb, 0, ka);
#pragma unroll
                for (int qt = 0; qt < 2; ++qt)
#pragma unroll
                    for (int kt = 0; kt < 4; ++kt)
#pragma unroll
                        for (int i = 0; i < 4; ++i) { const int key = 64 * ps + 16 * kt + 4 * g4 + i;
                            const float m = key <= t0 + 16 * qt + c16 ? 1.f : 0.f; const float v = sacc[qt][kt][i] * m; sn[qt] += m; ss[qt] += v; sq[qt] += v * v; } }
#pragma unroll
            for (int qt = 0; qt < 2; ++qt) { sn[qt] += __shfl_xor(sn[qt], 16); ss[qt] += __shfl_xor(ss[qt], 16); sq[qt] += __shfl_xor(sq[qt], 16);
                sn[qt] += __shfl_xor(sn[qt], 32); ss[qt] += __shfl_xor(ss[qt], 32); sq[qt] += __shfl_xor(sq[qt], 32);
                if (lane < 16) { stat[(wave * 32 + 16 * qt + lane) * 3 + 0] = sn[qt]; stat[(wave * 32 + 16 * qt + lane) * 3 + 1] = ss[qt]; stat[(wave * 32 + 16 * qt + lane) * 3 + 2] = sq[qt]; } } }
        __syncthreads();
        if (tid < 32) { float sn = 0.f, ss = 0.f, sq = 0.f;
            for (int w = 0; w < 8; ++w) { sn += stat[(w * 32 + tid) * 3 + 0]; ss += stat[(w * 32 + tid) * 3 + 1]; sq += stat[(w * 32 + tid) * 3 + 2]; }
            const int Nt = t0 + tid + 1;
            if (Nt > TOPK) { const float mean = ss / fmaxf(sn, 1.f); const float var = fmaxf(sq / fmaxf(sn, 1.f) - mean * mean, 0.f); const float sd = sqrtf(var);
                const float zq = inv_norm_top((float)TOPK / (float)Nt);
                const float width = fmaxf(3.0f * sd, 1e-6f * fabsf(mean) + 1e-30f);
                const float lo = mean + (zq - 1.5f) * sd, sc = (float)IX_NB / width;
                p_scale[tid] = sc; p_nls[tid] = -lo * sc; p_bst[tid] = 0; } }
        __syncthreads();
#pragma unroll 1
        for (int iter = 0; iter < ((MODE & 2) ? 8 : 0); ++iter) {
            const float nls0 = p_nls[c16], scale0 = p_scale[c16], nls1 = p_nls[16 + c16], scale1 = p_scale[16 + c16];
            u32x4 ka[4][2], kn[4][2];
            if (wave < npairs) ix_load_k(IKb, wave, lane, ka);
#pragma unroll 1
            for (int p = wave; p < npairs; p += 8) { f32x4 sacc[2][4];
                ix_scores<true>(ka, Qs, lane, sacc, IKb, p + 8 < npairs ? p + 8 : p, kn);
#pragma unroll
                for (int kt = 0; kt < 4; ++kt)
#pragma unroll
                    for (int s4 = 0; s4 < 2; ++s4) ka[kt][s4] = kn[kt][s4];
                if (64 * p + 63 <= t0) {
#pragma unroll
                    for (int qt = 0; qt < 2; ++qt) { LAS unsigned* hq = hist + 16 * qt + c16; const float scale = qt ? scale1 : scale0, nls = qt ? nls1 : nls0;
                        unsigned char* brow = bins + (size_t)(16 * qt + c16) * 8192 + 64 * p + 4 * g4;
#pragma unroll
                        for (int kt = 0; kt < 4; ++kt) { int bb[4];
#pragma unroll
                            for (int i = 0; i < 4; ++i) { bb[i] = ix_bin(sacc[qt][kt][i], scale, nls); LDS_ADD(hq + bb[i] * 32, 1u); }
                            *(unsigned*)(brow + 16 * kt) = (unsigned)bb[0] | ((unsigned)bb[1] << 8) | ((unsigned)bb[2] << 16) | ((unsigned)bb[3] << 24); } }
                } else {
#pragma unroll
                    for (int qt = 0; qt < 2; ++qt) { LAS unsigned* hq = hist + 16 * qt + c16; const float scale = qt ? scale1 : scale0, nls = qt ? nls1 : nls0; const int query = t0 + 16 * qt + c16;
                        unsigned char* brow = bins + (size_t)(16 * qt + c16) * 8192 + 64 * p + 4 * g4;
#pragma unroll
                        for (int kt = 0; kt < 4; ++kt) { int bb[4];
#pragma unroll
                            for (int i = 0; i < 4; ++i) { const int key = 64 * p + 16 * kt + 4 * g4 + i;
                                bb[i] = ix_bin(sacc[qt][kt][i], scale, nls); LDS_ADD(hq + bb[i] * 32, key <= query ? 1u : 0u); }
                            *(unsigned*)(brow + 16 * kt) = (unsigned)bb[0] | ((unsigned)bb[1] << 8) | ((unsigned)bb[2] << 16) | ((unsigned)bb[3] << 24); } } }
                asm volatile("" ::: "memory"); }
            __syncthreads();
#pragma unroll 1
            for (int k = 0; k < 4; ++k) { const int tq = 4 * wave + k; const int Nt = t0 + tq + 1;
                if (Nt <= TOPK) continue;
                unsigned c[4]; unsigned cs = 0;
#pragma unroll
                for (int i = 0; i < 4; ++i) { c[i] = hist[(IX_NB - 1 - (4 * lane + i)) * 32 + tq]; cs += c[i]; }
                unsigned pre = cs;
                pre = wave_iscan(pre);
                const unsigned long long mask = __ballot(pre >= (unsigned)TOPK);
                const int L = __ffsll((long long)mask) - 1;
                if (lane == L) { unsigned ex = pre - cs; int ii = 0;
#pragma unroll
                    for (int i = 0; i < 3; ++i) if (ii == i && ex + c[i] < (unsigned)TOPK) { ex += c[i]; ii = i + 1; }
                    const unsigned nin = ii == 0 ? c[0] : (ii == 1 ? c[1] : (ii == 2 ? c[2] : c[3]));
                    const int bst = IX_NB - 1 - (4 * lane + ii);
                    p_bst[tq] = bst; p_above[tq] = (int)ex;
                    const float sc_q = p_scale[tq], nls_q = p_nls[tq];
                    bool again = false;
                    if (nin > (unsigned)IX_CAP && iter < 7) { const float w1 = 1.0f / sc_q, wd = (float)IX_NB * w1, lo_q = -nls_q * w1;
                        float nlo, nwd;
                        if (bst == 0) { nwd = 2.f * wd; nlo = lo_q + w1 - nwd; }
                        else if (bst == IX_NB - 1) { nwd = 2.f * wd; nlo = lo_q + (float)(IX_NB - 1) * w1; }
                        else { nwd = w1; nlo = lo_q + (float)bst * w1; }
                        if (nwd > 1e-7f * fabsf(nlo) + 1e-36f) { const float nsc = (float)IX_NB / nwd; p_scale[tq] = nsc; p_nls[tq] = -nlo * nsc; LDS_ADD(p_notok, 1u); again = true; } }
                    (void)again; } }
            __syncthreads();
            const unsigned notok = p_notok[0];
            __syncthreads();
            for (int i = tid; i < 8192; i += NTHREADS) hist[i] = 0u;
            if (tid == 0) p_notok[0] = 0u;
            __syncthreads();
            if (notok == 0u) break;
        }
        if (MODE & 4) {
            asm volatile("s_waitcnt vmcnt(0)" ::: "memory"); __syncthreads(); __builtin_amdgcn_fence(__ATOMIC_ACQUIRE, "agent");
            const int nit = (t0 + 32 + 1023) >> 10;
            unsigned Kgt[4];
#pragma unroll
            for (int k = 0; k < 4; ++k) Kgt[k] = (unsigned)(0x7fff - p_bst[4 * wave + k]) * 0x00010001u;
            const unsigned char* brow = bins + (size_t)(4 * wave) * 8192 + 16 * lane;
            u32x4 xn[4];
#pragma unroll
            for (int k = 0; k < 4; ++k) xn[k] = *(const u32x4*)(brow + k * 8192);
#pragma unroll 1
            for (int it = 0; it < nit; ++it) {
                u32x4 xc[4];
#pragma unroll
                for (int k = 0; k < 4; ++k) xc[k] = xn[k];
                if (it + 1 < nit) {
#pragma unroll
                    for (int k = 0; k < 4; ++k) xn[k] = *(const u32x4*)(brow + k * 8192 + 1024 * (it + 1)); }
#pragma unroll
                for (int k = 0; k < 4; ++k) { const int tq = 4 * wave + k; const unsigned kgt = Kgt[k], kge = kgt + 0x00010001u;
                    const unsigned xs[4] = {xc[k].x, xc[k].y, xc[k].z, xc[k].w};
                    unsigned sel = 0u, ge = 0u;
#pragma unroll
                    for (int j = 0; j < 4; ++j) { const unsigned lo = xs[j] & 0x00ff00ffu, hi = (xs[j] >> 8) & 0x00ff00ffu;
                        { const unsigned u = (((lo + kgt) >> 15) & 0x00010001u) | (((hi + kgt) >> 14) & 0x00020002u); sel |= ((u | (u >> 14)) & 0xfu) << (4 * j); }
                        { const unsigned u = (((lo + kge) >> 15) & 0x00010001u) | (((hi + kge) >> 14) & 0x00020002u); ge |= ((u | (u >> 14)) & 0xfu) << (4 * j); } }
                    unsigned cand = ge & ~sel;
                    const int lim = t0 + tq - (1024 * it + 16 * lane);
                    const unsigned vm = lim >= 15 ? 0xffffu : (lim < 0 ? 0u : ((2u << lim) - 1u));
                    sel &= vm; cand &= vm;
                    const unsigned pk = sel | (cand << 16);
                    const unsigned other = (unsigned)__shfl_xor((int)pk, 1);
                    if (!(lane & 1)) { hist[tq * 256 + 32 * it + (lane >> 1)] = (pk & 0xffffu) | (other << 16); cmask[tq * 256 + 32 * it + (lane >> 1)] = (pk >> 16) | (other & 0xffff0000u); } }
            }
        }
        __syncthreads();
        LAS unsigned* klist = (LAS unsigned*)(C.lds + IX_LIST + wave * 1024);
        LAS float* slist = (LAS float*)(klist + 128);
        unsigned slowmask = 0u, ncs = 0u;
        if (MODE & 8) {
#pragma unroll 1
            for (int k = 0; k < 4; ++k) { const int tq = 4 * wave + k; const int Nt = t0 + tq + 1;
                const int R = TOPK - p_above[tq];
                if (Nt > TOPK && R > 0) {
                    unsigned cw[4]; unsigned cnt = 0;
#pragma unroll
                    for (int i = 0; i < 4; ++i) { cw[i] = cmask[tq * 256 + 4 * lane + i]; cnt += __popc(cw[i]); }
                    unsigned pre = cnt;
                    pre = wave_iscan(pre);
                    const unsigned tot = (unsigned)__builtin_amdgcn_readfirstlane((int)__shfl(pre, 63));
                    if (tot > 16u) slowmask |= 1u << k;
                    else { ncs |= tot << (8 * k);
                        unsigned pos = pre - cnt;
#pragma unroll
                        for (int i = 0; i < 4; ++i) { unsigned wbits = cw[i];
                            while (wbits) { const int bb = __ffs((int)wbits) - 1; wbits &= wbits - 1; klist[16 * k + pos] = (unsigned)(32 * (4 * lane + i) + bb); ++pos; } } } } }
            const int j = lane >> 4, ci = lane & 15, tqj = 4 * wave + j;
            const int ncj = (int)((ncs >> (8 * j)) & 0xffu);
            if (ci < ncj) { const unsigned key = klist[16 * j + ci]; const u32x4* kp = (const u32x4*)(IKb + (size_t)key * 64);
                unsigned kw[32];
#pragma unroll
                for (int c8 = 0; c8 < 8; ++c8) { const u32x4 w = kp[c8]; kw[4 * c8] = w.x; kw[4 * c8 + 1] = w.y; kw[4 * c8 + 2] = w.z; kw[4 * c8 + 3] = w.w; }
                const LAS float* wt = (const LAS float*)(C.lds + IX_W) + tqj;
                float sc = 0.f;
#pragma unroll
                for (int hh = 0; hh < 17; ++hh) { const LAS u32x4* qp = (const LAS u32x4*)(Qs + (hh * 32 + tqj) * IX_QROW); float d0 = 0.f, d1 = 0.f;
#pragma unroll
                    for (int c8 = 0; c8 < 8; ++c8) { const u32x4 qv = qp[c8];
                        d0 = dot2_bf16(qv.x, kw[4 * c8], d0); d1 = dot2_bf16(qv.y, kw[4 * c8 + 1], d1); d0 = dot2_bf16(qv.z, kw[4 * c8 + 2], d0); d1 = dot2_bf16(qv.w, kw[4 * c8 + 3], d1); }
                    const float dd = d0 + d1;
                    sc += hh == 16 ? dd : wt[(hh & 15) * 32] * fabsf(dd); }
                slist[16 * j + ci] = sc; }
            asm volatile("s_waitcnt lgkmcnt(0)" ::: "memory");
            if (ci < ncj) { const float ms = slist[16 * j + ci]; const unsigned mk = klist[16 * j + ci]; int rank = 0; const int Rj = TOPK - p_above[tqj];
                for (int o = 0; o < 16; ++o) { const float os = slist[16 * j + o]; const unsigned ok = klist[16 * j + o]; rank += (o < ncj && (os > ms || (os == ms && ok < mk))) ? 1 : 0; }
                if (rank < Rj) LDS_OR(hist + tqj * 256 + (mk >> 5), 1u << (mk & 31)); }
            asm volatile("s_waitcnt lgkmcnt(0)" ::: "memory");
        }
#pragma unroll 1
        for (int k = 0; k < ((MODE & 8) ? 4 : 0); ++k) { const int tq = 4 * wave + k; const int Nt = t0 + tq + 1;
            const int R = TOPK - p_above[tq];
            if ((slowmask >> k) & 1u) {
                unsigned cw[4]; unsigned cnt = 0;
#pragma unroll
                for (int i = 0; i < 4; ++i) { cw[i] = cmask[tq * 256 + 4 * lane + i]; cnt += __popc(cw[i]); }
                unsigned pre = cnt;
                pre = wave_iscan(pre);
                const unsigned tot = __shfl(pre, 63); const int nc = (int)(tot < (unsigned)IX_CAP ? tot : (unsigned)IX_CAP);
                unsigned pos = pre - cnt;
#pragma unroll
                for (int i = 0; i < 4; ++i) { unsigned wbits = cw[i];
                    while (wbits) { const int bb = __ffs((int)wbits) - 1; wbits &= wbits - 1; if (pos < (unsigned)IX_CAP) klist[pos] = (unsigned)(32 * (4 * lane + i) + bb); ++pos; } }
                const float wq = 0.5f * IW[(qrow0 + tq) * 16 + (lane & 15)];
#pragma unroll 1
                for (int ii = 0; ii < 2; ++ii) { const int ci = lane + 64 * ii;
                    if (ci < nc) { const unsigned key = klist[ci]; const u32x4* kp = (const u32x4*)(IKb + (size_t)key * 64);
                        unsigned kw[32];
#pragma unroll
                        for (int c8 = 0; c8 < 8; ++c8) { const u32x4 w = kp[c8]; kw[4 * c8] = w.x; kw[4 * c8 + 1] = w.y; kw[4 * c8 + 2] = w.z; kw[4 * c8 + 3] = w.w; }
                        float sc = 0.f;
#pragma unroll
                        for (int hh = 0; hh < 17; ++hh) { const LAS u32x4* qp = (const LAS u32x4*)(Qs + (hh * 32 + tq) * IX_QROW); float d0 = 0.f, d1 = 0.f;
#pragma unroll
                            for (int c8 = 0; c8 < 8; ++c8) { const u32x4 qv = qp[c8];
                                d0 = dot2_bf16(qv.x, kw[4 * c8], d0); d1 = dot2_bf16(qv.y, kw[4 * c8 + 1], d1); d0 = dot2_bf16(qv.z, kw[4 * c8 + 2], d0); d1 = dot2_bf16(qv.w, kw[4 * c8 + 3], d1); }
                            const float dd = d0 + d1;
                            sc += hh == 16 ? dd : __builtin_bit_cast(float, __builtin_amdgcn_readlane(__builtin_bit_cast(int, wq), hh & 15)) * fabsf(dd); }
                        slist[ci] = sc; } }
#pragma unroll 1
                for (int ii = 0; ii < 2; ++ii) { const int ci = lane + 64 * ii;
                    if (ci < nc) { const float ms = slist[ci]; const unsigned mk = klist[ci]; int rank = 0;
                        for (int o = 0; o < nc; ++o) { const float os = slist[o]; const unsigned ok = klist[o]; rank += (os > ms || (os == ms && ok < mk)) ? 1 : 0; }
                        if (rank < R) LDS_OR(hist + tq * 256 + (mk >> 5), 1u << (mk & 31)); } }
            }
            unsigned wd[4]; unsigned cnt = 0;
#pragma unroll
            for (int i = 0; i < 4; ++i) { wd[i] = hist[tq * 256 + 4 * lane + i]; cnt += __popc(wd[i]); }
            unsigned pre = cnt;
            pre = wave_iscan(pre);
            const unsigned total = __shfl(pre, 63);
            unsigned pos = pre - cnt; LAS int* olist = (LAS int*)klist;
#pragma unroll
            for (int i = 0; i < 4; ++i) { unsigned wbits = wd[i];
                while (wbits) { const int bb = __ffs((int)wbits) - 1; wbits &= wbits - 1; if (pos < (unsigned)TOPK) olist[pos] = 32 * (4 * lane + i) + bb; ++pos; } }
            asm volatile("s_waitcnt lgkmcnt(0)" ::: "memory");
            { i32x4 ov = *(const LAS i32x4*)(olist + 4 * lane); const int tl = (int)total;
                ov.x = 4 * lane + 0 < tl ? ov.x : -1; ov.y = 4 * lane + 1 < tl ? ov.y : -1; ov.z = 4 * lane + 2 < tl ? ov.z : -1; ov.w = 4 * lane + 3 < tl ? ov.w : -1;
                *((i32x4*)(IDX + (qrow0 + tq) * TOPK) + lane) = ov; }
            asm volatile("s_waitcnt lgkmcnt(0)" ::: "memory");
        }
    }
}

typedef short s16x4 __attribute__((ext_vector_type(4)));
typedef int i32x4 __attribute__((ext_vector_type(4)));
typedef __attribute__((address_space(3))) s16x4 las_s16x4;
using pg8::bf16x8;
#define MFMA16(a, b, c) __builtin_amdgcn_mfma_f32_16x16x32_bf16((a), (b), (c), 0, 0, 0)
constexpr int DS_ROW = 544, DS_IMG = 32 * DS_ROW, DS_WSTRIDE = DS_IMG + 2048, DS_BIAS = 8 * DS_WSTRIDE;
static_assert(DS_BIAS + 129 * 8 * 4 <= LDS_BYTES, "dsa LDS map");
__device__ __forceinline__ float gain_absmax(const float* g, int n, int lane) { float m = 0.f; for (int i = lane; i < n; i += 64) m = fmaxf(m, fabsf(g[i])); return wave_max(m); }

__device__ __forceinline__ void fast_dsa(Ctx& C) {
    unsigned char* ws = C.ws; const int tid = opaque_v(C.tid), lane = tid & 63, wave = C.wave;
    const bf16_t* QABS = (const bf16_t*)(ws + WS_QABS); const bf16_t* CKV = (const bf16_t*)(ws + WS_CKV); const float* KSS = (const float*)(ws + WS_KSS);
    const int* IDX = (const int*)(ws + WS_IDX); bf16_t* PC = (bf16_t*)(ws + WS_PC); const float* rel_bias = C.in[22];
    LAS unsigned char* img = C.lds + wave * DS_WSTRIDE;
    LAS int* idxs = (LAS int*)(img + DS_IMG);
    LAS unsigned* offs = (LAS unsigned*)(img + DS_IMG + 1024);
    LAS float* biasA = (LAS float*)(C.lds + DS_BIAS);
    __syncthreads();
    float bmax = 0.f;
    for (int i = tid; i < 129 * 8; i += NTHREADS) { const int dist = i >> 3, h = i & 7; const float v = h < 6 ? rel_bias[(dist < 128 ? T5_BUCKET[dist] : 31) * 18 + h] : 0.f; biasA[i] = v; }
    for (int i = lane; i < 32 * 6; i += 64) bmax = fmaxf(bmax, fabsf(rel_bias[(i / 6) * 18 + (i % 6)]));
    bmax = wave_max(bmax);
    const float bound = gain_absmax(C.in[8], 128, lane) * gain_absmax(C.in[9], 128, lane) * 11.3137085f + bmax;
    const float shift = fmaxf(0.f, bound - 30.f);
    __syncthreads();
    const int g = lane >> 4, hd = lane & 15, hq = hd & 7;
    const int xcd = C.vcu >> 5, b = xcd & 1;
    const int wl = ((xcd >> 1) * 32 + (C.vcu & 31)) * NWAVES + wave;
    const float* KSSb = KSS + (size_t)b * SEQ * 8; const bf16_t* CKVb = CKV + (size_t)b * SEQ * 256;
    i32x4 idxrow = *((const i32x4*)(IDX + ((size_t)b * SEQ + wl) * TOPK) + lane);
#pragma unroll 1
    for (int t = wl; t < SEQ; t += 1024) {
        const size_t q = (size_t)b * SEQ + t;
        { const i32x4 v = idxrow; *((LAS i32x4*)idxs + lane) = v; if (t + 1024 < SEQ) idxrow = *((const i32x4*)(IDX + (q + 1024) * TOPK) + lane);
          u32x4 o; o.x = (unsigned)(v.x < 0 ? 0 : v.x) << 9; o.y = (unsigned)(v.y < 0 ? 0 : v.y) << 9; o.z = (unsigned)(v.z < 0 ? 0 : v.z) << 9; o.w = (unsigned)(v.w < 0 ? 0 : v.w) << 9; *((LAS u32x4*)offs + lane) = o; }
        bf16x8 qb[8];
#pragma unroll
        for (int ks = 0; ks < 8; ++ks) { u32x4 w = (u32x4){0u, 0u, 0u, 0u}; if (hd < 6) w = *(const u32x4*)(QABS + q * 1536 + hd * 256 + 32 * ks + 8 * g); qb[ks] = __builtin_bit_cast(bf16x8, w); }
        f32x4 pcT[16];
#pragma unroll
        for (int rt = 0; rt < 16; ++rt) pcT[rt] = (f32x4){0.f, 0.f, 0.f, 0.f};
        float lsum = 0.f;
        u32x4 gr[16]; f32x4 ksv[2];
        const int rl = lane >> 5, cl = lane & 31;
#define DSA_GATHER(pp_) do { _Pragma("unroll") for (int i = 0; i < 16; ++i) { const unsigned ro = offs[32 * (pp_) + 2 * i + rl]; \
                gr[i] = *(const u32x4*)((const unsigned char*)CKVb + (ro + (unsigned)(cl * 16))); } \
            _Pragma("unroll") for (int tt = 0; tt < 2; ++tt) { const unsigned ro = offs[32 * (pp_) + 16 * tt + hd]; ksv[tt] = *(const f32x4*)((const unsigned char*)KSSb + ((ro >> 4) + (unsigned)(16 * (g & 1)))); } } while (0)
        DSA_GATHER(0);
#pragma unroll 1
        for (int pp = 0; pp < 8; ++pp) {
            const i32x4 kv0 = *((const LAS i32x4*)idxs + (8 * pp + g)), kv1 = *((const LAS i32x4*)idxs + (8 * pp + 4 + g));
            const int kq[8] = {kv0.x, kv0.y, kv0.z, kv0.w, kv1.x, kv1.y, kv1.z, kv1.w};
            float bv[8];
#pragma unroll
            for (int i = 0; i < 8; ++i) { const int kk = kq[i] < 0 ? 0 : kq[i]; const int dist = t - kk; bv[i] = biasA[(dist < 128 ? dist : 128) * 8 + hq]; }
#pragma unroll
            for (int i = 0; i < 16; ++i) *(LAS u32x4*)(img + (2 * i + rl) * DS_ROW + cl * 16) = gr[i];
#pragma unroll
            for (int tt = 0; tt < 2; ++tt) { f32x4 rr; rr[0] = rsqrt_f(ksv[tt][0] * (1.f / 128.f) + EPS); rr[1] = rsqrt_f(ksv[tt][1] * (1.f / 128.f) + EPS); rr[2] = rsqrt_f(ksv[tt][2] * (1.f / 128.f) + EPS); rr[3] = rsqrt_f(ksv[tt][3] * (1.f / 128.f) + EPS);
                *(LAS f32x4*)(img + (16 * tt + hd) * DS_ROW + 512 + 16 * (g & 1)) = rr; }
            asm volatile("" ::: "memory");
            if (pp < 7) DSA_GATHER(pp + 1);
            asm volatile("" ::: "memory");
            f32x4 lg[2];
#pragma unroll
            for (int tt = 0; tt < 2; ++tt) { lg[tt] = (f32x4){0.f, 0.f, 0.f, 0.f}; bf16x8 af[8];
#pragma unroll
                for (int ks = 0; ks < 8; ++ks) af[ks] = __builtin_bit_cast(bf16x8, *(const LAS u32x4*)(img + (16 * tt + hd) * DS_ROW + 64 * ks + 16 * g));
#pragma unroll
                for (int ks = 0; ks < 8; ++ks) lg[tt] = MFMA16(af[ks], qb[ks], lg[tt]); }
            float rsv[8];
#pragma unroll
            for (int i = 0; i < 8; ++i) rsv[i] = *(const LAS float*)(img + (16 * (i >> 2) + 4 * g + (i & 3)) * DS_ROW + 512 + 4 * hq);
            float p[8];
#pragma unroll
            for (int i = 0; i < 8; ++i) { const float e = __expf(lg[i >> 2][i & 3] * rsv[i] + bv[i] - shift); p[i] = kq[i] < 0 ? 0.f : e; lsum += p[i]; }
            u32x4 pw; pw.x = pg8::cvt_pk_bf16(p[0], p[1]); pw.y = pg8::cvt_pk_bf16(p[2], p[3]); pw.z = pg8::cvt_pk_bf16(p[4], p[5]); pw.w = pg8::cvt_pk_bf16(p[6], p[7]);
            const bf16x8 pb = __builtin_bit_cast(bf16x8, pw);
            const LAS unsigned char* tb = img + (4 * g + ((lane & 15) >> 2)) * DS_ROW + (lane & 3) * 8;
#pragma unroll
            for (int rh = 0; rh < 2; ++rh) { s16x4 a0[8], a1[8];
#pragma unroll
                for (int r8 = 0; r8 < 8; ++r8) { const int rt = 8 * rh + r8; a0[r8] = __builtin_amdgcn_ds_read_tr16_b64_v4i16((las_s16x4*)(tb + rt * 32)); a1[r8] = __builtin_amdgcn_ds_read_tr16_b64_v4i16((las_s16x4*)(tb + 16 * DS_ROW + rt * 32)); }
#pragma unroll
                for (int r8 = 0; r8 < 8; ++r8) { const int rt = 8 * rh + r8; const bf16x8 a = (bf16x8){a0[r8][0], a0[r8][1], a0[r8][2], a0[r8][3], a1[r8][0], a1[r8][1], a1[r8][2], a1[r8][3]};
                    pcT[rt] = MFMA16(a, pb, pcT[rt]); } }
            asm volatile("" ::: "memory");
        }
#undef DSA_GATHER
        lsum += __shfl_xor(lsum, 16); lsum += __shfl_xor(lsum, 32);
        const float linv = __builtin_amdgcn_rcpf(lsum);
        if (hd < 6) {
#pragma unroll
            for (int rt = 0; rt < 16; ++rt) { u32x2 w; w.x = pk2(pcT[rt][0] * linv, pcT[rt][1] * linv); w.y = pk2(pcT[rt][2] * linv, pcT[rt][3] * linv);
                *(u32x2*)(PC + q * 1536 + hd * 256 + 16 * rt + 4 * g) = w; } }
    }
}

template <int D, int KSTR, class F>
__device__ __forceinline__ void tile_attn_item(const LAS unsigned char* Kl, const LAS unsigned char* Vt, const u32x4 (&qf)[D / 16], int kt_lo, int kt_hi, int lane, const F& elem, f32x16 (&O)[D / 32], float& lsum) {
    const int h = lane >> 5, ql = lane & 31;
#pragma unroll
    for (int dt = 0; dt < D / 32; ++dt)
#pragma unroll
        for (int r = 0; r < 16; ++r) O[dt][r] = 0.f;
    lsum = 0.f;
#pragma unroll 1
    for (int kt = kt_lo; kt < kt_hi; ++kt) {
        f32x16 S;
#pragma unroll
        for (int r = 0; r < 16; ++r) S[r] = 0.f;
        const LAS unsigned char* kr = Kl + (32 * kt + ql) * KSTR + 16 * h;
#pragma unroll
        for (int ks = 0; ks < D / 16; ++ks) { const u32x4 ka = *(const LAS u32x4*)(kr + 32 * ks); S = MFMA32(ka, qf[ks], S); }
        float p[16];
#pragma unroll
        for (int r = 0; r < 16; ++r) { p[r] = elem(32 * kt + (r & 3) + 8 * (r >> 2) + 4 * h, S[r]); lsum += p[r]; }
        u32x4 pb[2];
#pragma unroll
        for (int s2 = 0; s2 < 2; ++s2) { pb[s2].x = pg8::cvt_pk_bf16(p[8 * s2 + 0], p[8 * s2 + 1]); pb[s2].y = pg8::cvt_pk_bf16(p[8 * s2 + 2], p[8 * s2 + 3]);
            pb[s2].z = pg8::cvt_pk_bf16(p[8 * s2 + 4], p[8 * s2 + 5]); pb[s2].w = pg8::cvt_pk_bf16(p[8 * s2 + 6], p[8 * s2 + 7]); }
#pragma unroll
        for (int dt = 0; dt < D / 32; ++dt)
#pragma unroll
            for (int s2 = 0; s2 < 2; ++s2) { const LAS unsigned char* vp = Vt + (32 * dt + ql) * 520 + (32 * kt + 16 * s2 + 4 * h) * 2;
                const u32x2 lo = *(const LAS u32x2*)vp, hi = *(const LAS u32x2*)(vp + 16);
                u32x4 va; va.x = lo.x; va.y = lo.y; va.z = hi.x; va.w = hi.y;
                O[dt] = MFMA32(va, pb[s2], O[dt]); }
    }
}

constexpr int SW_K = 0, SW_KSTR = 144, SW_VT = 256 * SW_KSTR, SW_BIAS = SW_VT + 64 * 520, SW_T = SW_BIAS + 6 * 128 * 4;
static_assert(SW_T + 8 * 32 * SW_KSTR <= LDS_BYTES - 64, "swa LDS map");
__device__ __forceinline__ void fast_swa(Ctx& C) {
    unsigned char* ws = C.ws; const int tid = opaque_v(C.tid), lane = tid & 63, wave = C.wave;
    const bf16_t* BQ = (const bf16_t*)(ws + WS_BQ); const bf16_t* BK = (const bf16_t*)(ws + WS_BK); const bf16_t* BV = (const bf16_t*)(ws + WS_BV);
    const bf16_t* GATE = (const bf16_t*)((unsigned char*)C.out + DO_GATE); bf16_t* OP = (bf16_t*)(ws + WS_OP);
    const float* sinks = C.in[12]; const float* rel_bias = C.in[22];
    LAS unsigned char* Kl = C.lds + SW_K; LAS unsigned char* Vt = C.lds + SW_VT; LAS float* bl = (LAS float*)(C.lds + SW_BIAS);
    float bmax = 0.f;
    for (int i = lane; i < 32 * 12; i += 64) bmax = fmaxf(bmax, fabsf(rel_bias[(i / 12) * 18 + 6 + (i % 12)]));
    bmax = wave_max(bmax);
    const float bound = gain_absmax(C.in[10], 64, lane) * gain_absmax(C.in[11], 64, lane) * 8.0f + bmax;
    const float shift = fmaxf(0.f, bound - 30.f);
#pragma unroll 1
    for (int u = C.vcu; u < 256; u += C.G) {
        const int b = u >> 7, g = (u >> 6) & 1, n = u & 63;
        const long s0 = (long)128 * n - 128;
        __syncthreads();
        { u32x4 kvr[4], vvr[4];
#pragma unroll
            for (int i = 0; i < 4; ++i) { const int c = tid + NTHREADS * i, kk = c >> 3, c8 = c & 7; const long sp = s0 + kk;
                kvr[i] = (u32x4){0u, 0u, 0u, 0u}; vvr[i] = (u32x4){0u, 0u, 0u, 0u};
                if (sp >= 0) { kvr[i] = *((const u32x4*)(BK + ((size_t)b * SEQ + sp) * 128 + g * 64) + c8); vvr[i] = *((const u32x4*)(BV + ((size_t)b * SEQ + sp) * 128 + g * 64) + c8); } }
#pragma unroll
            for (int i = 0; i < 4; ++i) { const int c = tid + NTHREADS * i, kk = c >> 3, c8 = c & 7;
                *(LAS u32x4*)(Kl + kk * SW_KSTR + c8 * 16) = kvr[i];
                const unsigned vw[4] = {vvr[i].x, vvr[i].y, vvr[i].z, vvr[i].w};
#pragma unroll
                for (int e = 0; e < 4; ++e) { *(LAS bf16_t*)(Vt + (c8 * 8 + 2 * e) * 520 + kk * 2) = (bf16_t)(vw[e] & 0xffff); *(LAS bf16_t*)(Vt + (c8 * 8 + 2 * e + 1) * 520 + kk * 2) = (bf16_t)(vw[e] >> 16); } } }
        for (int i = tid; i < 6 * 128; i += NTHREADS) { const int hl = i >> 7, dist = i & 127; bl[i] = rel_bias[T5_BUCKET[dist] * 18 + 6 + 6 * g + hl]; }
        __syncthreads();
#pragma unroll 1
        for (int it = wave; it < 24; it += NWAVES) {
            const int hl = it >> 2, qt = it & 3, hq = 6 * g + hl;
            const size_t qrow = (size_t)b * SEQ + 128 * n + 32 * qt + (lane & 31);
            u32x4 qf[4];
#pragma unroll
            for (int ks = 0; ks < 4; ++ks) qf[ks] = *((const u32x4*)(BQ + qrow * 768 + hq * 64) + 2 * ks + (lane >> 5));
            const int dq = 128 + 32 * qt + (lane & 31);
            const LAS float* blh = bl + hl * 128;
            auto elem = [&](int kk, float sv) -> float { const int dist = dq - kk; const bool ok = dist >= 0 && dist < 128 && (s0 + kk) >= 0;
                const float e = __expf(sv + blh[dist & 127] - shift); return ok ? e : 0.f; };
            f32x16 O[2]; float lsum;
            tile_attn_item<64, SW_KSTR>(Kl, Vt, qf, qt, qt + 5, lane, elem, O, lsum);
            lsum += __shfl_xor(lsum, 32);
            const float inv = 1.0f / (lsum + __expf(sinks[hq] - shift));
            LAS unsigned char* T = C.lds + SW_T + wave * (32 * SW_KSTR);
#pragma unroll
            for (int dt = 0; dt < 2; ++dt)
#pragma unroll
                for (int r4 = 0; r4 < 4; ++r4) { u32x2 w; w.x = pk2(O[dt][4 * r4 + 0] * inv, O[dt][4 * r4 + 1] * inv); w.y = pk2(O[dt][4 * r4 + 2] * inv, O[dt][4 * r4 + 3] * inv);
                    *(LAS u32x2*)(T + (lane & 31) * SW_KSTR + (32 * dt + 8 * r4 + 4 * (lane >> 5)) * 2) = w; }
            asm volatile("s_waitcnt lgkmcnt(0)" ::: "memory");
            const size_t qb0 = (size_t)b * SEQ + 128 * n + 32 * qt;
#pragma unroll
            for (int i = 0; i < 4; ++i) { const int rw = 8 * i + (lane >> 3), ch = lane & 7; const size_t ob = (qb0 + rw) * 2048 + 768 + hq * 64 + 8 * ch;
                const u32x4 ov = *(const LAS u32x4*)(T + rw * SW_KSTR + ch * 16); const u32x4 gw = *(const u32x4*)(GATE + ob);
                u32x2 o8;
                o8.x = pk4_fp8(16.f * bf2f(ov.x & 0xffff) * bf2f(gw.x & 0xffff), 16.f * bf2f(ov.x >> 16) * bf2f(gw.x >> 16), 16.f * bf2f(ov.y & 0xffff) * bf2f(gw.y & 0xffff), 16.f * bf2f(ov.y >> 16) * bf2f(gw.y >> 16));
                o8.y = pk4_fp8(16.f * bf2f(ov.z & 0xffff) * bf2f(gw.z & 0xffff), 16.f * bf2f(ov.z >> 16) * bf2f(gw.z >> 16), 16.f * bf2f(ov.w & 0xffff) * bf2f(gw.w & 0xffff), 16.f * bf2f(ov.w >> 16) * bf2f(gw.w >> 16));
                *(u32x2*)((unsigned char*)OP + ob) = o8; }
            asm volatile("s_waitcnt lgkmcnt(0)" ::: "memory");
        }
    }
}
constexpr int MA_K = 0, MA_KSTR = 272, MA_VT = 256 * MA_KSTR;
static_assert(MA_VT + 128 * 520 <= LDS_BYTES, "mem-attn LDS map");
__device__ __forceinline__ void fast_mem(Ctx& C) {
    unsigned char* ws = C.ws; const int tid = opaque_v(C.tid), lane = tid & 63, wave = C.wave;
    const bf16_t* CQ = (const bf16_t*)(ws + WS_CQ); const bf16_t* KC = (const bf16_t*)(ws + WS_KC); const bf16_t* VC = (const bf16_t*)(ws + WS_VC);
    const bf16_t* GATE = (const bf16_t*)((unsigned char*)C.out + DO_GATE); bf16_t* OP = (bf16_t*)(ws + WS_OP);
    LAS unsigned char* Kl = C.lds + MA_K; LAS unsigned char* Vt = C.lds + MA_VT;
    const float bound = gain_absmax(C.in[15], 128, lane) * gain_absmax(C.in[16], 128, lane) * 11.3137085f;
    const float shift = fmaxf(0.f, bound - 30.f);
#pragma unroll 1
    for (int u = C.vcu; u < 256; u += C.G) {
        const int b = u >> 7, h = (u >> 5) & 3, n = u & 31;
        __syncthreads();
        { u32x4 kvr[8], vvr[8];
#pragma unroll
            for (int i = 0; i < 8; ++i) { const int c = tid + NTHREADS * i, kk = c >> 4, c8 = c & 15;
                kvr[i] = *((const u32x4*)(KC + ((size_t)b * MEMLEN + kk) * 512 + h * 128) + c8); vvr[i] = *((const u32x4*)(VC + ((size_t)b * MEMLEN + kk) * 512 + h * 128) + c8); }
#pragma unroll
            for (int i = 0; i < 8; ++i) { const int c = tid + NTHREADS * i, kk = c >> 4, c8 = c & 15;
                *(LAS u32x4*)(Kl + kk * MA_KSTR + c8 * 16) = kvr[i];
                const unsigned vw[4] = {vvr[i].x, vvr[i].y, vvr[i].z, vvr[i].w};
#pragma unroll
                for (int e = 0; e < 4; ++e) { *(LAS bf16_t*)(Vt + (c8 * 8 + 2 * e) * 520 + kk * 2) = (bf16_t)(vw[e] & 0xffff); *(LAS bf16_t*)(Vt + (c8 * 8 + 2 * e + 1) * 520 + kk * 2) = (bf16_t)(vw[e] >> 16); } } }
        __syncthreads();
        {
            const size_t qrow = (size_t)b * SEQ + 256 * n + 32 * wave + (lane & 31);
            u32x4 qf[8];
#pragma unroll
            for (int ks = 0; ks < 8; ++ks) qf[ks] = *((const u32x4*)(CQ + qrow * 512 + h * 128) + 2 * ks + (lane >> 5));
            auto elem = [&](int, float sv) -> float { return __expf(sv - shift); };
            f32x16 O[4]; float lsum;
            tile_attn_item<128, MA_KSTR>(Kl, Vt, qf, 0, 8, lane, elem, O, lsum);
            lsum += __shfl_xor(lsum, 32);
            const float inv = 1.0f / lsum;
            __syncthreads();
            LAS unsigned char* T = C.lds + wave * (32 * MA_KSTR);
#pragma unroll
            for (int dt = 0; dt < 4; ++dt)
#pragma unroll
                for (int r4 = 0; r4 < 4; ++r4) { u32x2 w; w.x = pk2(O[dt][4 * r4 + 0] * inv, O[dt][4 * r4 + 1] * inv); w.y = pk2(O[dt][4 * r4 + 2] * inv, O[dt][4 * r4 + 3] * inv);
                    *(LAS u32x2*)(T + (lane & 31) * MA_KSTR + (32 * dt + 8 * r4 + 4 * (lane >> 5)) * 2) = w; }
            asm volatile("s_waitcnt lgkmcnt(0)" ::: "memory");
            const size_t qb0 = (size_t)b * SEQ + 256 * n + 32 * wave;
#pragma unroll
            for (int i = 0; i < 8; ++i) { const int rw = 4 * i + (lane >> 4), ch = lane & 15; const size_t ob = (qb0 + rw) * 2048 + 1536 + h * 128 + 8 * ch;
                const u32x4 ov = *(const LAS u32x4*)(T + rw * MA_KSTR + ch * 16); const u32x4 gw = *(const u32x4*)(GATE + ob);
                u32x2 o8;
                o8.x = pk4_fp8(16.f * bf2f(ov.x & 0xffff) * bf2f(gw.x & 0xffff), 16.f * bf2f(ov.x >> 16) * bf2f(gw.x >> 16), 16.f * bf2f(ov.y & 0xffff) * bf2f(gw.y & 0xffff), 16.f * bf2f(ov.y >> 16) * bf2f(gw.y >> 16));
                o8.y = pk4_fp8(16.f * bf2f(ov.z & 0xffff) * bf2f(gw.z & 0xffff), 16.f * bf2f(ov.z >> 16) * bf2f(gw.z >> 16), 16.f * bf2f(ov.w & 0xffff) * bf2f(gw.w & 0xffff), 16.f * bf2f(ov.w >> 16) * bf2f(gw.w >> 16));
                *(u32x2*)((unsigned char*)OP + ob) = o8; }
        }
    }
}

__global__ void __launch_bounds__(NTHREADS, 2) mk_fwd(Args args) {
    extern __shared__ __attribute__((aligned(16))) unsigned char lds_raw[];
    Ctx C;
    C.in = args.in;
    C.out = args.out; C.ws = args.ws;
    C.lds = (LAS unsigned char*)lds_raw;
    C.tid = threadIdx.x; C.lane = C.tid & 63; C.wave = __builtin_amdgcn_readfirstlane(C.tid >> 6);
    C.G = gridDim.x; { const int bx = blockIdx.x; C.vcu = (C.G % 8 == 0) ? (bx % 8) * (C.G / 8) + bx / 8 : bx; }
    cg::grid_group grid = cg::this_grid();
    volatile LAS unsigned* bst = (volatile LAS unsigned*)(C.lds + LDS_BYTES - 64);
    if (C.tid < 16) bst[C.tid] = 0u;
    __syncthreads();
    if (blockIdx.x == 0) { unsigned* bw = (unsigned*)(args.ws + WS_CTL); for (int i = C.tid; i < XCD_BAR_WORDS; i += NTHREADS) bw[i] = 0u; }
    XcdBarrier xbar;
    const int lo = args.ph_lo, hi = args.ph_hi;
    unsigned char* ws = C.ws;
#ifndef PHMASK
#define PHMASK 0x7f
#endif
#define IN(k) (((PHMASK >> (k)) & 1) && lo <= (k) && (k) < hi)
#define SEAM(k) do { if (IN(k) && IN((k) + 1)) { if ((k) == 0) grid.sync(); else xcd_barrier(xbar); } } while (0)
    const int bx = (int)blockIdx.x;

    if (IN(0)) { p0_prologue(C); }
    grid.sync();
    xbar = xcd_barrier_post((unsigned*)(args.ws + WS_CTL), bst);
    if (IN(1)) {
        EpiIn E{C.lds, ws, (unsigned char*)C.out, C.in, 0, 1};
        { pg8::Gemm g{(const bf16_t*)(ws + WS_H), (const bf16_t*)(ws + WS_WINT), M, NWIN_A, 2048, 2048, 2048, 0}; pg8::StaticOrder S; S.init(M, NWIN_A, C.G, bx);
          pg8::gemm_phase<EpiIn, pg8::StaticOrder>(C.lds, g, S, E); }
        {
          pg8::Gemm g{(const bf16_t*)(ws + WS_H8), (const bf16_t*)(ws + WS_WMIX8), M, NWIN_B, 2048, 2048, 2048, 0}; pg8::StaticOrder S; S.init(M, NWIN_B, C.G, bx);
          E.pnoff = 2;
          pg8::gemm_phase<EpiIn, pg8::StaticOrder, true, true, true>(C.lds, g, S, E); E.pnoff = 0; }
        { E.memkv = 1; pg8::Gemm g{(const bf16_t*)(ws + WS_MEMN), (const bf16_t*)(ws + WS_WMEMT), BATCH * MEMLEN, 1024, 2048, 2048, 2048, 0}; pg8::StaticOrder S; S.init(BATCH * MEMLEN, 1024, C.G, (bx + 64) % C.G);
          pg8::gemm_phase<EpiIn, pg8::StaticOrder>(C.lds, g, S, E); }
    }
    SEAM(1);
    if (IN(2)) {
        { pg8::Gemm g{(const bf16_t*)(ws + WS_CKV), (const bf16_t*)(ws + WS_WKT), M, 768, 256, 256, 256, 0}; pg8::StaticOrder S; S.init(M, 768, C.G, bx);
          EpiKss E{(float*)(ws + WS_KSS)};
          pg8::gemm_phase<EpiKss, pg8::StaticOrder>(C.lds, g, S, E); }
        { int kq = 128; asm volatile("" : "+s"(kq));
          pg8::Gemm g{(const bf16_t*)(ws + WS_QA), (const bf16_t*)(ws + WS_WQBD), M, 1536, kq, 768, 128, 128}; pg8::StaticOrder S; S.init(M, 1536, C.G, bx);
          EpiBf E{(bf16_t*)(ws + WS_QABS), 1536};
          pg8::gemm_phase<EpiBf, pg8::StaticOrder>(C.lds, g, S, E); }
        fast_indexer<15>(C, (int*)(ws + WS_IDX));
        __syncthreads();
        fast_swa(C);
        __syncthreads();
        fast_mem(C);
    }
    SEAM(2);
    if (IN(3)) { fast_dsa(C); }
    SEAM(3);
    if (IN(4)) {
        pg8::Gemm g{(const bf16_t*)(ws + WS_PC), (const bf16_t*)(ws + WS_WVBD), M, 768, 512, 1536, 512, 512}; pg8::StaticOrder S; S.init(M, 768, C.G, bx);
        EpiGateMul E{(bf16_t*)(ws + WS_OP), (const bf16_t*)((unsigned char*)C.out + DO_GATE)};
        pg8::gemm_phase<EpiGateMul, pg8::StaticOrder>(C.lds, g, S, E);
    }
    SEAM(4);
    if (IN(5)) {
        pg8::Gemm g{(const bf16_t*)(ws + WS_OP), (const bf16_t*)(ws + WS_WUPT), M, 2048, 2048, 2048, 2048, 0, 0x7b7b7b7b, 0x7a7a7a7a}; pg8::StaticOrder S; S.init(M, 2048, C.G, bx);
        EpiMerge E{(bf16_t*)(ws + WS_MERGED), (const bf16_t*)(ws + WS_BIG), 6, 12};
        pg8::gemm_phase<EpiMerge, pg8::StaticOrder, true, true, true>(C.lds, g, S, E);
    }
    SEAM(5);
    if (IN(6)) {
        pg8::Gemm g{(const bf16_t*)(ws + WS_MERGED), (const bf16_t*)(ws + WS_WOT), M, 2048, 2048, 2048, 2048, 0, 0x7b7b7b7b, 0x79797979}; pg8::StaticOrder S; S.init(M, 2048, C.G, bx);
        EpiOut E{C.out, C.in[0]};
        pg8::gemm_phase<EpiOut, pg8::StaticOrder, true, true, true>(C.lds, g, S, E);
    }
#undef IN
#undef SEAM
}

extern "C" void kernel_launch(void* const* d_in, const int* in_sizes, int n_in, void* d_out, int out_size, void* d_ws, size_t ws_size, hipStream_t stream) {
    static int grid = 0;
    if (grid == 0) {
        if (n_in != 23 || out_size != M * DM || ws_size < WS_END) { fprintf(stderr, "kernel_launch: unexpected shapes (n_in %d out %d ws %zu)\n", n_in, out_size, ws_size); grid = -1; return; }
        int dev = 0, cus = 0, per_cu = 0;
        hipGetDevice(&dev); hipDeviceGetAttribute(&cus, hipDeviceAttributeMultiprocessorCount, dev);
        hipFuncSetAttribute((const void*)mk_fwd, hipFuncAttributeMaxDynamicSharedMemorySize, LDS_BYTES);
        hipOccupancyMaxActiveBlocksPerMultiprocessor(&per_cu, (const void*)mk_fwd, NTHREADS, LDS_BYTES);
        if (per_cu < 1) { fprintf(stderr, "kernel_launch: occupancy query says %d blocks/CU\n", per_cu); per_cu = 1; }
        (void)hipGetLastError();
        grid = cus;
    }
    if (grid < 0) return;
    Args a{};
    for (int i = 0; i < 23; ++i) a.in[i] = (const float*)d_in[i];
    a.out = (float*)d_out; a.ws = (unsigned char*)d_ws;
#if MK_SINGLE
    a.ph_lo = 0; a.ph_hi = 7; a.single = 1;
    void* kargs[] = {&a};
    hipError_t e = hipLaunchCooperativeKernel((const void*)mk_fwd, dim3(grid), dim3(NTHREADS), kargs, LDS_BYTES, stream);
    if (e != hipSuccess) fprintf(stderr, "cooperative launch failed: %s (grid %d)\n", hipGetErrorString(e), grid);
#else
    for (int p = 0; p < 7; ++p) { a.ph_lo = p; a.ph_hi = p + 1; a.single = 0;
        hipLaunchKernelGGL(mk_fwd, dim3(grid), dim3(NTHREADS), LDS_BYTES, stream, a); }
#endif
}
```

```cpp
#include <hip/hip_runtime.h>
#include <hip/hip_cooperative_groups.h>
#include <cstdio>
#include <cstdint>
namespace cg = cooperative_groups;

#ifndef MK_SINGLE
#define MK_SINGLE 1
#endif

namespace pg8 {
#define PG8_LAS __attribute__((address_space(3)))
typedef unsigned short bf16_t;
typedef short bf16x8 __attribute__((ext_vector_type(8)));
typedef float f32x4 __attribute__((ext_vector_type(4)));
typedef unsigned u32x4 __attribute__((ext_vector_type(4)));
typedef unsigned u32x2 __attribute__((ext_vector_type(2)));
constexpr int BM = 256, BK = 64, HALF = 128, HTB = HALF * BK * 2, STAGE_BYTES = 8 * HTB, NXCD = 8, WGM = 2;

__host__ __device__ __forceinline__ int lds_byte(int r, int c) { const int st = (r >> 4) * 2 + (c >> 5), rr = r & 15, cc = c & 31, ob = rr * 64 + cc * 2; return st * 1024 + (ob ^ (((ob >> 9) & 1) << 5)); }
__host__ __device__ __forceinline__ void stage_rc(int b, int& R, int& C) { const int st = b / 1024, sb = b % 1024, swz = sb ^ (((sb >> 9) & 1) << 5); R = (st >> 1) * 16 + swz / 64; C = (st & 1) * 32 + (swz % 64) / 2; }
__host__ __device__ __forceinline__ int perm32(int rho) { const int n = rho >> 4, i = rho & 15; return 8 * (i >> 2) + 4 * n + (i & 3); }

struct Unit { int pm, pn; };
struct Gemm { const bf16_t* A; const bf16_t* Bt; int M, N, K, lda, ldb, akoff; int sca = 0x7f7f7f7f, scb = 0x79797979; };

struct StaticOrder {
    int nM, nN, nwg, G, c;
    __host__ __device__ void init(int M, int N, int G_, int c_) { nM = M / BM; nN = N / BM; nwg = nM * nN; G = G_; c = c_; }
    __host__ __device__ bool next(int i, Unit& u) const {
        const long L = (long)i * G + c; if (L >= nwg) return false;
        int wgid = (int)L; { const int q = nwg / NXCD, r = nwg % NXCD, xcd = wgid % NXCD, off = wgid / NXCD; wgid = (xcd < r ? xcd * (q + 1) : r * (q + 1) + (xcd - r) * q) + off; }
        const int nig = WGM * nN, gid = wgid / nig, fm = gid * WGM, gsz = (nM - fm) < WGM ? (nM - fm) : WGM;
        u.pm = fm + ((wgid % nig) % gsz); u.pn = (wgid % nig) / gsz; return true;
    }
    __device__ __forceinline__ void a_ready(const Unit&) const {}
    __device__ __forceinline__ void done(const Unit&) const {}
};

typedef int i32x8 __attribute__((ext_vector_type(8)));
typedef int i32x4v __attribute__((ext_vector_type(4)));
__device__ __forceinline__ unsigned cvt_pk_bf16(float lo, float hi) { unsigned r; asm volatile("v_cvt_pk_bf16_f32 %0, %1, %2" : "=v"(r) : "v"(lo), "v"(hi)); return r; }

template <class Epi, class Sched, bool ALIGN_EPI = true, bool SP2 = true, bool F8 = false>
__device__ __forceinline__ void gemm_phase(PG8_LAS unsigned char* lds, const Gemm g, const Sched& S, const Epi& E) {
    const int tid = threadIdx.x, wid = __builtin_amdgcn_readfirstlane(tid >> 6), lane = tid & 63, wr = wid >> 2, wc = wid & 3, fr = lane & 15, fq = lane >> 4;
    constexpr int ES = F8 ? 1 : 2;
    const int nt = g.K / (F8 ? 2 * BK : BK);
    unsigned voffA[2], voffB[2];
#pragma unroll
    for (int i = 0; i < 2; ++i) { int R, C; stage_rc(tid * 16 + i * 8192, R, C); const int Rb = Epi::PERM ? ((R & ~31) + perm32(R & 31)) : R;
        voffA[i] = (unsigned)(R * g.lda * ES + C * 2); voffB[i] = (unsigned)(Rb * g.ldb * ES + C * 2); }
    const size_t kstep = (size_t)(BK * 2);
    const size_t hstepA = (size_t)HALF * g.lda * ES, hstepB = (size_t)HALF * g.ldb * ES;
    const size_t tstepA = 2 * hstepA, tstepB = 2 * hstepB;
    const unsigned ldsw = (unsigned)wid * 1024u;
    const int aoff = F8 ? lds_byte(wr * 64 + fr, (fq >> 1) * 32 + (fq & 1) * 16) : lds_byte(wr * 64 + fr, fq * 8), boff = F8 ? lds_byte(wc * 32 + fr, (fq >> 1) * 32 + (fq & 1) * 16) : lds_byte(wc * 32 + fr, fq * 8);
#define PG8_SA(b, h) (((b) * 2 + (h)) * HTB)
#define PG8_SB(b, h) ((4 + (b) * 2 + (h)) * HTB)
#define PG8_STAGE(bufoff, gbase, voff) do { _Pragma("unroll") for (int _i = 0; _i < 2; ++_i) \
        __builtin_amdgcn_global_load_lds((const unsigned*)((const char*)(gbase) + (voff)[_i]), (PG8_LAS unsigned*)(lds + (bufoff) + ldsw + _i * 8192), 16, 0, 0); } while (0)
#define PG8_LD8(p) __builtin_shufflevector(*(const PG8_LAS i32x4v*)(p), *(const PG8_LAS i32x4v*)((p) + 16), 0, 1, 2, 3, 4, 5, 6, 7)
#define PG8_LDA(dst, b, h) do { _Pragma("unroll") for (int m = 0; m < 4; ++m) { if constexpr (F8) dst##8[m] = PG8_LD8(lds + PG8_SA(b, h) + aoff + m * 2048); else { _Pragma("unroll") for (int k = 0; k < 2; ++k) dst[m][k] = *(const PG8_LAS bf16x8*)(lds + PG8_SA(b, h) + aoff + m * 2048 + k * 1024); } } } while (0)
#define PG8_LDB(dst, b, h) do { _Pragma("unroll") for (int n = 0; n < 2; ++n) { if constexpr (F8) dst##8[n] = PG8_LD8(lds + PG8_SB(b, h) + boff + n * 2048); else { _Pragma("unroll") for (int k = 0; k < 2; ++k) dst[n][k] = *(const PG8_LAS bf16x8*)(lds + PG8_SB(b, h) + boff + n * 2048 + k * 1024); } } } while (0)
#define PG8_MMA(ai, bj, At, Bt) do { __builtin_amdgcn_s_setprio(1); _Pragma("unroll") for (int m = 0; m < 4; ++m) _Pragma("unroll") for (int n = 0; n < 2; ++n) { \
        if constexpr (F8) { asm volatile("s_nop 1\n\tv_mfma_scale_f32_16x16x128_f8f6f4 %0, %1, %2, %0, %3, %4 op_sel_hi:[0,0,0]" : "+v"(acc[ai][bj][m][n]) : "v"(Bt##8[n]), "v"(At##8[m]), "v"(sc_b), "v"(sc_a)); } \
        else { _Pragma("unroll") for (int k = 0; k < 2; ++k) acc[ai][bj][m][n] = __builtin_amdgcn_mfma_f32_16x16x32_bf16(Bt[n][k], At[m][k], acc[ai][bj][m][n], 0, 0, 0); } } \
        if constexpr (F8) asm volatile("s_nop 7" ::: "memory"); __builtin_amdgcn_s_setprio(0); } while (0)
#define PG8_WAIT_V(n) asm volatile("s_waitcnt vmcnt(" #n ")" ::: "memory")
#define PG8_WAIT_L(n) asm volatile("s_waitcnt lgkmcnt(" #n ")" ::: "memory")
#define PG8_BAR __builtin_amdgcn_s_barrier()
#define PG8_SCHED __builtin_amdgcn_sched_barrier(0)
    Unit cur, nxt; int ui = 0;
    if (!S.next(0, cur)) return;
    f32x4 acc[2][2][4][2];
#pragma unroll
    for (int a = 0; a < 2; ++a)
#pragma unroll
        for (int b = 0; b < 2; ++b)
#pragma unroll
            for (int m = 0; m < 4; ++m)
#pragma unroll
                for (int n = 0; n < 2; ++n) acc[a][b][m][n] = (f32x4){0.f, 0.f, 0.f, 0.f};
    if constexpr (F8) { _Pragma("unroll") for (int a = 0; a < 2; ++a) _Pragma("unroll") for (int b = 0; b < 2; ++b)
        asm volatile("s_nop 7" : "+v"(acc[a][b][0][0]), "+v"(acc[a][b][0][1]), "+v"(acc[a][b][1][0]), "+v"(acc[a][b][1][1]), "+v"(acc[a][b][2][0]), "+v"(acc[a][b][2][1]), "+v"(acc[a][b][3][0]), "+v"(acc[a][b][3][1])); }
    bf16x8 At[4][2], B0[2][2], B1[2][2]; i32x8 At8[4], B08[2], B18[2];
    int sc_a = g.sca, sc_b = g.scb;
    asm volatile("" : "+v"(sc_a), "+v"(sc_b));
    const char* cA = (const char*)g.A + (size_t)cur.pm * tstepA + (size_t)cur.pn * g.akoff * ES; const char* cB = (const char*)g.Bt + (size_t)cur.pn * tstepB;
    S.a_ready(cur);
    if constexpr (SP2) {
        PG8_STAGE(PG8_SB(0, 0), cB, voffB); PG8_STAGE(PG8_SB(0, 1), cB + hstepB, voffB); PG8_STAGE(PG8_SA(0, 0), cA, voffA); PG8_STAGE(PG8_SA(0, 1), cA + hstepA, voffA);
        if (wr == 1) PG8_BAR;
        PG8_WAIT_V(2); PG8_BAR;
        PG8_STAGE(PG8_SB(1, 0), cB + kstep, voffB); PG8_STAGE(PG8_SA(1, 0), cA + kstep, voffA); PG8_STAGE(PG8_SB(1, 1), cB + hstepB + kstep, voffB);
        PG8_WAIT_V(6); PG8_BAR;
    } else {
        PG8_STAGE(PG8_SB(0, 0), cB, voffB); PG8_STAGE(PG8_SA(0, 0), cA, voffA); PG8_STAGE(PG8_SB(0, 1), cB + hstepB, voffB); PG8_STAGE(PG8_SA(0, 1), cA + hstepA, voffA);
        if (wr == 1) PG8_BAR;
        PG8_WAIT_V(4); PG8_BAR;
        PG8_STAGE(PG8_SB(1, 0), cB + kstep, voffB); PG8_STAGE(PG8_SA(1, 0), cA + kstep, voffA); PG8_STAGE(PG8_SB(1, 1), cB + hstepB + kstep, voffB);
        PG8_WAIT_V(6); PG8_BAR;
    }
    for (;;) {
        const bool has_next = S.next(ui + 1, nxt);
        const char* nA = has_next ? (const char*)g.A + (size_t)nxt.pm * tstepA + (size_t)nxt.pn * g.akoff * ES : cA; const char* nB = has_next ? (const char*)g.Bt + (size_t)nxt.pn * tstepB : cB;
#pragma unroll 1
        for (int t = 0; t < nt; t += 2) {
            const bool last = (t == nt - 2);
            const char* a1 = cA + (size_t)(t + 1) * kstep;
            const char* a2 = last ? nA : cA + (size_t)(t + 2) * kstep; const char* b2 = last ? nB : cB + (size_t)(t + 2) * kstep;
            const char* a3 = a2 + kstep; const char* b3 = b2 + kstep;
            if (last && has_next) S.a_ready(nxt);
            if constexpr (Epi::HAS_MID) { if (t == E.mid_t0 || t == E.mid_t1) E.mid(acc, cur, t, wr, wc, fr, fq); }
            if constexpr (SP2) {
            PG8_LDB(B0, 0, 0); PG8_LDB(B1, 0, 1); PG8_SCHED; PG8_LDA(At, 0, 0); PG8_STAGE(PG8_SA(1, 1), a1 + hstepA, voffA);
            PG8_WAIT_V(8); PG8_WAIT_L(0); PG8_BAR; PG8_MMA(0, 0, At, B0); PG8_MMA(0, 1, At, B1); PG8_BAR; PG8_SCHED;
            PG8_LDA(At, 0, 1); PG8_STAGE(PG8_SB(0, 0), b2, voffB); PG8_STAGE(PG8_SB(0, 1), b2 + hstepB, voffB); PG8_STAGE(PG8_SA(0, 0), a2, voffA);
            PG8_WAIT_V(8); PG8_WAIT_L(0); PG8_BAR; PG8_MMA(1, 0, At, B0); PG8_MMA(1, 1, At, B1); PG8_BAR; PG8_SCHED;
            PG8_LDB(B0, 1, 0); PG8_LDB(B1, 1, 1); PG8_SCHED; PG8_LDA(At, 1, 0); PG8_STAGE(PG8_SA(0, 1), a2 + hstepA, voffA);
            PG8_WAIT_V(8); PG8_WAIT_L(0); PG8_BAR; PG8_MMA(0, 0, At, B0); PG8_MMA(0, 1, At, B1); PG8_BAR; PG8_SCHED;
            PG8_LDA(At, 1, 1); PG8_STAGE(PG8_SB(1, 0), b3, voffB); PG8_STAGE(PG8_SB(1, 1), b3 + hstepB, voffB); PG8_STAGE(PG8_SA(1, 0), a3, voffA);
            PG8_WAIT_V(8); PG8_WAIT_L(0); PG8_BAR; PG8_MMA(1, 0, At, B0); PG8_MMA(1, 1, At, B1); PG8_BAR; PG8_SCHED;
            } else {
            PG8_LDB(B0, 0, 0); PG8_SCHED; PG8_LDA(At, 0, 0); PG8_STAGE(PG8_SA(1, 1), a1 + hstepA, voffA);
            PG8_WAIT_L(8); PG8_BAR; PG8_WAIT_L(0); PG8_MMA(0, 0, At, B0); PG8_BAR; PG8_SCHED;
            PG8_LDB(B1, 0, 1); PG8_STAGE(PG8_SB(0, 0), b2, voffB);
            PG8_BAR; PG8_WAIT_L(0); PG8_MMA(0, 1, At, B1); PG8_BAR;
            PG8_LDA(At, 0, 1); PG8_STAGE(PG8_SA(0, 0), a2, voffA);
            PG8_BAR; PG8_WAIT_L(0); PG8_MMA(1, 0, At, B0); PG8_BAR; PG8_SCHED;
            PG8_STAGE(PG8_SB(0, 1), b2 + hstepB, voffB);
            PG8_WAIT_V(6); PG8_BAR; PG8_MMA(1, 1, At, B1); PG8_BAR;
            PG8_LDB(B0, 1, 0); PG8_SCHED; PG8_LDA(At, 1, 0); PG8_STAGE(PG8_SA(0, 1), a2 + hstepA, voffA);
            PG8_WAIT_L(8); PG8_BAR; PG8_WAIT_L(0); PG8_MMA(0, 0, At, B0); PG8_BAR; PG8_SCHED;
            PG8_LDB(B1, 1, 1); PG8_STAGE(PG8_SB(1, 0), b3, voffB);
            PG8_BAR; PG8_WAIT_L(0); PG8_MMA(0, 1, At, B1); PG8_BAR;
            PG8_LDA(At, 1, 1); PG8_STAGE(PG8_SA(1, 0), a3, voffA);
            PG8_BAR; PG8_WAIT_L(0); PG8_MMA(1, 0, At, B0); PG8_BAR; PG8_SCHED;
            PG8_STAGE(PG8_SB(1, 1), b3 + hstepB, voffB);
            PG8_WAIT_V(6); PG8_BAR; PG8_MMA(1, 1, At, B1); PG8_BAR;
            }
        }
        if constexpr (ALIGN_EPI) { if (wr == 0) PG8_BAR; }
        if constexpr (F8) { _Pragma("unroll") for (int a = 0; a < 2; ++a) _Pragma("unroll") for (int b = 0; b < 2; ++b)
            asm volatile("s_nop 15\n\ts_nop 15" : "+v"(acc[a][b][0][0]), "+v"(acc[a][b][0][1]), "+v"(acc[a][b][1][0]), "+v"(acc[a][b][1][1]), "+v"(acc[a][b][2][0]), "+v"(acc[a][b][2][1]), "+v"(acc[a][b][3][0]), "+v"(acc[a][b][3][1])); }
        E(acc, cur, wr, wc, fr, fq);
        if (!has_next) break;
#pragma unroll
        for (int a = 0; a < 2; ++a)
#pragma unroll
            for (int b = 0; b < 2; ++b)
#pragma unroll
                for (int m = 0; m < 4; ++m)
#pragma unroll
                    for (int n = 0; n < 2; ++n) acc[a][b][m][n] = (f32x4){0.f, 0.f, 0.f, 0.f};
        if constexpr (F8) { _Pragma("unroll") for (int a = 0; a < 2; ++a) _Pragma("unroll") for (int b = 0; b < 2; ++b)
        asm volatile("s_nop 7" : "+v"(acc[a][b][0][0]), "+v"(acc[a][b][0][1]), "+v"(acc[a][b][1][0]), "+v"(acc[a][b][1][1]), "+v"(acc[a][b][2][0]), "+v"(acc[a][b][2][1]), "+v"(acc[a][b][3][0]), "+v"(acc[a][b][3][1])); }
        cur = nxt; cA = nA; cB = nB; ++ui;
        if constexpr (ALIGN_EPI) { if (wr == 1) PG8_BAR; }
    }
    PG8_WAIT_V(0);
    if constexpr (!ALIGN_EPI) { if (wr == 0) PG8_BAR; }
    PG8_BAR;
#undef PG8_SA
#undef PG8_SB
#undef PG8_STAGE
#undef PG8_LDA
#undef PG8_LDB
#undef PG8_MMA
#undef PG8_WAIT_V
#undef PG8_WAIT_L
#undef PG8_BAR
#undef PG8_SCHED
}
}

using pg8::bf16_t; using pg8::f32x4; using pg8::u32x4; using pg8::u32x2;
#define LAS __attribute__((address_space(3)))
constexpr int BATCH = 2, SEQ = 8192, DM = 2048, M = BATCH * SEQ, MEMLEN = 256;
constexpr int IN_COLS = 11856, NWIN = 12032, NWIN_A = 1792, NWIN_B = 10240;
constexpr int RAWW = 2816;
constexpr int TOPK = 256;
constexpr float EPS = 1e-6f;
constexpr int NWAVES = 8, NTHREADS = 512;
constexpr int LDS_BYTES = 163840;
constexpr int NPH = 8;

constexpr size_t MiB = 1u << 20;
constexpr size_t WS_CTL = 0;
constexpr size_t WS_WMEMT = 1 * MiB, WS_WKT = 5 * MiB, WS_WQBD = 6 * MiB, WS_WVBD = 9 * MiB, WS_WUPT = 12 * MiB, WS_WOT = 20 * MiB;
constexpr size_t WS_WINT = 28 * MiB;
constexpr size_t WS_QABS = WS_WINT;
constexpr size_t WS_WMIX8 = WS_WINT + 16 * MiB;
constexpr size_t WS_H = 76 * MiB;
constexpr size_t WS_OP = WS_H;
constexpr size_t WS_BIG = 140 * MiB;
constexpr size_t WS_QA = 332 * MiB, WS_CKV = 356 * MiB, WS_IK = 364 * MiB, WS_IW = 366 * MiB, WS_BQ = 367 * MiB, WS_BK = 391 * MiB, WS_BV = 395 * MiB, WS_CQ = 399 * MiB;
constexpr size_t WS_KC = 415 * MiB, WS_VC = 416 * MiB, WS_KSS = 417 * MiB;
constexpr size_t WS_MERGED = 332 * MiB;
constexpr size_t WS_H8 = 438 * MiB;
constexpr size_t WS_MEMN = 418 * MiB, WS_RAWM = 420 * MiB, WS_IDX = 422 * MiB, WS_PC = 438 * MiB, WS_END = 486 * MiB;
constexpr size_t DO_GATE = 0, DO_IQ = 64 * MiB;

__device__ const unsigned char T5_BUCKET[128] = {
0,1,2,3,4,5,6,7,8,9,10,11,12,13,14,15,16,16,16,17,17,18,18,18,19,19,19,20,20,20,20,21,21,21,21,22,22,22,22,22,23,23,23,23,23,23,24,24,24,24,24,24,25,25,25,25,25,25,25,26,26,26,26,26,26,26,26,27,27,27,27,27,27,27,27,27,27,28,28,28,28,28,28,28,28,28,28,29,29,29,29,29,29,29,29,29,29,29,29,30,30,30,30,30,30,30,30,30,30,30,30,30,30,31,31,31,31,31,31,31,31,31,31,31,31,31,31,31};

__device__ __forceinline__ float bf2f(unsigned short b) { return __uint_as_float(((unsigned)b) << 16); }
__device__ __forceinline__ unsigned f2bf(float f) { unsigned u = __float_as_uint(f); return (u + 0x7fffu + ((u >> 16) & 1u)) >> 16; }
__device__ __forceinline__ unsigned pk2(float lo, float hi) { return pg8::cvt_pk_bf16(lo, hi); }
__device__ __forceinline__ float wave_sum(float v) {
#pragma unroll
    for (int o = 1; o < 64; o <<= 1) v += __shfl_xor(v, o);
    return v;
}
__device__ __forceinline__ unsigned wave_iscan(unsigned v) {
    int x = (int)v;
    x += __builtin_amdgcn_update_dpp(0, x, 0x111, 0xf, 0xf, false);
    x += __builtin_amdgcn_update_dpp(0, x, 0x112, 0xf, 0xf, false);
    x += __builtin_amdgcn_update_dpp(0, x, 0x114, 0xf, 0xf, false);
    x += __builtin_amdgcn_update_dpp(0, x, 0x118, 0xf, 0xf, false);
    x += __builtin_amdgcn_update_dpp(0, x, 0x142, 0xa, 0xf, false);
    x += __builtin_amdgcn_update_dpp(0, x, 0x143, 0xc, 0xf, false);
    return (unsigned)x;
}
__device__ __forceinline__ float wave_max(float v) {
#pragma unroll
    for (int o = 1; o < 64; o <<= 1) v = fmaxf(v, __shfl_xor(v, o));
    return v;
}
__device__ __forceinline__ int opaque_v(int v) { asm volatile("" : "+v"(v)); return v; }
__device__ __forceinline__ float sigmoid_f(float v) { return __builtin_amdgcn_rcpf(1.f + __builtin_amdgcn_exp2f(v * -1.4426950408889634f)); }
__device__ __forceinline__ float silu_f(float v) { return v * sigmoid_f(v); }
__device__ __forceinline__ float einv_f(float v) { return fminf(1.f + __builtin_amdgcn_exp2f(v * -1.4426950408889634f), 448.f); }
__device__ __forceinline__ float rsqrt_f(float v) { return __builtin_amdgcn_rsqf(v); }

struct Args { const float* in[23]; float* out; unsigned char* ws; int ph_lo, ph_hi, single, pad; };
struct Ctx {
    const float* const* in; float* out; unsigned char* ws;
    LAS unsigned char* lds; int tid, lane, wave, vcu, G;
};

#define GAS __attribute__((address_space(1)))
#define XB_TMO      128
#define XB_XCNT(j)  (256  + 64 * (j))
#define XB_XSUB(j)  (1280 + 64 * (j))
#define XB_XGEN(j)  (2304 + 64 * (j))
#define XB_TOP      3328
#define XB_TOPGEN   3392
#define XCD_BAR_WORDS 3456
#define XB_SPIN_CAP (1u << 22)
__device__ __forceinline__ unsigned xb_ld(unsigned* p)              { return __hip_atomic_load(p, __ATOMIC_RELAXED, __HIP_MEMORY_SCOPE_AGENT); }
__device__ __forceinline__ unsigned xb_add(unsigned* p, unsigned v) { return __hip_atomic_fetch_add(p, v, __ATOMIC_RELAXED, __HIP_MEMORY_SCOPE_AGENT); }
__device__ __forceinline__ unsigned xb_xcc_id() { return (unsigned)__builtin_amdgcn_s_getreg((3 << 11) | 20) & 0xFu; }
#define XB_SPIN(cond, bar) do { unsigned _sp = 0; while (cond) { __builtin_amdgcn_s_sleep(1); \
    if ((++_sp & 255u) == 0u) { if (xb_ld(&(bar)[XB_TMO])) break; if (_sp > XB_SPIN_CAP) { atomicAdd(&(bar)[XB_TMO], 1u); break; } } } } while (0)
struct XcdBarrier { unsigned* bar; unsigned x; volatile LAS unsigned* st; };
__device__ __forceinline__ XcdBarrier xcd_barrier_post(unsigned* bar, volatile LAS unsigned* st) {
    XcdBarrier b; b.bar = bar; b.x = xb_xcc_id(); b.st = st;
    if (threadIdx.x == 0) (void)xb_add(&bar[XB_XCNT(b.x)], 1u);
    return b;
}
__device__ __forceinline__ void xcd_barrier_complete(unsigned* bar, unsigned x, unsigned& nloc, unsigned& nx) {
    const unsigned G = gridDim.x * gridDim.y * gridDim.z;
    unsigned sum, cnt, mine, sp = 0u;
    for (;;) {
        sum = 0u; cnt = 0u; mine = 0u;
#pragma unroll
        for (unsigned j = 0; j < 16; ++j) { const unsigned c = xb_ld(&bar[XB_XCNT(j)]); sum += c; cnt += (c > 0u) ? 1u : 0u; mine = (j == x) ? c : mine; }
        if (sum == G) break;
        __builtin_amdgcn_s_sleep(1);
        if ((++sp & 255u) == 0u) { if (xb_ld(&bar[XB_TMO])) break; if (sp > XB_SPIN_CAP) { atomicAdd(&bar[XB_TMO], 1u); break; } }
    }
    nloc = mine > 0u ? mine : 1u; nx = cnt > 0u ? cnt : 1u;
}
__device__ __forceinline__ void xcd_barrier(const XcdBarrier& b) {
    asm volatile("s_waitcnt vmcnt(0)" ::: "memory");
    __syncthreads();
    if (threadIdx.x == 0) {
        unsigned* bar = b.bar;
        __builtin_amdgcn_s_waitcnt(0);
        unsigned nloc = b.st[0], nx = b.st[1];
        if (nloc == 0u) { xcd_barrier_complete(bar, b.x, nloc, nx); b.st[0] = nloc; b.st[1] = nx; }
        const unsigned old = xb_add(&bar[XB_XSUB(b.x)], 1u);
        const unsigned gen = old / nloc;
        if (old + 1u == (gen + 1u) * nloc) {
            __builtin_amdgcn_fence(__ATOMIC_RELEASE, "agent");
            asm volatile("s_waitcnt vmcnt(0)" ::: "memory");
            const unsigned og = xb_add(&bar[XB_TOP], 1u);
            const unsigned tg = og / nx;
            if (og + 1u == (tg + 1u) * nx) xb_add(&bar[XB_TOPGEN], 1u);
            else XB_SPIN(xb_ld(&bar[XB_TOPGEN]) == tg, bar);
            __builtin_amdgcn_fence(__ATOMIC_ACQUIRE, "agent");
            xb_add(&bar[XB_XGEN(b.x)], 1u);
            asm volatile("s_waitcnt vmcnt(0)" ::: "memory");
        } else {
            XB_SPIN(xb_ld(&bar[XB_XGEN(b.x)]) == gen, bar);
            __builtin_amdgcn_fence(__ATOMIC_ACQUIRE, "agent");
            asm volatile("s_waitcnt vmcnt(0)" ::: "memory");
        }
    }
    __syncthreads();
}

__device__ __forceinline__ unsigned pk4_fp8(float a, float b, float c, float d);
#define EPI_ROWS(ai, m) (u.pm * 256 + (ai) * 128 + wr * 64 + (m) * 16 + fr)
#define EPI_COLT(bj, n) ((bj) * 128 + wc * 32 + (n) * 16 + 4 * fq)
#define EPI_COLP(bj) ((bj) * 128 + wc * 32 + 8 * fq)

constexpr int EPX_OFF = 131072, EPY_OFF = 131072 + 8192;
struct EpiIn {
    static constexpr bool PERM = true, HAS_MID = false;
    LAS unsigned char* lds; unsigned char* ws; unsigned char* dout; const float* const* in;
    int memkv, pnoff;
    __device__ __forceinline__ void store4(bf16_t* p, const f32x4 v) const { u32x2 w; w.x = pk2(v[0], v[1]); w.y = pk2(v[2], v[3]); *(u32x2*)p = w; }
    __device__ __forceinline__ void store8(bf16_t* p, const f32x4 a, const f32x4 b) const { u32x4 w; w.x = pk2(a[0], a[1]); w.y = pk2(a[2], a[3]); w.z = pk2(b[0], b[1]); w.w = pk2(b[2], b[3]); *(u32x4*)p = w; }
    __device__ __forceinline__ void operator()(const f32x4 (&acc)[2][2][4][2], const pg8::Unit& u, int wr, int wc, int fr_, int fq_) const {
        int pn = u.pn;
        if (pnoff == 1) pn = pn < 6 ? pn + 3 : 12; else if (pnoff == 2) pn = pn < 3 ? pn : (pn < 6 ? pn + 6 : pn + 7);
        const int fr = opaque_v(fr_), fq = opaque_v(fq_);
        bf16_t* const QA = (bf16_t*)(ws + WS_QA); bf16_t* const CKV = (bf16_t*)(ws + WS_CKV); bf16_t* const IQ = (bf16_t*)(dout + DO_IQ); bf16_t* const IK = (bf16_t*)(ws + WS_IK);
        bf16_t* const BQ = (bf16_t*)(ws + WS_BQ); bf16_t* const BK = (bf16_t*)(ws + WS_BK); bf16_t* const BV = (bf16_t*)(ws + WS_BV); bf16_t* const CQ = (bf16_t*)(ws + WS_CQ);
        bf16_t* const GATE = (bf16_t*)(dout + DO_GATE); bf16_t* const MIX = (bf16_t*)(ws + WS_BIG); bf16_t* const KC = (bf16_t*)(ws + WS_KC); bf16_t* const VC = (bf16_t*)(ws + WS_VC); float* const IW = (float*)(ws + WS_IW);
        int kind; bf16_t* dst; int ld, cb; int gi = 0; float gsc = 1.f;
        if (memkv) { if (pn < 2) { kind = 3; dst = KC; ld = 512; cb = pn * 256; gi = 16; } else { kind = 0; dst = VC; ld = 512; cb = (pn - 2) * 256; } }
        else if (pn <= 2) { kind = 3; dst = QA; ld = 768; cb = pn * 256; gi = 8; }
        else if (pn == 3) { kind = 4; dst = CKV; ld = 256; cb = 0; gi = 4; }
        else if (pn <= 7) { kind = 0; dst = IQ; ld = 1024; cb = (pn - 4) * 256; }
        else if (pn == 8) { kind = 6; dst = IK; ld = 64; cb = 0; }
        else if (pn <= 11) { kind = 5; dst = BQ; ld = 768; cb = (pn - 9) * 256; gi = 10; gsc = 0.125f; }
        else if (pn == 12) { kind = 7; dst = BK; ld = 128; cb = 0; gi = 11; }
        else if (pn <= 14) { kind = 3; dst = CQ; ld = 512; cb = (pn - 13) * 256; gi = 15; gsc = 0.08838834764831845f; }
        else if (pn <= 17) { kind = 1; dst = GATE; ld = 2048; cb = (pn - 15) * 256; }
        else if (pn <= 20) { kind = 1; dst = GATE; ld = 2048; cb = 768 + (pn - 18) * 256; }
        else if (pn <= 22) { kind = 1; dst = GATE; ld = 2048; cb = 1536 + (pn - 21) * 256; }
        else { kind = 2; dst = MIX; ld = 6144; cb = (pn - 23) * 256; }
        if (kind <= 2) {
#pragma unroll
            for (int bj = 0; bj < 2; ++bj) { const int c = cb + EPI_COLP(bj); f32x4 b0 = (f32x4){0.f, 0.f, 0.f, 0.f}, b1 = b0; if (kind == 2) { b0 = *(const f32x4*)(in[20] + c); b1 = *(const f32x4*)(in[20] + c + 4); }
#pragma unroll
                for (int ai = 0; ai < 2; ++ai)
#pragma unroll
                    for (int m = 0; m < 4; ++m) { const size_t row = EPI_ROWS(ai, m); f32x4 v = acc[ai][bj][m][0] + b0, w = acc[ai][bj][m][1] + b1;
                        if (kind == 1) { v[0] = silu_f(v[0]); v[1] = silu_f(v[1]); v[2] = silu_f(v[2]); v[3] = silu_f(v[3]); w[0] = silu_f(w[0]); w[1] = silu_f(w[1]); w[2] = silu_f(w[2]); w[3] = silu_f(w[3]); }
                        if (kind == 2) { v[0] = einv_f(v[0]); v[1] = einv_f(v[1]); v[2] = einv_f(v[2]); v[3] = einv_f(v[3]); w[0] = einv_f(w[0]); w[1] = einv_f(w[1]); w[2] = einv_f(w[2]); w[3] = einv_f(w[3]); }
                        if (kind == 2) { u32x2 o8; o8.x = pk4_fp8(v[0], v[1], v[2], v[3]); o8.y = pk4_fp8(w[0], w[1], w[2], w[3]); *(u32x2*)((unsigned char*)MIX + row * 6144 + c) = o8; }
                        else store8(dst + row * ld + c, v, w);
                        asm volatile("" ::: "memory"); } }
            return;
        }
        LAS float* X = (LAS float*)(lds + EPX_OFF); LAS float* Y = (LAS float*)(lds + EPY_OFF);
        const float* gain = in[gi]; const float* ln_g = in[6]; const float* ln_b = in[7];
#pragma unroll
        for (int ai = 0; ai < 2; ++ai)
#pragma unroll
            for (int m = 0; m < 4; ++m) { const int rl = ai * 128 + wr * 64 + m * 16 + fr;
#pragma unroll
                for (int bj = 0; bj < 2; ++bj) { const f32x4 a0 = acc[ai][bj][m][0], a1 = acc[ai][bj][m][1];
                    float sq = (a0[0] * a0[0] + a0[1] * a0[1]) + (a0[2] * a0[2] + a0[3] * a0[3]) + (a1[0] * a1[0] + a1[1] * a1[1]) + (a1[2] * a1[2] + a1[3] * a1[3]);
                    sq += __shfl_xor(sq, 16); sq += __shfl_xor(sq, 32);
                    if (fq == 0) X[(rl * 2 + bj) * 4 + wc] = sq;
                    if (kind == 6) { float sm = (a0[0] + a0[1]) + (a0[2] + a0[3]) + (a1[0] + a1[1]) + (a1[2] + a1[3]); sm += __shfl_xor(sm, 16); sm += __shfl_xor(sm, 32); if (fq == 0) Y[(rl * 2 + bj) * 4 + wc] = sm; } } }
        asm volatile("s_waitcnt lgkmcnt(0)" ::: "memory"); __builtin_amdgcn_s_barrier(); asm volatile("" ::: "memory");
#pragma unroll
        for (int ai = 0; ai < 2; ++ai)
#pragma unroll
            for (int m = 0; m < 4; ++m) { const int rl = ai * 128 + wr * 64 + m * 16 + fr; const size_t row = EPI_ROWS(ai, m);
                const f32x4 x0 = *(const LAS f32x4*)(X + (rl * 2 + 0) * 4), x1 = *(const LAS f32x4*)(X + (rl * 2 + 1) * 4);
                float rs0, rs1;
                if (kind == 3) { rs0 = rsqrt_f(((x0[0] + x0[1]) + (x0[2] + x0[3])) * (1.f / 128.f) + EPS); rs1 = rsqrt_f(((x1[0] + x1[1]) + (x1[2] + x1[3])) * (1.f / 128.f) + EPS); }
                else if (kind == 4) { rs0 = rs1 = rsqrt_f((((x0[0] + x0[1]) + (x0[2] + x0[3])) + ((x1[0] + x1[1]) + (x1[2] + x1[3]))) * (1.f / 256.f) + EPS); }
                else { const int w2 = wc & 2; rs0 = rsqrt_f((w2 ? x0[2] + x0[3] : x0[0] + x0[1]) * (1.f / 64.f) + EPS); rs1 = rsqrt_f((w2 ? x1[2] + x1[3] : x1[0] + x1[1]) * (1.f / 64.f) + EPS); }
                if (kind == 6) {
                    if (wc < 2) { const f32x4 y0 = *(const LAS f32x4*)(Y + (rl * 2 + 0) * 4); const float mean = (y0[0] + y0[1]) * (1.f / 64.f); const float var = fmaxf((x0[0] + x0[1]) * (1.f / 64.f) - mean * mean, 0.f); const float rstd = rsqrt_f(var + EPS);
                        const int c = wc * 32 + 8 * fq; const f32x4 g0 = *(const f32x4*)(ln_g + c), g1 = *(const f32x4*)(ln_g + c + 4), e0 = *(const f32x4*)(ln_b + c), e1 = *(const f32x4*)(ln_b + c + 4);
                        store8(IK + row * 64 + c, (acc[ai][0][m][0] - mean) * rstd * g0 + e0, (acc[ai][0][m][1] - mean) * rstd * g1 + e1); }
                    else if (wc == 2 && fq < 2) { *(f32x4*)(IW + row * 16 + 8 * fq) = acc[ai][0][m][0] * 0.03125f; *(f32x4*)(IW + row * 16 + 8 * fq + 4) = acc[ai][0][m][1] * 0.03125f; }
                } else if (kind == 7) {
                    const int c = wc * 32 + 8 * fq; const f32x4 g0 = *(const f32x4*)(gain + (c & 63)), g1 = *(const f32x4*)(gain + (c & 63) + 4);
                    store8(BK + row * 128 + c, acc[ai][0][m][0] * rs0 * g0, acc[ai][0][m][1] * rs0 * g1); store8(BV + row * 128 + c, acc[ai][1][m][0], acc[ai][1][m][1]);
                } else {
#pragma unroll
                    for (int bj = 0; bj < 2; ++bj) { const int ct = EPI_COLP(bj); const int go = kind == 4 ? ct : (kind == 3 ? (ct & 127) : (ct & 63)); const f32x4 g0 = *(const f32x4*)(gain + go), g1 = *(const f32x4*)(gain + go + 4);
                        const float rr = (bj ? rs1 : rs0) * gsc;
                        store8(dst + row * ld + cb + ct, acc[ai][bj][m][0] * rr * g0, acc[ai][bj][m][1] * rr * g1); } }
                asm volatile("" ::: "memory"); }
    }
};
struct EpiMix {
    static constexpr bool PERM = true, HAS_MID = false;
    bf16_t* MIX; const float* gb;
    __device__ __forceinline__ void operator()(const f32x4 (&acc)[2][2][4][2], const pg8::Unit& u, int wr, int wc, int fr_, int fq_) const {
        const int fr = opaque_v(fr_), fq = opaque_v(fq_);
#pragma unroll
        for (int bj = 0; bj < 2; ++bj) { const int c = u.pn * 256 + EPI_COLP(bj); const f32x4 b0 = *(const f32x4*)(gb + c), b1 = *(const f32x4*)(gb + c + 4);
#pragma unroll
            for (int ai = 0; ai < 2; ++ai)
#pragma unroll
                for (int m = 0; m < 4; ++m) { const size_t row = EPI_ROWS(ai, m); const f32x4 v = acc[ai][bj][m][0] + b0, w = acc[ai][bj][m][1] + b1;
                    u32x4 o; o.x = pk2(sigmoid_f(v[0]), sigmoid_f(v[1])); o.y = pk2(sigmoid_f(v[2]), sigmoid_f(v[3])); o.z = pk2(sigmoid_f(w[0]), sigmoid_f(w[1])); o.w = pk2(sigmoid_f(w[2]), sigmoid_f(w[3]));
                    *(u32x4*)(MIX + row * 6144 + c) = o; asm volatile("" ::: "memory"); } }
    }
};
struct EpiF32 {
    static constexpr bool PERM = false, HAS_MID = false;
    float* C; int ldc;
    __device__ __forceinline__ void operator()(const f32x4 (&acc)[2][2][4][2], const pg8::Unit& u, int wr, int wc, int fr, int fq) const {
#pragma unroll
        for (int ai = 0; ai < 2; ++ai)
#pragma unroll
            for (int m = 0; m < 4; ++m) { const size_t row = EPI_ROWS(ai, m);
#pragma unroll
                for (int bj = 0; bj < 2; ++bj)
#pragma unroll
                    for (int n = 0; n < 2; ++n) *(f32x4*)(C + row * ldc + u.pn * 256 + EPI_COLT(bj, n)) = acc[ai][bj][m][n]; }
    }
};
struct EpiBf {
    static constexpr bool PERM = false, HAS_MID = false;
    bf16_t* O; int ldc;
    __device__ __forceinline__ void operator()(const f32x4 (&acc)[2][2][4][2], const pg8::Unit& u, int wr, int wc, int fr, int fq) const {
#pragma unroll
        for (int ai = 0; ai < 2; ++ai)
#pragma unroll
            for (int m = 0; m < 4; ++m) { const size_t row = EPI_ROWS(ai, m);
#pragma unroll
                for (int bj = 0; bj < 2; ++bj)
#pragma unroll
                    for (int n = 0; n < 2; ++n) { const f32x4 v = acc[ai][bj][m][n]; u32x2 w; w.x = pk2(v[0], v[1]); w.y = pk2(v[2], v[3]);
                        *(u32x2*)(O + row * ldc + u.pn * 256 + EPI_COLT(bj, n)) = w; } }
    }
};
struct EpiKss {
    static constexpr bool PERM = false, HAS_MID = false;
    float* KSS;
    __device__ __forceinline__ void operator()(const f32x4 (&acc)[2][2][4][2], const pg8::Unit& u, int wr, int wc, int fr, int fq) const {
#pragma unroll
        for (int ai = 0; ai < 2; ++ai)
#pragma unroll
            for (int m = 0; m < 4; ++m) { const size_t row = EPI_ROWS(ai, m);
#pragma unroll
                for (int bj = 0; bj < 2; ++bj) { float s = 0.f;
#pragma unroll
                    for (int n = 0; n < 2; ++n) { const f32x4 v = acc[ai][bj][m][n]; s += (v[0] * v[0] + v[1] * v[1]) + (v[2] * v[2] + v[3] * v[3]); }
                    atomicAdd(KSS + row * 8 + 2 * u.pn + bj, s); }
                asm volatile("" ::: "memory"); }
    }
};
struct EpiGateMul {
    static constexpr bool PERM = false, HAS_MID = false;
    bf16_t* OP; const bf16_t* GATE;
    __device__ __forceinline__ void operator()(const f32x4 (&acc)[2][2][4][2], const pg8::Unit& u, int wr, int wc, int fr, int fq) const {
#pragma unroll
        for (int ai = 0; ai < 2; ++ai)
#pragma unroll
            for (int m = 0; m < 4; ++m) { const size_t row = EPI_ROWS(ai, m);
#pragma unroll
                for (int bj = 0; bj < 2; ++bj)
#pragma unroll
                    for (int n = 0; n < 2; ++n) { const int c = u.pn * 256 + EPI_COLT(bj, n); const f32x4 v = acc[ai][bj][m][n];
                        const u32x2 gw = *(const u32x2*)(GATE + row * 2048 + c);
                        *(unsigned*)((unsigned char*)OP + row * 2048 + c) = pk4_fp8(16.f * v[0] * bf2f(gw.x & 0xffff), 16.f * v[1] * bf2f(gw.x >> 16), 16.f * v[2] * bf2f(gw.y & 0xffff), 16.f * v[3] * bf2f(gw.y >> 16)); }
                asm volatile("" ::: "memory"); }
    }
};
struct EpiMerge {
    static constexpr bool PERM = true, HAS_MID = true;
    bf16_t* MERGED; const unsigned char* MIX; int mid_t0, mid_t1;
    __device__ __forceinline__ void gate8(const bf16_t* p, f32x4& a, f32x4& b) const { const u32x4 w = *(const u32x4*)p;
        a[0] = bf2f(w.x & 0xffff); a[1] = bf2f(w.x >> 16); a[2] = bf2f(w.y & 0xffff); a[3] = bf2f(w.y >> 16); b[0] = bf2f(w.z & 0xffff); b[1] = bf2f(w.z >> 16); b[2] = bf2f(w.w & 0xffff); b[3] = bf2f(w.w >> 16);
#pragma unroll
        for (int j = 0; j < 4; ++j) { a[j] = fmaxf(a[j], 1e-20f); b[j] = fmaxf(b[j], 1e-20f); } }
    __device__ __forceinline__ void unpack8(const u32x2 w, f32x4& a, f32x4& b) const {
        typedef float f32x2v __attribute__((ext_vector_type(2)));
        const f32x2v a0 = __builtin_amdgcn_cvt_pk_f32_fp8((int)w.x, false), a1 = __builtin_amdgcn_cvt_pk_f32_fp8((int)w.x, true), b0 = __builtin_amdgcn_cvt_pk_f32_fp8((int)w.y, false), b1 = __builtin_amdgcn_cvt_pk_f32_fp8((int)w.y, true);
        a[0] = a0[0]; a[1] = a0[1]; a[2] = a1[0]; a[3] = a1[1]; b[0] = b0[0]; b[1] = b0[1]; b[2] = b1[0]; b[3] = b1[1]; }
    __device__ __forceinline__ void mid(f32x4 (&acc)[2][2][4][2], const pg8::Unit& u, int t, int wr, int wc, int fr_, int fq_) const {
        const int fr = opaque_v(fr_), fq = opaque_v(fq_); const int gprev = t == mid_t0 ? 0 : 2048;
        u32x2 wp[4][2][2], wn[4][2][2];
#define MID_LOAD(bt) do { _Pragma("unroll") for (int mm = 0; mm < 2; ++mm) { const size_t row = EPI_ROWS((bt) >> 1, 2 * ((bt) & 1) + mm); \
            _Pragma("unroll") for (int bj = 0; bj < 2; ++bj) { const int c = u.pn * 256 + EPI_COLP(bj); wp[bt][mm][bj] = *(const u32x2*)(MIX + row * 6144 + gprev + c); wn[bt][mm][bj] = *(const u32x2*)(MIX + row * 6144 + gprev + 2048 + c); } } } while (0)
#define MID_USE(bt) do { _Pragma("unroll") for (int mm = 0; mm < 2; ++mm) { const int ai = (bt) >> 1, m = 2 * ((bt) & 1) + mm; \
            _Pragma("unroll") for (int bj = 0; bj < 2; ++bj) { f32x4 p0, p1, n0, n1; unpack8(wp[bt][mm][bj], p0, p1); unpack8(wn[bt][mm][bj], n0, n1); \
                _Pragma("unroll") for (int j = 0; j < 4; ++j) { acc[ai][bj][m][0][j] *= n0[j] * __builtin_amdgcn_rcpf(p0[j]); acc[ai][bj][m][1][j] *= n1[j] * __builtin_amdgcn_rcpf(p1[j]); } } } } while (0)
        MID_LOAD(0); MID_LOAD(1); asm volatile("" ::: "memory");
        MID_USE(0); asm volatile("" ::: "memory"); MID_LOAD(2); asm volatile("" ::: "memory");
        MID_USE(1); asm volatile("" ::: "memory"); MID_LOAD(3); asm volatile("" ::: "memory");
        MID_USE(2); asm volatile("" ::: "memory");
        MID_USE(3); asm volatile("" ::: "memory");
#undef MID_LOAD
#undef MID_USE
    }
    __device__ __forceinline__ void operator()(const f32x4 (&acc)[2][2][4][2], const pg8::Unit& u, int wr, int wc, int fr_, int fq_) const {
        const int fr = opaque_v(fr_), fq = opaque_v(fq_);
#pragma unroll
        for (int ai = 0; ai < 2; ++ai) { u32x2 wg[4][2];
#pragma unroll
            for (int m = 0; m < 4; ++m) { const size_t row = EPI_ROWS(ai, m);
#pragma unroll
                for (int bj = 0; bj < 2; ++bj) wg[m][bj] = *(const u32x2*)(MIX + row * 6144 + 4096 + u.pn * 256 + EPI_COLP(bj)); }
            asm volatile("" ::: "memory");
#pragma unroll
            for (int m = 0; m < 4; ++m) { const size_t row = EPI_ROWS(ai, m);
#pragma unroll
                for (int bj = 0; bj < 2; ++bj) { const int c = u.pn * 256 + EPI_COLP(bj); f32x4 g0, g1; unpack8(wg[m][bj], g0, g1);
                    f32x4 v, w;
#pragma unroll
                    for (int j = 0; j < 4; ++j) { v[j] = acc[ai][bj][m][0][j] * __builtin_amdgcn_rcpf(g0[j]); w[j] = acc[ai][bj][m][1][j] * __builtin_amdgcn_rcpf(g1[j]); }
                    u32x2 o; o.x = pk4_fp8(16.f * v[0], 16.f * v[1], 16.f * v[2], 16.f * v[3]); o.y = pk4_fp8(16.f * w[0], 16.f * w[1], 16.f * w[2], 16.f * w[3]); *(u32x2*)((unsigned char*)MERGED + row * 2048 + c) = o; } }
            asm volatile("" ::: "memory"); }
    }
};
struct EpiOut {
    static constexpr bool PERM = false, HAS_MID = false;
    float* out; const float* x;
    __device__ __forceinline__ void operator()(const f32x4 (&acc)[2][2][4][2], const pg8::Unit& u, int wr, int wc, int fr, int fq) const {
#pragma unroll
        for (int ai = 0; ai < 2; ++ai)
#pragma unroll
            for (int mh = 0; mh < 2; ++mh) { f32x4 xv[2][2][2];
#pragma unroll
                for (int mm = 0; mm < 2; ++mm) { const size_t row = EPI_ROWS(ai, 2 * mh + mm);
#pragma unroll
                    for (int bj = 0; bj < 2; ++bj)
#pragma unroll
                        for (int n = 0; n < 2; ++n) xv[mm][bj][n] = *(const f32x4*)(x + row * 2048 + u.pn * 256 + EPI_COLT(bj, n)); }
                asm volatile("" ::: "memory");
#pragma unroll
                for (int mm = 0; mm < 2; ++mm) { const size_t row = EPI_ROWS(ai, 2 * mh + mm);
#pragma unroll
                    for (int bj = 0; bj < 2; ++bj)
#pragma unroll
                        for (int n = 0; n < 2; ++n) *(f32x4*)(out + row * 2048 + u.pn * 256 + EPI_COLT(bj, n)) = xv[mm][bj][n] + acc[ai][bj][2 * mh + mm][n]; }
                asm volatile("" ::: "memory"); }
    }
};

template <class F>
__device__ __forceinline__ void cvt_matrix(Ctx& C, bf16_t* dst, int dld, int Nn, int K, const F& f) {
    const long total = (long)Nn * (K / 8);
    for (long it = (long)C.vcu * NTHREADS + C.tid; it < total; it += (long)C.G * NTHREADS) {
        const int n = (int)(it % Nn), k0 = (int)(it / Nn) * 8;
        u32x4 w; w.x = pk2(f(n, k0), f(n, k0 + 1)); w.y = pk2(f(n, k0 + 2), f(n, k0 + 3)); w.z = pk2(f(n, k0 + 4), f(n, k0 + 5)); w.w = pk2(f(n, k0 + 6), f(n, k0 + 7));
        *(u32x4*)(dst + (size_t)n * dld + k0) = w;
    }
}
__device__ __forceinline__ unsigned pk4_fp8(float a, float b, float c, float d);
__device__ __forceinline__ void rms_rows2_to_bf16(const float* xrow, const float* g, bf16_t* orow, size_t rstride, int lane, unsigned char* o8row = nullptr) {
    const f32x4* xr0 = (const f32x4*)xrow + lane; const f32x4* xr1 = (const f32x4*)(xrow + rstride) + lane; const f32x4* gr = (const f32x4*)g + lane;
    f32x4 v0[8], v1[8]; float s0 = 0.f, s1 = 0.f;
#pragma unroll
    for (int j = 0; j < 8; ++j) { v0[j] = xr0[64 * j]; v1[j] = xr1[64 * j]; }
#pragma unroll
    for (int j = 0; j < 8; ++j) { s0 += (v0[j][0] * v0[j][0] + v0[j][1] * v0[j][1]) + (v0[j][2] * v0[j][2] + v0[j][3] * v0[j][3]); s1 += (v1[j][0] * v1[j][0] + v1[j][1] * v1[j][1]) + (v1[j][2] * v1[j][2] + v1[j][3] * v1[j][3]); }
    const float r0 = rsqrt_f(wave_sum(s0) * (1.f / 2048.f) + EPS), r1 = rsqrt_f(wave_sum(s1) * (1.f / 2048.f) + EPS);
    u32x2* o0 = (u32x2*)orow + lane; u32x2* o1 = (u32x2*)(orow + rstride) + lane;
#pragma unroll
    for (int j = 0; j < 8; ++j) { const f32x4 gg = gr[64 * j]; u32x2 w;
        w.x = pk2(v0[j][0] * r0 * gg[0], v0[j][1] * r0 * gg[1]); w.y = pk2(v0[j][2] * r0 * gg[2], v0[j][3] * r0 * gg[3]); o0[64 * j] = w;
        w.x = pk2(v1[j][0] * r1 * gg[0], v1[j][1] * r1 * gg[1]); w.y = pk2(v1[j][2] * r1 * gg[2], v1[j][3] * r1 * gg[3]); o1[64 * j] = w;
        if (o8row) { ((unsigned*)o8row)[lane + 64 * j] = pk4_fp8(v0[j][0] * r0 * gg[0], v0[j][1] * r0 * gg[1], v0[j][2] * r0 * gg[2], v0[j][3] * r0 * gg[3]);
            ((unsigned*)(o8row + rstride))[lane + 64 * j] = pk4_fp8(v1[j][0] * r1 * gg[0], v1[j][1] * r1 * gg[1], v1[j][2] * r1 * gg[2], v1[j][3] * r1 * gg[3]); } }
}
template <class F>
__device__ __forceinline__ void transpose_item(const F& f, bf16_t* dst, int dld, int k0, int n0, LAS float* scr, int lane) {
    float tv[32];
#pragma unroll
    for (int i = 0; i < 32; ++i) tv[i] = f(k0 + 2 * i + (lane >> 5), n0 + (lane & 31));
#pragma unroll
    for (int i = 0; i < 32; ++i) scr[(2 * i + (lane >> 5)) * 33 + (lane & 31)] = tv[i];
    asm volatile("s_waitcnt lgkmcnt(0)" ::: "memory");
    const int c = lane & 7;
#pragma unroll
    for (int j = 0; j < 4; ++j) { const int n = (lane >> 3) + 8 * j; const LAS float* sp = scr + (8 * c) * 33 + n;
        u32x4 o; o.x = pk2(sp[0 * 33], sp[1 * 33]); o.y = pk2(sp[2 * 33], sp[3 * 33]); o.z = pk2(sp[4 * 33], sp[5 * 33]); o.w = pk2(sp[6 * 33], sp[7 * 33]);
        *(u32x4*)(dst + (size_t)(n0 + n) * dld + k0 + 8 * c) = o; }
    asm volatile("s_waitcnt lgkmcnt(0)" ::: "memory");
}
__device__ __forceinline__ unsigned pk4_fp8(float a, float b, float c, float d) { int w = 0; w = __builtin_amdgcn_cvt_pk_fp8_f32(a, b, w, false); w = __builtin_amdgcn_cvt_pk_fp8_f32(c, d, w, true); return (unsigned)w; }
template <class F>
__device__ __forceinline__ void transpose_item8(const F& f, unsigned char* dst, int dld, int k0, int n0, LAS float* scr, int lane) {
    float tv[32];
#pragma unroll
    for (int i = 0; i < 32; ++i) tv[i] = f(k0 + 2 * i + (lane >> 5), n0 + (lane & 31));
#pragma unroll
    for (int i = 0; i < 32; ++i) scr[(2 * i + (lane >> 5)) * 33 + (lane & 31)] = tv[i];
    asm volatile("s_waitcnt lgkmcnt(0)" ::: "memory");
    const int c = lane & 7;
#pragma unroll
    for (int j = 0; j < 4; ++j) { const int n = (lane >> 3) + 8 * j; const LAS float* sp = scr + (8 * c) * 33 + n;
        u32x2 o; o.x = pk4_fp8(sp[0 * 33], sp[1 * 33], sp[2 * 33], sp[3 * 33]); o.y = pk4_fp8(sp[4 * 33], sp[5 * 33], sp[6 * 33], sp[7 * 33]);
        *(u32x2*)(dst + (size_t)(n0 + n) * dld + k0 + 8 * c) = o; }
    asm volatile("s_waitcnt lgkmcnt(0)" ::: "memory");
}
__device__ __forceinline__ void p0_prologue(Ctx& C) {
    unsigned char* ws = C.ws;
    const float* w_in = C.in[3]; const float* w_kv_up = C.in[5]; const float* k_norm_a = C.in[9]; const float* w_mem_kv = C.in[14];
    const float* w_up_a = C.in[17]; const float* w_up_b = C.in[18]; const float* w_up_c = C.in[19]; const float* w_o = C.in[21];
    const int lane = C.lane;
    const int gw = C.vcu * NWAVES + C.wave, NGW = C.G * NWAVES;
    LAS float* scr = (LAS float*)(C.lds + C.wave * 8704);
    constexpr int I_WIN = 32 * (NWIN_A / 32), I_MIX = 32 * (NWIN_B / 32), I_UP = 32 * 64, I_O = 32 * 64, I_MEM = 32 * 32;
    for (int it = gw; it < I_WIN + I_MIX + I_UP + I_O + I_MEM; it += NGW) {
        int r = it;
        if (r < I_WIN) { const int nb = r % (NWIN_A / 32), kb = r / (NWIN_A / 32);
            transpose_item([=](int k, int n) -> float { if (n >= 1360 && n < 1536) return 0.f;
                const int c = n < 1360 ? 768 + n : 3664 + (n - 1536); return w_in[(size_t)k * IN_COLS + c]; }, (bf16_t*)(ws + WS_WINT), 2048, 64 * kb, 32 * nb, scr, lane); continue; }
        r -= I_WIN;
        if (r < I_MIX) { const int nb = r % (NWIN_B / 32), kb = r / (NWIN_B / 32);
            transpose_item8([=](int k, int n) -> float { int c;
                if (n < 768) c = n; else if (n < 1536) c = 2896 + (n - 768); else if (n < 2048) c = 4688 + (n - 1536);
                else { const int m = n - 2048; c = m < 768 ? 2128 + m : (m < 1536 ? 3920 + (m - 768) : (m < 2048 ? 5200 + (m - 1536) : 5712 + (m - 2048))); }
                return 64.0f * w_in[(size_t)k * IN_COLS + c]; }, ws + WS_WMIX8, 2048, 64 * kb, 32 * nb, scr, lane); continue; }
        r -= I_MIX;
        if (r < I_UP) { const int nb = r % 64, kb = r / 64; const int k0 = 64 * kb;
            const float* src = k0 < 768 ? w_up_a : (k0 < 1536 ? w_up_b - (size_t)768 * 2048 : w_up_c - (size_t)1536 * 2048);
            transpose_item8([=](int k, int n) -> float { return 32.0f * src[(size_t)k * 2048 + n]; }, ws + WS_WUPT, 2048, k0, 32 * nb, scr, lane); continue; }
        r -= I_UP;
        if (r < I_O) { const int nb = r % 64, kb = r / 64;
            transpose_item8([=](int k, int n) -> float { return 64.0f * w_o[(size_t)k * 2048 + n]; }, ws + WS_WOT, 2048, 64 * kb, 32 * nb, scr, lane); continue; }
        r -= I_O;
        { const int nb = r % 32, kb = r / 32;
            transpose_item([=](int k, int n) -> float { return w_mem_kv[(size_t)k * 1024 + n]; }, (bf16_t*)(ws + WS_WMEMT), 2048, 64 * kb, 32 * nb, scr, lane); }
    }
    cvt_matrix(C, (bf16_t*)(ws + WS_WKT), 256, 768, 256, [=](int n, int k) -> float { return w_kv_up[(size_t)k * 1536 + n]; });
    cvt_matrix(C, (bf16_t*)(ws + WS_WVBD), 512, 768, 512, [=](int n, int k) -> float { return (k >> 8) == ((n >> 7) & 1) ? w_kv_up[(size_t)(k & 255) * 1536 + 768 + n] : 0.f; });
    cvt_matrix(C, (bf16_t*)(ws + WS_WQBD), 128, 1536, 128, [=](int n, int k) -> float {
        return w_kv_up[(size_t)(n & 255) * 1536 + (n >> 8) * 128 + k] * k_norm_a[k] * 0.08838834764831845f; });
    for (int m = gw; m < M / 2; m += NGW) rms_rows2_to_bf16(C.in[0] + (size_t)m * DM, C.in[2], (bf16_t*)(ws + WS_H) + (size_t)m * DM, (size_t)(M / 2) * DM, C.lane, ws + WS_H8 + (size_t)m * DM);
    for (int m = gw; m < BATCH * MEMLEN / 2; m += NGW) rms_rows2_to_bf16(C.in[1] + (size_t)m * DM, C.in[13], (bf16_t*)(ws + WS_MEMN) + (size_t)m * DM, (size_t)(BATCH * MEMLEN / 2) * DM, C.lane);
    float* kss = (float*)(ws + WS_KSS);
    for (int i = C.vcu * NTHREADS + C.tid; i < M * 8; i += C.G * NTHREADS) kss[i] = 0.f;
}

typedef __bf16 bf8v __attribute__((ext_vector_type(8)));
typedef int i32x4 __attribute__((ext_vector_type(4)));
typedef float f32x16 __attribute__((ext_vector_type(16)));
#define MFMA32(a, b, c) __builtin_amdgcn_mfma_f32_32x32x16_bf16(__builtin_bit_cast(bf8v, (a)), __builtin_bit_cast(bf8v, (b)), (c), 0, 0, 0)
constexpr int IX_NB = 256, IX_CAP = 128, IX_QROW = 144;
constexpr int IX_Q = 0, IX_HIST = 78848, IX_CAND = IX_HIST + 32768, IX_PAR = IX_CAND + 32768, IX_STAT = IX_PAR + 1024;
static_assert(IX_STAT + 3072 <= LDS_BYTES, "indexer LDS map");
#define LDS_ADD(p, v) __hip_atomic_fetch_add((p), (v), __ATOMIC_RELAXED, __HIP_MEMORY_SCOPE_WORKGROUP)
#define LDS_OR(p, v) __hip_atomic_fetch_or((p), (v), __ATOMIC_RELAXED, __HIP_MEMORY_SCOPE_WORKGROUP)

__device__ __forceinline__ float inv_norm_top(float p) {
    const bool flip = p > 0.5f; float pp = flip ? 1.f - p : p; pp = fmaxf(pp, 1e-6f);
    const float t = sqrtf(-2.f * __logf(pp));
    const float z = t - (2.515517f + 0.802853f * t + 0.010328f * t * t) / (1.f + 1.432788f * t + 0.189269f * t * t + 0.001308f * t * t * t);
    return flip ? -z : z;
}
constexpr int IX_W = IX_STAT + 8192;
#define MFMA16I(a, b, c) __builtin_amdgcn_mfma_f32_16x16x32_bf16(__builtin_bit_cast(bf8v, (a)), __builtin_bit_cast(bf8v, (b)), (c), 0, 0, 0)
__device__ __forceinline__ void ix_load_k(const bf16_t* IKb, int p, int lane, u32x4 (&ka)[4][2]) {
#pragma unroll
    for (int kt = 0; kt < 4; ++kt) { int key = 64 * p + 16 * kt + (lane & 15); key = key < SEQ ? key : SEQ - 1;
        const u32x4* kp = (const u32x4*)(IKb + (size_t)key * 64) + (lane >> 4);
#pragma unroll
        for (int s = 0; s < 2; ++s) ka[kt][s] = kp[4 * s]; }
}
template <bool PREF>
__device__ __forceinline__ void ix_scores(const u32x4 (&ka)[4][2], const LAS unsigned char* Qs, int lane, f32x4 (&sacc)[2][4], const bf16_t* IKb, int pn, u32x4 (&kn)[4][2]) {
    const LAS unsigned char* qb = Qs + (lane & 15) * IX_QROW + (lane >> 4) * 16;
    const LAS float* wl = (const LAS float*)(Qs - IX_Q + IX_W) + (lane & 15);
    u32x4 qc[2][2], qn[2][2]; float wc0, wc1, wn0, wn1, wp1 = 0.f;
#pragma unroll
    for (int qt = 0; qt < 2; ++qt)
#pragma unroll
        for (int s = 0; s < 2; ++s) qc[qt][s] = *(const LAS u32x4*)(qb + (16 * 32 + 16 * qt) * IX_QROW + 64 * s);
#pragma unroll
    for (int qt = 0; qt < 2; ++qt)
#pragma unroll
        for (int s = 0; s < 2; ++s) qn[qt][s] = *(const LAS u32x4*)(qb + (16 * qt) * IX_QROW + 64 * s);
    wn0 = wl[0]; wn1 = wl[16];
    asm volatile("" ::: "memory");
#pragma unroll
    for (int qt = 0; qt < 2; ++qt)
#pragma unroll
        for (int kt = 0; kt < 4; ++kt) sacc[qt][kt] = (f32x4){0.f, 0.f, 0.f, 0.f};
#pragma unroll
    for (int s = 0; s < 2; ++s)
#pragma unroll
        for (int qt = 0; qt < 2; ++qt)
#pragma unroll
            for (int kt = 0; kt < 4; ++kt) sacc[qt][kt] = MFMA16I(ka[kt][s], qc[qt][s], sacc[qt][kt]);
    f32x4 z0[4], z1[4];
#pragma unroll
    for (int kt = 0; kt < 4; ++kt) z1[kt] = (f32x4){0.f, 0.f, 0.f, 0.f};
#pragma unroll
    for (int hh = 0; hh < 16; ++hh) {
#pragma unroll
        for (int qt = 0; qt < 2; ++qt)
#pragma unroll
            for (int s = 0; s < 2; ++s) qc[qt][s] = qn[qt][s];
        wc0 = wn0; wc1 = wn1;
#pragma unroll
        for (int kt = 0; kt < 4; ++kt) z0[kt] = (f32x4){0.f, 0.f, 0.f, 0.f};
#pragma unroll
        for (int s = 0; s < 2; ++s)
#pragma unroll
            for (int kt = 0; kt < 4; ++kt) z0[kt] = MFMA16I(ka[kt][s], qc[0][s], z0[kt]);
        if (hh > 0) {
#pragma unroll
            for (int kt = 0; kt < 4; ++kt)
#pragma unroll
                for (int i = 0; i < 4; ++i) { float t1 = __builtin_fmaf(__builtin_fabsf(z1[kt][i]), wp1, sacc[1][kt][i]); asm volatile("" : "+v"(t1)); sacc[1][kt][i] = t1; }
#pragma unroll
            for (int i = 0; i < 8; ++i) { __builtin_amdgcn_sched_group_barrier(0x008, 1, 0); __builtin_amdgcn_sched_group_barrier(0x002, 2, 0); }
            asm volatile("" : "+v"(sacc[1][0]), "+v"(sacc[1][1]), "+v"(sacc[1][2]), "+v"(sacc[1][3]));
        }
        __builtin_amdgcn_sched_barrier(0);
#pragma unroll
        for (int kt = 0; kt < 4; ++kt) z1[kt] = (f32x4){0.f, 0.f, 0.f, 0.f};
#pragma unroll
        for (int s = 0; s < 2; ++s)
#pragma unroll
            for (int kt = 0; kt < 4; ++kt) z1[kt] = MFMA16I(ka[kt][s], qc[1][s], z1[kt]);
        if (hh < 15) {
#pragma unroll
            for (int qt = 0; qt < 2; ++qt)
#pragma unroll
                for (int s = 0; s < 2; ++s) qn[qt][s] = *(const LAS u32x4*)(qb + ((hh + 1) * 32 + 16 * qt) * IX_QROW + 64 * s);
            wn0 = wl[(hh + 1) * 32]; wn1 = wl[(hh + 1) * 32 + 16]; }
#pragma unroll
        for (int kt = 0; kt < 4; ++kt)
#pragma unroll
            for (int i = 0; i < 4; ++i) { float t0 = __builtin_fmaf(__builtin_fabsf(z0[kt][i]), wc0, sacc[0][kt][i]); asm volatile("" : "+v"(t0)); sacc[0][kt][i] = t0; }
#pragma unroll
        for (int i = 0; i < 8; ++i) { __builtin_amdgcn_sched_group_barrier(0x008, 1, 0); __builtin_amdgcn_sched_group_barrier(0x002, 2, 0); if (hh < 15 && i < 6) __builtin_amdgcn_sched_group_barrier(0x100, 1, 0); }
        asm volatile("" : "+v"(sacc[0][0]), "+v"(sacc[0][1]), "+v"(sacc[0][2]), "+v"(sacc[0][3]));
        __builtin_amdgcn_sched_barrier(0);
        wp1 = wc1;
        if (PREF && hh == 5) { ix_load_k(IKb, pn, lane, kn); asm volatile("" ::: "memory"); }
    }
#pragma unroll
    for (int kt = 0; kt < 4; ++kt)
#pragma unroll
        for (int i = 0; i < 4; ++i) { float t1 = __builtin_fmaf(__builtin_fabsf(z1[kt][i]), wp1, sacc[1][kt][i]); asm volatile("" : "+v"(t1)); sacc[1][kt][i] = t1; }
    asm volatile("" : "+v"(sacc[1][0]), "+v"(sacc[1][1]), "+v"(sacc[1][2]), "+v"(sacc[1][3]));
}
typedef __bf16 bf16x2v __attribute__((ext_vector_type(2)));
__device__ __forceinline__ float dot2_bf16(unsigned w, unsigned x, float acc) { return __builtin_amdgcn_fdot2_f32_bf16(__builtin_bit_cast(bf16x2v, w), __builtin_bit_cast(bf16x2v, x), acc, false); }
__device__ __forceinline__ int ix_bin(float sv, float scale, float nls) { int bb = (int)__builtin_fmaf(sv, scale, nls); return bb < 0 ? 0 : (bb > IX_NB - 1 ? IX_NB - 1 : bb); }
__device__ __forceinline__ float f_next(float x) { int i = __float_as_int(x); if (x == 0.f) return __int_as_float(1); i += (i >= 0) ? 1 : -1; return __int_as_float(i); }
__device__ __forceinline__ float f_prev(float x) { int i = __float_as_int(x); if (x == 0.f) return __int_as_float((int)0x80000001u); i += (i >= 0) ? -1 : 1; return __int_as_float(i); }
__device__ __forceinline__ float ix_threshold(int k, float scale, float nls) {
    float gs = ((float)k - nls) / scale;
    for (int i = 0; i < 64 && ix_bin(gs, scale, nls) >= k; ++i) gs = f_prev(gs);
    for (int i = 0; i < 64 && ix_bin(gs, scale, nls) < k; ++i) gs = f_next(gs);
    return gs;
}
constexpr int IX_LIST = IX_STAT;
static_assert(IX_STAT + 8 * 1024 <= LDS_BYTES - 64, "indexer LDS map");
template <int MODE>
__device__ __forceinline__ void fast_indexer(Ctx& C, int* IDX) {
    unsigned char* ws = C.ws; const int wave = C.wave;
    const bf16_t* IQ = (const bf16_t*)((unsigned char*)C.out + DO_IQ); const bf16_t* IK = (const bf16_t*)(ws + WS_IK); const float* IW = (const float*)(ws + WS_IW);
    LAS unsigned char* Qs = C.lds + IX_Q;
    LAS unsigned* hist = (LAS unsigned*)(C.lds + IX_HIST);
    LAS unsigned* cmask = (LAS unsigned*)(C.lds + IX_CAND);
    LAS float* p_nls = (LAS float*)(C.lds + IX_PAR);
    LAS float* p_scale = p_nls + 32;
    LAS int* p_bst = (LAS int*)(p_nls + 64);
    LAS int* p_above = (LAS int*)(p_nls + 96);
    LAS float* p_tlo = p_nls + 128;
    LAS float* p_thi = p_nls + 160;
    LAS unsigned* p_notok = (LAS unsigned*)(p_nls + 192);
    LAS float* stat = (LAS float*)(C.lds + IX_STAT);
#pragma unroll 1
    for (int uu = 0; uu < 2; ++uu) {
        const int tid = opaque_v(C.tid), lane = tid & 63, c16 = lane & 15, g4 = lane >> 4;
        const int b = uu, qblk = uu == 0 ? C.vcu : (255 - C.vcu);
        if (qblk < 0 || qblk > 255) continue;
        const int t0 = 32 * qblk, npairs = (qblk + 2) >> 1;
        const size_t qrow0 = (size_t)b * SEQ + t0;
        const bf16_t* IKb = IK + (size_t)b * SEQ * 64;
        unsigned char* const bins = C.vcu < 192 ? ws + WS_H8 + (size_t)C.vcu * 262144 : ws + WS_H + 32 * MiB + (size_t)(C.vcu - 192) * 262144;
        __syncthreads();
        { u32x4 qv[8];
#pragma unroll
            for (int i = 0; i < 8; ++i) { const int c = tid + NTHREADS * i, r = c >> 7, ch = c & 127; qv[i] = *((const u32x4*)(IQ + (qrow0 + r) * 1024) + ch); }
#pragma unroll
            for (int i = 0; i < 8; ++i) { const int c = tid + NTHREADS * i, r = c >> 7, ch = c & 127, hh = ch >> 3, c8 = ch & 7; *(LAS u32x4*)(Qs + (hh * 32 + r) * IX_QROW + c8 * 16) = qv[i]; } }
        for (int i = tid; i < 8192; i += NTHREADS) { hist[i] = 0u; cmask[i] = 0u; }
        if (tid < 32) { p_bst[tid] = -1; p_above[tid] = 0; p_nls[tid] = 0.f; p_scale[tid] = 0.f; p_tlo[tid] = -INFINITY; p_thi[tid] = -INFINITY; }
        if (tid == 32) p_notok[0] = 0u;
        if (tid < 512) { LAS float* wt = (LAS float*)(C.lds + IX_W); wt[tid] = 0.5f * IW[(qrow0 + (tid & 31)) * 16 + (tid >> 5)]; }
        __syncthreads();
        for (int e = tid; e < 32 * 64; e += NTHREADS) { const int r = e >> 6, d = e & 63; float a = 0.f;
#pragma unroll
            for (int hh = 0; hh < 16; ++hh) a += ((const LAS float*)(C.lds + IX_W))[hh * 32 + r] * bf2f(*(const LAS bf16_t*)(Qs + (hh * 32 + r) * IX_QROW + d * 2));
            *(LAS bf16_t*)(Qs + (16 * 32 + r) * IX_QROW + d * 2) = (bf16_t)f2bf(a); }
        __syncthreads();
        if (MODE & 1) { float sn[2] = {0.f, 0.f}, ss[2] = {0.f, 0.f}, sq[2] = {0.f, 0.f};
            const int ps = npairs <= 8 ? wave : (wave * npairs) >> 3;
            if (ps < npairs) { f32x4 sacc[2][4]; u32x4 ka[4][2]; ix_load_k(IKb, ps, lane, ka); ix_scores<false>(ka, Qs, lane, sacc, IKb, 0, ka);
#pragma unroll
                for (int qt = 0; qt < 2; ++qt)
#pragma unroll
                    for (int kt = 0; kt < 4; ++kt)
#pragma unroll
                        for (int i = 0; i < 4; ++i) { const int key = 64 * ps + 16 * kt + 4 * g4 + i;
                            const float m = key <= t0 + 16 * qt + c16 ? 1.f : 0.f; const float v = sacc[qt][kt][i] * m; sn[qt] += m; ss[qt] += v; sq[qt] += v * v; } }
#pragma unroll
            for (int qt = 0; qt < 2; ++qt) { sn[qt] += __shfl_xor(sn[qt], 16); ss[qt] += __shfl_xor(ss[qt], 16); sq[qt] += __shfl_xor(sq[qt], 16);
                sn[qt] += __shfl_xor(sn[qt], 32); ss[qt] += __shfl_xor(ss[qt], 32); sq[qt] += __shfl_xor(sq[qt], 32);
                if (lane < 16) { stat[(wave * 32 + 16 * qt + lane) * 3 + 0] = sn[qt]; stat[(wave * 32 + 16 * qt + lane) * 3 + 1] = ss[qt]; stat[(wave * 32 + 16 * qt + lane) * 3 + 2] = sq[qt]; } } }
        __syncthreads();
        if (tid < 32) { float sn = 0.f, ss = 0.f, sq = 0.f;
            for (int w = 0; w < 8; ++w) { sn += stat[(w * 32 + tid) * 3 + 0]; ss += stat[(w * 32 + tid) * 3 + 1]; sq += stat[(w * 32 + tid) * 3 + 2]; }
            const int Nt = t0 + tid + 1;
            if (Nt > TOPK) { const float mean = ss / fmaxf(sn, 1.f); const float var = fmaxf(sq / fmaxf(sn, 1.f) - mean * mean, 0.f); const float sd = sqrtf(var);
                const float zq = inv_norm_top((float)TOPK / (float)Nt);
                const float width = fmaxf(3.0f * sd, 1e-6f * fabsf(mean) + 1e-30f);
                const float lo = mean + (zq - 1.5f) * sd, sc = (float)IX_NB / width;
                p_scale[tid] = sc; p_nls[tid] = -lo * sc; p_bst[tid] = 0; } }
        __syncthreads();
#pragma unroll 1
        for (int iter = 0; iter < ((MODE & 2) ? 8 : 0); ++iter) {
            const float nls0 = p_nls[c16], scale0 = p_scale[c16], nls1 = p_nls[16 + c16], scale1 = p_scale[16 + c16];
            u32x4 ka[4][2], kn[4][2];
            if (wave < npairs) ix_load_k(IKb, wave, lane, ka);
#pragma unroll 1
            for (int p = wave; p < npairs; p += 8) { f32x4 sacc[2][4];
                ix_scores<true>(ka, Qs, lane, sacc, IKb, p + 8 < npairs ? p + 8 : p, kn);
#pragma unroll
                for (int kt = 0; kt < 4; ++kt)
#pragma unroll
                    for (int s4 = 0; s4 < 2; ++s4) ka[kt][s4] = kn[kt][s4];
                if (64 * p + 63 <= t0) {
#pragma unroll
                    for (int qt = 0; qt < 2; ++qt) { LAS unsigned* hq = hist + 16 * qt + c16; const float scale = qt ? scale1 : scale0, nls = qt ? nls1 : nls0;
                        unsigned char* brow = bins + (size_t)(16 * qt + c16) * 8192 + 64 * p + 4 * g4;
#pragma unroll
                        for (int kt = 0; kt < 4; ++kt) { int bb[4];
#pragma unroll
                            for (int i = 0; i < 4; ++i) { bb[i] = ix_bin(sacc[qt][kt][i], scale, nls); LDS_ADD(hq + bb[i] * 32, 1u); }
                            *(unsigned*)(brow + 16 * kt) = (unsigned)bb[0] | ((unsigned)bb[1] << 8) | ((unsigned)bb[2] << 16) | ((unsigned)bb[3] << 24); } }
                } else {
#pragma unroll
                    for (int qt = 0; qt < 2; ++qt) { LAS unsigned* hq = hist + 16 * qt + c16; const float scale = qt ? scale1 : scale0, nls = qt ? nls1 : nls0; const int query = t0 + 16 * qt + c16;
                        unsigned char* brow = bins + (size_t)(16 * qt + c16) * 8192 + 64 * p + 4 * g4;
#pragma unroll
                        for (int kt = 0; kt < 4; ++kt) { int bb[4];
#pragma unroll
                            for (int i = 0; i < 4; ++i) { const int key = 64 * p + 16 * kt + 4 * g4 + i;
                                bb[i] = ix_bin(sacc[qt][kt][i], scale, nls); LDS_ADD(hq + bb[i] * 32, key <= query ? 1u : 0u); }
                            *(unsigned*)(brow + 16 * kt) = (unsigned)bb[0] | ((unsigned)bb[1] << 8) | ((unsigned)bb[2] << 16) | ((unsigned)bb[3] << 24); } } }
                asm volatile("" ::: "memory"); }
            __syncthreads();
#pragma unroll 1
            for (int k = 0; k < 4; ++k) { const int tq = 4 * wave + k; const int Nt = t0 + tq + 1;
                if (Nt <= TOPK) continue;
                unsigned c[4]; unsigned cs = 0;
#pragma unroll
                for (int i = 0; i < 4; ++i) { c[i] = hist[(IX_NB - 1 - (4 * lane + i)) * 32 + tq]; cs += c[i]; }
                unsigned pre = cs;
                pre = wave_iscan(pre);
                const unsigned long long mask = __ballot(pre >= (unsigned)TOPK);
                const int L = __ffsll((long long)mask) - 1;
                if (lane == L) { unsigned ex = pre - cs; int ii = 0;
#pragma unroll
                    for (int i = 0; i < 3; ++i) if (ii == i && ex + c[i] < (unsigned)TOPK) { ex += c[i]; ii = i + 1; }
                    const unsigned nin = ii == 0 ? c[0] : (ii == 1 ? c[1] : (ii == 2 ? c[2] : c[3]));
                    const int bst = IX_NB - 1 - (4 * lane + ii);
                    p_bst[tq] = bst; p_above[tq] = (int)ex;
                    const float sc_q = p_scale[tq], nls_q = p_nls[tq];
                    bool again = false;
                    if (nin > (unsigned)IX_CAP && iter < 7) { const float w1 = 1.0f / sc_q, wd = (float)IX_NB * w1, lo_q = -nls_q * w1;
                        float nlo, nwd;
                        if (bst == 0) { nwd = 2.f * wd; nlo = lo_q + w1 - nwd; }
                        else if (bst == IX_NB - 1) { nwd = 2.f * wd; nlo = lo_q + (float)(IX_NB - 1) * w1; }
                        else { nwd = w1; nlo = lo_q + (float)bst * w1; }
                        if (nwd > 1e-7f * fabsf(nlo) + 1e-36f) { const float nsc = (float)IX_NB / nwd; p_scale[tq] = nsc; p_nls[tq] = -nlo * nsc; LDS_ADD(p_notok, 1u); again = true; } }
                    (void)again; } }
            __syncthreads();
            const unsigned notok = p_notok[0];
            __syncthreads();
            for (int i = tid; i < 8192; i += NTHREADS) hist[i] = 0u;
            if (tid == 0) p_notok[0] = 0u;
            __syncthreads();
            if (notok == 0u) break;
        }
        if (MODE & 4) {
            asm volatile("s_waitcnt vmcnt(0)" ::: "memory"); __syncthreads(); __builtin_amdgcn_fence(__ATOMIC_ACQUIRE, "agent");
            const int nit = (t0 + 32 + 1023) >> 10;
            unsigned Kgt[4];
#pragma unroll
            for (int k = 0; k < 4; ++k) Kgt[k] = (unsigned)(0x7fff - p_bst[4 * wave + k]) * 0x00010001u;
            const unsigned char* brow = bins + (size_t)(4 * wave) * 8192 + 16 * lane;
            u32x4 xn[4];
#pragma unroll
            for (int k = 0; k < 4; ++k) xn[k] = *(const u32x4*)(brow + k * 8192);
#pragma unroll 1
            for (int it = 0; it < nit; ++it) {
                u32x4 xc[4];
#pragma unroll
                for (int k = 0; k < 4; ++k) xc[k] = xn[k];
                if (it + 1 < nit) {
#pragma unroll
                    for (int k = 0; k < 4; ++k) xn[k] = *(const u32x4*)(brow + k * 8192 + 1024 * (it + 1)); }
#pragma unroll
                for (int k = 0; k < 4; ++k) { const int tq = 4 * wave + k; const unsigned kgt = Kgt[k], kge = kgt + 0x00010001u;
                    const unsigned xs[4] = {xc[k].x, xc[k].y, xc[k].z, xc[k].w};
                    unsigned sel = 0u, ge = 0u;
#pragma unroll
                    for (int j = 0; j < 4; ++j) { const unsigned lo = xs[j] & 0x00ff00ffu, hi = (xs[j] >> 8) & 0x00ff00ffu;
                        { const unsigned u = (((lo + kgt) >> 15) & 0x00010001u) | (((hi + kgt) >> 14) & 0x00020002u); sel |= ((u | (u >> 14)) & 0xfu) << (4 * j); }
                        { const unsigned u = (((lo + kge) >> 15) & 0x00010001u) | (((hi + kge) >> 14) & 0x00020002u); ge |= ((u | (u >> 14)) & 0xfu) << (4 * j); } }
                    unsigned cand = ge & ~sel;
                    const int lim = t0 + tq - (1024 * it + 16 * lane);
                    const unsigned vm = lim >= 15 ? 0xffffu : (lim < 0 ? 0u : ((2u << lim) - 1u));
                    sel &= vm; cand &= vm;
                    const unsigned pk = sel | (cand << 16);
                    const unsigned other = (unsigned)__shfl_xor((int)pk, 1);
                    if (!(lane & 1)) { hist[tq * 256 + 32 * it + (lane >> 1)] = (pk & 0xffffu) | (other << 16); cmask[tq * 256 + 32 * it + (lane >> 1)] = (pk >> 16) | (other & 0xffff0000u); } }
            }
        }
        __syncthreads();
        LAS unsigned* klist = (LAS unsigned*)(C.lds + IX_LIST + wave * 1024);
        LAS float* slist = (LAS float*)(klist + 128);
        unsigned slowmask = 0u, ncs = 0u;
        if (MODE & 8) {
#pragma unroll 1
            for (int k = 0; k < 4; ++k) { const int tq = 4 * wave + k; const int Nt = t0 + tq + 1;
                const int R = TOPK - p_above[tq];
                if (Nt > TOPK && R > 0) {
                    unsigned cw[4]; unsigned cnt = 0;
#pragma unroll
                    for (int i = 0; i < 4; ++i) { cw[i] = cmask[tq * 256 + 4 * lane + i]; cnt += __popc(cw[i]); }
                    unsigned pre = cnt;
                    pre = wave_iscan(pre);
                    const unsigned tot = (unsigned)__builtin_amdgcn_readfirstlane((int)__shfl(pre, 63));
                    if (tot > 16u) slowmask |= 1u << k;
                    else { ncs |= tot << (8 * k);
                        unsigned pos = pre - cnt;
#pragma unroll
                        for (int i = 0; i < 4; ++i) { unsigned wbits = cw[i];
                            while (wbits) { const int bb = __ffs((int)wbits) - 1; wbits &= wbits - 1; klist[16 * k + pos] = (unsigned)(32 * (4 * lane + i) + bb); ++pos; } } } } }
            const int j = lane >> 4, ci = lane & 15, tqj = 4 * wave + j;
            const int ncj = (int)((ncs >> (8 * j)) & 0xffu);
            if (ci < ncj) { const unsigned key = klist[16 * j + ci]; const u32x4* kp = (const u32x4*)(IKb + (size_t)key * 64);
                unsigned kw[32];
#pragma unroll
                for (int c8 = 0; c8 < 8; ++c8) { const u32x4 w = kp[c8]; kw[4 * c8] = w.x; kw[4 * c8 + 1] = w.y; kw[4 * c8 + 2] = w.z; kw[4 * c8 + 3] = w.w; }
                const LAS float* wt = (const LAS float*)(C.lds + IX_W) + tqj;
                float sc = 0.f;
#pragma unroll
                for (int hh = 0; hh < 17; ++hh) { const LAS u32x4* qp = (const LAS u32x4*)(Qs + (hh * 32 + tqj) * IX_QROW); float d0 = 0.f, d1 = 0.f;
#pragma unroll
                    for (int c8 = 0; c8 < 8; ++c8) { const u32x4 qv = qp[c8];
                        d0 = dot2_bf16(qv.x, kw[4 * c8], d0); d1 = dot2_bf16(qv.y, kw[4 * c8 + 1], d1); d0 = dot2_bf16(qv.z, kw[4 * c8 + 2], d0); d1 = dot2_bf16(qv.w, kw[4 * c8 + 3], d1); }
                    const float dd = d0 + d1;
                    sc += hh == 16 ? dd : wt[(hh & 15) * 32] * fabsf(dd); }
                slist[16 * j + ci] = sc; }
            asm volatile("s_waitcnt lgkmcnt(0)" ::: "memory");
            if (ci < ncj) { const float ms = slist[16 * j + ci]; const unsigned mk = klist[16 * j + ci]; int rank = 0; const int Rj = TOPK - p_above[tqj];
                for (int o = 0; o < 16; ++o) { const float os = slist[16 * j + o]; const unsigned ok = klist[16 * j + o]; rank += (o < ncj && (os > ms || (os == ms && ok < mk))) ? 1 : 0; }
                if (rank < Rj) LDS_OR(hist + tqj * 256 + (mk >> 5), 1u << (mk & 31)); }
            asm volatile("s_waitcnt lgkmcnt(0)" ::: "memory");
        }
#pragma unroll 1
        for (int k = 0; k < ((MODE & 8) ? 4 : 0); ++k) { const int tq = 4 * wave + k; const int Nt = t0 + tq + 1;
            const int R = TOPK - p_above[tq];
            if ((slowmask >> k) & 1u) {
                unsigned cw[4]; unsigned cnt = 0;
#pragma unroll
                for (int i = 0; i < 4; ++i) { cw[i] = cmask[tq * 256 + 4 * lane + i]; cnt += __popc(cw[i]); }
                unsigned pre = cnt;
                pre = wave_iscan(pre);
                const unsigned tot = __shfl(pre, 63); const int nc = (int)(tot < (unsigned)IX_CAP ? tot : (unsigned)IX_CAP);
                unsigned pos = pre - cnt;
#pragma unroll
                for (int i = 0; i < 4; ++i) { unsigned wbits = cw[i];
                    while (wbits) { const int bb = __ffs((int)wbits) - 1; wbits &= wbits - 1; if (pos < (unsigned)IX_CAP) klist[pos] = (unsigned)(32 * (4 * lane + i) + bb); ++pos; } }
                const float wq = 0.5f * IW[(qrow0 + tq) * 16 + (lane & 15)];
#pragma unroll 1
                for (int ii = 0; ii < 2; ++ii) { const int ci = lane + 64 * ii;
                    if (ci < nc) { const unsigned key = klist[ci]; const u32x4* kp = (const u32x4*)(IKb + (size_t)key * 64);
                        unsigned kw[32];
#pragma unroll
                        for (int c8 = 0; c8 < 8; ++c8) { const u32x4 w = kp[c8]; kw[4 * c8] = w.x; kw[4 * c8 + 1] = w.y; kw[4 * c8 + 2] = w.z; kw[4 * c8 + 3] = w.w; }
                        float sc = 0.f;
#pragma unroll
                        for (int hh = 0; hh < 17; ++hh) { const LAS u32x4* qp = (const LAS u32x4*)(Qs + (hh * 32 + tq) * IX_QROW); float d0 = 0.f, d1 = 0.f;
#pragma unroll
                            for (int c8 = 0; c8 < 8; ++c8) { const u32x4 qv = qp[c8];
                                d0 = dot2_bf16(qv.x, kw[4 * c8], d0); d1 = dot2_bf16(qv.y, kw[4 * c8 + 1], d1); d0 = dot2_bf16(qv.z, kw[4 * c8 + 2], d0); d1 = dot2_bf16(qv.w, kw[4 * c8 + 3], d1); }
                            const float dd = d0 + d1;
                            sc += hh == 16 ? dd : __builtin_bit_cast(float, __builtin_amdgcn_readlane(__builtin_bit_cast(int, wq), hh & 15)) * fabsf(dd); }
                        slist[ci] = sc; } }
#pragma unroll 1
                for (int ii = 0; ii < 2; ++ii) { const int ci = lane + 64 * ii;
                    if (ci < nc) { const float ms = slist[ci]; const unsigned mk = klist[ci]; int rank = 0;
                        for (int o = 0; o < nc; ++o) { const float os = slist[o]; const unsigned ok = klist[o]; rank += (os > ms || (os == ms && ok < mk)) ? 1 : 0; }
                        if (rank < R) LDS_OR(hist + tq * 256 + (mk >> 5), 1u << (mk & 31)); } }
            }
            unsigned wd[4]; unsigned cnt = 0;
#pragma unroll
            for (int i = 0; i < 4; ++i) { wd[i] = hist[tq * 256 + 4 * lane + i]; cnt += __popc(wd[i]); }
            unsigned pre = cnt;
            pre = wave_iscan(pre);
            const unsigned total = __shfl(pre, 63);
            unsigned pos = pre - cnt; LAS int* olist = (LAS int*)klist;
#pragma unroll
            for (int i = 0; i < 4; ++i) { unsigned wbits = wd[i];
                while (wbits) { const int bb = __ffs((int)wbits) - 1; wbits &= wbits - 1; if (pos < (unsigned)TOPK) olist[pos] = 32 * (4 * lane + i) + bb; ++pos; } }
            asm volatile("s_waitcnt lgkmcnt(0)" ::: "memory");
            { i32x4 ov = *(const LAS i32x4*)(olist + 4 * lane); const int tl = (int)total;
                ov.x = 4 * lane + 0 < tl ? ov.x : -1; ov.y = 4 * lane + 1 < tl ? ov.y : -1; ov.z = 4 * lane + 2 < tl ? ov.z : -1; ov.w = 4 * lane + 3 < tl ? ov.w : -1;
                *((i32x4*)(IDX + (qrow0 + tq) * TOPK) + lane) = ov; }
            asm volatile("s_waitcnt lgkmcnt(0)" ::: "memory");
        }
    }
}

typedef short s16x4 __attribute__((ext_vector_type(4)));
typedef int i32x4 __attribute__((ext_vector_type(4)));
typedef __attribute__((address_space(3))) s16x4 las_s16x4;
using pg8::bf16x8;
#define MFMA16(a, b, c) __builtin_amdgcn_mfma_f32_16x16x32_bf16((a), (b), (c), 0, 0, 0)
constexpr int DS_ROW = 544, DS_IMG = 32 * DS_ROW, DS_WSTRIDE = DS_IMG + 2048, DS_BIAS = 8 * DS_WSTRIDE;
static_assert(DS_BIAS + 129 * 8 * 4 <= LDS_BYTES, "dsa LDS map");
__device__ __forceinline__ float gain_absmax(const float* g, int n, int lane) { float m = 0.f; for (int i = lane; i < n; i += 64) m = fmaxf(m, fabsf(g[i])); return wave_max(m); }

__device__ __forceinline__ void fast_dsa(Ctx& C) {
    unsigned char* ws = C.ws; const int tid = opaque_v(C.tid), lane = tid & 63, wave = C.wave;
    const bf16_t* QABS = (const bf16_t*)(ws + WS_QABS); const bf16_t* CKV = (const bf16_t*)(ws + WS_CKV); const float* KSS = (const float*)(ws + WS_KSS);
    const int* IDX = (const int*)(ws + WS_IDX); bf16_t* PC = (bf16_t*)(ws + WS_PC); const float* rel_bias = C.in[22];
    LAS unsigned char* img = C.lds + wave * DS_WSTRIDE;
    LAS int* idxs = (LAS int*)(img + DS_IMG);
    LAS unsigned* offs = (LAS unsigned*)(img + DS_IMG + 1024);
    LAS float* biasA = (LAS float*)(C.lds + DS_BIAS);
    __syncthreads();
    float bmax = 0.f;
    for (int i = tid; i < 129 * 8; i += NTHREADS) { const int dist = i >> 3, h = i & 7; const float v = h < 6 ? rel_bias[(dist < 128 ? T5_BUCKET[dist] : 31) * 18 + h] : 0.f; biasA[i] = v; }
    for (int i = lane; i < 32 * 6; i += 64) bmax = fmaxf(bmax, fabsf(rel_bias[(i / 6) * 18 + (i % 6)]));
    bmax = wave_max(bmax);
    const float bound = gain_absmax(C.in[8], 128, lane) * gain_absmax(C.in[9], 128, lane) * 11.3137085f + bmax;
    const float shift = fmaxf(0.f, bound - 30.f);
    __syncthreads();
    const int g = lane >> 4, hd = lane & 15, hq = hd & 7;
    const int xcd = C.vcu >> 5, b = xcd & 1;
    const int wl = ((xcd >> 1) * 32 + (C.vcu & 31)) * NWAVES + wave;
    const float* KSSb = KSS + (size_t)b * SEQ * 8; const bf16_t* CKVb = CKV + (size_t)b * SEQ * 256;
    i32x4 idxrow = *((const i32x4*)(IDX + ((size_t)b * SEQ + wl) * TOPK) + lane);
#pragma unroll 1
    for (int t = wl; t < SEQ; t += 1024) {
        const size_t q = (size_t)b * SEQ + t;
        { const i32x4 v = idxrow; *((LAS i32x4*)idxs + lane) = v; if (t + 1024 < SEQ) idxrow = *((const i32x4*)(IDX + (q + 1024) * TOPK) + lane);
          u32x4 o; o.x = (unsigned)(v.x < 0 ? 0 : v.x) << 9; o.y = (unsigned)(v.y < 0 ? 0 : v.y) << 9; o.z = (unsigned)(v.z < 0 ? 0 : v.z) << 9; o.w = (unsigned)(v.w < 0 ? 0 : v.w) << 9; *((LAS u32x4*)offs + lane) = o; }
        bf16x8 qb[8];
#pragma unroll
        for (int ks = 0; ks < 8; ++ks) { u32x4 w = (u32x4){0u, 0u, 0u, 0u}; if (hd < 6) w = *(const u32x4*)(QABS + q * 1536 + hd * 256 + 32 * ks + 8 * g); qb[ks] = __builtin_bit_cast(bf16x8, w); }
        f32x4 pcT[16];
#pragma unroll
        for (int rt = 0; rt < 16; ++rt) pcT[rt] = (f32x4){0.f, 0.f, 0.f, 0.f};
        float lsum = 0.f;
        u32x4 gr[16]; f32x4 ksv[2];
        const int rl = lane >> 5, cl = lane & 31;
#define DSA_GATHER(pp_) do { _Pragma("unroll") for (int i = 0; i < 16; ++i) { const unsigned ro = offs[32 * (pp_) + 2 * i + rl]; \
                gr[i] = *(const u32x4*)((const unsigned char*)CKVb + (ro + (unsigned)(cl * 16))); } \
            _Pragma("unroll") for (int tt = 0; tt < 2; ++tt) { const unsigned ro = offs[32 * (pp_) + 16 * tt + hd]; ksv[tt] = *(const f32x4*)((const unsigned char*)KSSb + ((ro >> 4) + (unsigned)(16 * (g & 1)))); } } while (0)
        DSA_GATHER(0);
#pragma unroll 1
        for (int pp = 0; pp < 8; ++pp) {
            const i32x4 kv0 = *((const LAS i32x4*)idxs + (8 * pp + g)), kv1 = *((const LAS i32x4*)idxs + (8 * pp + 4 + g));
            const int kq[8] = {kv0.x, kv0.y, kv0.z, kv0.w, kv1.x, kv1.y, kv1.z, kv1.w};
            float bv[8];
#pragma unroll
            for (int i = 0; i < 8; ++i) { const int kk = kq[i] < 0 ? 0 : kq[i]; const int dist = t - kk; bv[i] = biasA[(dist < 128 ? dist : 128) * 8 + hq]; }
#pragma unroll
            for (int i = 0; i < 16; ++i) *(LAS u32x4*)(img + (2 * i + rl) * DS_ROW + cl * 16) = gr[i];
#pragma unroll
            for (int tt = 0; tt < 2; ++tt) { f32x4 rr; rr[0] = rsqrt_f(ksv[tt][0] * (1.f / 128.f) + EPS); rr[1] = rsqrt_f(ksv[tt][1] * (1.f / 128.f) + EPS); rr[2] = rsqrt_f(ksv[tt][2] * (1.f / 128.f) + EPS); rr[3] = rsqrt_f(ksv[tt][3] * (1.f / 128.f) + EPS);
                *(LAS f32x4*)(img + (16 * tt + hd) * DS_ROW + 512 + 16 * (g & 1)) = rr; }
            asm volatile("" ::: "memory");
            if (pp < 7) DSA_GATHER(pp + 1);
            asm volatile("" ::: "memory");
            f32x4 lg[2];
#pragma unroll
            for (int tt = 0; tt < 2; ++tt) { lg[tt] = (f32x4){0.f, 0.f, 0.f, 0.f}; bf16x8 af[8];
#pragma unroll
                for (int ks = 0; ks < 8; ++ks) af[ks] = __builtin_bit_cast(bf16x8, *(const LAS u32x4*)(img + (16 * tt + hd) * DS_ROW + 64 * ks + 16 * g));
#pragma unroll
                for (int ks = 0; ks < 8; ++ks) lg[tt] = MFMA16(af[ks], qb[ks], lg[tt]); }
            float rsv[8];
#pragma unroll
            for (int i = 0; i < 8; ++i) rsv[i] = *(const LAS float*)(img + (16 * (i >> 2) + 4 * g + (i & 3)) * DS_ROW + 512 + 4 * hq);
            float p[8];
#pragma unroll
            for (int i = 0; i < 8; ++i) { const float e = __expf(lg[i >> 2][i & 3] * rsv[i] + bv[i] - shift); p[i] = kq[i] < 0 ? 0.f : e; lsum += p[i]; }
            u32x4 pw; pw.x = pg8::cvt_pk_bf16(p[0], p[1]); pw.y = pg8::cvt_pk_bf16(p[2], p[3]); pw.z = pg8::cvt_pk_bf16(p[4], p[5]); pw.w = pg8::cvt_pk_bf16(p[6], p[7]);
            const bf16x8 pb = __builtin_bit_cast(bf16x8, pw);
            const LAS unsigned char* tb = img + (4 * g + ((lane & 15) >> 2)) * DS_ROW + (lane & 3) * 8;
#pragma unroll
            for (int rh = 0; rh < 2; ++rh) { s16x4 a0[8], a1[8];
#pragma unroll
                for (int r8 = 0; r8 < 8; ++r8) { const int rt = 8 * rh + r8; a0[r8] = __builtin_amdgcn_ds_read_tr16_b64_v4i16((las_s16x4*)(tb + rt * 32)); a1[r8] = __builtin_amdgcn_ds_read_tr16_b64_v4i16((las_s16x4*)(tb + 16 * DS_ROW + rt * 32)); }
#pragma unroll
                for (int r8 = 0; r8 < 8; ++r8) { const int rt = 8 * rh + r8; const bf16x8 a = (bf16x8){a0[r8][0], a0[r8][1], a0[r8][2], a0[r8][3], a1[r8][0], a1[r8][1], a1[r8][2], a1[r8][3]};
                    pcT[rt] = MFMA16(a, pb, pcT[rt]); } }
            asm volatile("" ::: "memory");
        }
#undef DSA_GATHER
        lsum += __shfl_xor(lsum, 16); lsum += __shfl_xor(lsum, 32);
        const float linv = __builtin_amdgcn_rcpf(lsum);
        if (hd < 6) {
#pragma unroll
            for (int rt = 0; rt < 16; ++rt) { u32x2 w; w.x = pk2(pcT[rt][0] * linv, pcT[rt][1] * linv); w.y = pk2(pcT[rt][2] * linv, pcT[rt][3] * linv);
                *(u32x2*)(PC + q * 1536 + hd * 256 + 16 * rt + 4 * g) = w; } }
    }
}

template <int D, int KSTR, class F>
__device__ __forceinline__ void tile_attn_item(const LAS unsigned char* Kl, const LAS unsigned char* Vt, const u32x4 (&qf)[D / 16], int kt_lo, int kt_hi, int lane, const F& elem, f32x16 (&O)[D / 32], float& lsum) {
    const int h = lane >> 5, ql = lane & 31;
#pragma unroll
    for (int dt = 0; dt < D / 32; ++dt)
#pragma unroll
        for (int r = 0; r < 16; ++r) O[dt][r] = 0.f;
    lsum = 0.f;
#pragma unroll 1
    for (int kt = kt_lo; kt < kt_hi; ++kt) {
        f32x16 S;
#pragma unroll
        for (int r = 0; r < 16; ++r) S[r] = 0.f;
        const LAS unsigned char* kr = Kl + (32 * kt + ql) * KSTR + 16 * h;
#pragma unroll
        for (int ks = 0; ks < D / 16; ++ks) { const u32x4 ka = *(const LAS u32x4*)(kr + 32 * ks); S = MFMA32(ka, qf[ks], S); }
        float p[16];
#pragma unroll
        for (int r = 0; r < 16; ++r) { p[r] = elem(32 * kt + (r & 3) + 8 * (r >> 2) + 4 * h, S[r]); lsum += p[r]; }
        u32x4 pb[2];
#pragma unroll
        for (int s2 = 0; s2 < 2; ++s2) { pb[s2].x = pg8::cvt_pk_bf16(p[8 * s2 + 0], p[8 * s2 + 1]); pb[s2].y = pg8::cvt_pk_bf16(p[8 * s2 + 2], p[8 * s2 + 3]);
            pb[s2].z = pg8::cvt_pk_bf16(p[8 * s2 + 4], p[8 * s2 + 5]); pb[s2].w = pg8::cvt_pk_bf16(p[8 * s2 + 6], p[8 * s2 + 7]); }
#pragma unroll
        for (int dt = 0; dt < D / 32; ++dt)
#pragma unroll
            for (int s2 = 0; s2 < 2; ++s2) { const LAS unsigned char* vp = Vt + (32 * dt + ql) * 520 + (32 * kt + 16 * s2 + 4 * h) * 2;
                const u32x2 lo = *(const LAS u32x2*)vp, hi = *(const LAS u32x2*)(vp + 16);
                u32x4 va; va.x = lo.x; va.y = lo.y; va.z = hi.x; va.w = hi.y;
                O[dt] = MFMA32(va, pb[s2], O[dt]); }
    }
}

constexpr int SW_K = 0, SW_KSTR = 144, SW_VT = 256 * SW_KSTR, SW_BIAS = SW_VT + 64 * 520, SW_T = SW_BIAS + 6 * 128 * 4;
static_assert(SW_T + 8 * 32 * SW_KSTR <= LDS_BYTES - 64, "swa LDS map");
__device__ __forceinline__ void fast_swa(Ctx& C) {
    unsigned char* ws = C.ws; const int tid = opaque_v(C.tid), lane = tid & 63, wave = C.wave;
    const bf16_t* BQ = (const bf16_t*)(ws + WS_BQ); const bf16_t* BK = (const bf16_t*)(ws + WS_BK); const bf16_t* BV = (const bf16_t*)(ws + WS_BV);
    const bf16_t* GATE = (const bf16_t*)((unsigned char*)C.out + DO_GATE); bf16_t* OP = (bf16_t*)(ws + WS_OP);
    const float* sinks = C.in[12]; const float* rel_bias = C.in[22];
    LAS unsigned char* Kl = C.lds + SW_K; LAS unsigned char* Vt = C.lds + SW_VT; LAS float* bl = (LAS float*)(C.lds + SW_BIAS);
    float bmax = 0.f;
    for (int i = lane; i < 32 * 12; i += 64) bmax = fmaxf(bmax, fabsf(rel_bias[(i / 12) * 18 + 6 + (i % 12)]));
    bmax = wave_max(bmax);
    const float bound = gain_absmax(C.in[10], 64, lane) * gain_absmax(C.in[11], 64, lane) * 8.0f + bmax;
    const float shift = fmaxf(0.f, bound - 30.f);
#pragma unroll 1
    for (int u = C.vcu; u < 256; u += C.G) {
        const int b = u >> 7, g = (u >> 6) & 1, n = u & 63;
        const long s0 = (long)128 * n - 128;
        __syncthreads();
        { u32x4 kvr[4], vvr[4];
#pragma unroll
            for (int i = 0; i < 4; ++i) { const int c = tid + NTHREADS * i, kk = c >> 3, c8 = c & 7; const long sp = s0 + kk;
                kvr[i] = (u32x4){0u, 0u, 0u, 0u}; vvr[i] = (u32x4){0u, 0u, 0u, 0u};
                if (sp >= 0) { kvr[i] = *((const u32x4*)(BK + ((size_t)b * SEQ + sp) * 128 + g * 64) + c8); vvr[i] = *((const u32x4*)(BV + ((size_t)b * SEQ + sp) * 128 + g * 64) + c8); } }
#pragma unroll
            for (int i = 0; i < 4; ++i) { const int c = tid + NTHREADS * i, kk = c >> 3, c8 = c & 7;
                *(LAS u32x4*)(Kl + kk * SW_KSTR + c8 * 16) = kvr[i];
                const unsigned vw[4] = {vvr[i].x, vvr[i].y, vvr[i].z, vvr[i].w};
#pragma unroll
                for (int e = 0; e < 4; ++e) { *(LAS bf16_t*)(Vt + (c8 * 8 + 2 * e) * 520 + kk * 2) = (bf16_t)(vw[e] & 0xffff); *(LAS bf16_t*)(Vt + (c8 * 8 + 2 * e + 1) * 520 + kk * 2) = (bf16_t)(vw[e] >> 16); } } }
        for (int i = tid; i < 6 * 128; i += NTHREADS) { const int hl = i >> 7, dist = i & 127; bl[i] = rel_bias[T5_BUCKET[dist] * 18 + 6 + 6 * g + hl]; }
        __syncthreads();
#pragma unroll 1
        for (int it = wave; it < 24; it += NWAVES) {
            const int hl = it >> 2, qt = it & 3, hq = 6 * g + hl;
            const size_t qrow = (size_t)b * SEQ + 128 * n + 32 * qt + (lane & 31);
            u32x4 qf[4];
#pragma unroll
            for (int ks = 0; ks < 4; ++ks) qf[ks] = *((const u32x4*)(BQ + qrow * 768 + hq * 64) + 2 * ks + (lane >> 5));
            const int dq = 128 + 32 * qt + (lane & 31);
            const LAS float* blh = bl + hl * 128;
            auto elem = [&](int kk, float sv) -> float { const int dist = dq - kk; const bool ok = dist >= 0 && dist < 128 && (s0 + kk) >= 0;
                const float e = __expf(sv + blh[dist & 127] - shift); return ok ? e : 0.f; };
            f32x16 O[2]; float lsum;
            tile_attn_item<64, SW_KSTR>(Kl, Vt, qf, qt, qt + 5, lane, elem, O, lsum);
            lsum += __shfl_xor(lsum, 32);
            const float inv = 1.0f / (lsum + __expf(sinks[hq] - shift));
            LAS unsigned char* T = C.lds + SW_T + wave * (32 * SW_KSTR);
#pragma unroll
            for (int dt = 0; dt < 2; ++dt)
#pragma unroll
                for (int r4 = 0; r4 < 4; ++r4) { u32x2 w; w.x = pk2(O[dt][4 * r4 + 0] * inv, O[dt][4 * r4 + 1] * inv); w.y = pk2(O[dt][4 * r4 + 2] * inv, O[dt][4 * r4 + 3] * inv);
                    *(LAS u32x2*)(T + (lane & 31) * SW_KSTR + (32 * dt + 8 * r4 + 4 * (lane >> 5)) * 2) = w; }
            asm volatile("s_waitcnt lgkmcnt(0)" ::: "memory");
            const size_t qb0 = (size_t)b * SEQ + 128 * n + 32 * qt;
#pragma unroll
            for (int i = 0; i < 4; ++i) { const int rw = 8 * i + (lane >> 3), ch = lane & 7; const size_t ob = (qb0 + rw) * 2048 + 768 + hq * 64 + 8 * ch;
                const u32x4 ov = *(const LAS u32x4*)(T + rw * SW_KSTR + ch * 16); const u32x4 gw = *(const u32x4*)(GATE + ob);
                u32x2 o8;
                o8.x = pk4_fp8(16.f * bf2f(ov.x & 0xffff) * bf2f(gw.x & 0xffff), 16.f * bf2f(ov.x >> 16) * bf2f(gw.x >> 16), 16.f * bf2f(ov.y & 0xffff) * bf2f(gw.y & 0xffff), 16.f * bf2f(ov.y >> 16) * bf2f(gw.y >> 16));
                o8.y = pk4_fp8(16.f * bf2f(ov.z & 0xffff) * bf2f(gw.z & 0xffff), 16.f * bf2f(ov.z >> 16) * bf2f(gw.z >> 16), 16.f * bf2f(ov.w & 0xffff) * bf2f(gw.w & 0xffff), 16.f * bf2f(ov.w >> 16) * bf2f(gw.w >> 16));
                *(u32x2*)((unsigned char*)OP + ob) = o8; }
            asm volatile("s_waitcnt lgkmcnt(0)" ::: "memory");
        }
    }
}
constexpr int MA_K = 0, MA_KSTR = 272, MA_VT = 256 * MA_KSTR;
static_assert(MA_VT + 128 * 520 <= LDS_BYTES, "mem-attn LDS map");
__device__ __forceinline__ void fast_mem(Ctx& C) {
    unsigned char* ws = C.ws; const int tid = opaque_v(C.tid), lane = tid & 63, wave = C.wave;
    const bf16_t* CQ = (const bf16_t*)(ws + WS_CQ); const bf16_t* KC = (const bf16_t*)(ws + WS_KC); const bf16_t* VC = (const bf16_t*)(ws + WS_VC);
    const bf16_t* GATE = (const bf16_t*)((unsigned char*)C.out + DO_GATE); bf16_t* OP = (bf16_t*)(ws + WS_OP);
    LAS unsigned char* Kl = C.lds + MA_K; LAS unsigned char* Vt = C.lds + MA_VT;
    const float bound = gain_absmax(C.in[15], 128, lane) * gain_absmax(C.in[16], 128, lane) * 11.3137085f;
    const float shift = fmaxf(0.f, bound - 30.f);
#pragma unroll 1
    for (int u = C.vcu; u < 256; u += C.G) {
        const int b = u >> 7, h = (u >> 5) & 3, n = u & 31;
        __syncthreads();
        { u32x4 kvr[8], vvr[8];
#pragma unroll
            for (int i = 0; i < 8; ++i) { const int c = tid + NTHREADS * i, kk = c >> 4, c8 = c & 15;
                kvr[i] = *((const u32x4*)(KC + ((size_t)b * MEMLEN + kk) * 512 + h * 128) + c8); vvr[i] = *((const u32x4*)(VC + ((size_t)b * MEMLEN + kk) * 512 + h * 128) + c8); }
#pragma unroll
            for (int i = 0; i < 8; ++i) { const int c = tid + NTHREADS * i, kk = c >> 4, c8 = c & 15;
                *(LAS u32x4*)(Kl + kk * MA_KSTR + c8 * 16) = kvr[i];
                const unsigned vw[4] = {vvr[i].x, vvr[i].y, vvr[i].z, vvr[i].w};
#pragma unroll
                for (int e = 0; e < 4; ++e) { *(LAS bf16_t*)(Vt + (c8 * 8 + 2 * e) * 520 + kk * 2) = (bf16_t)(vw[e] & 0xffff); *(LAS bf16_t*)(Vt + (c8 * 8 + 2 * e + 1) * 520 + kk * 2) = (bf16_t)(vw[e] >> 16); } } }
        __syncthreads();
        {
            const size_t qrow = (size_t)b * SEQ + 256 * n + 32 * wave + (lane & 31);
            u32x4 qf[8];
#pragma unroll
            for (int ks = 0; ks < 8; ++ks) qf[ks] = *((const u32x4*)(CQ + qrow * 512 + h * 128) + 2 * ks + (lane >> 5));
            auto elem = [&](int, float sv) -> float { return __expf(sv - shift); };
            f32x16 O[4]; float lsum;
            tile_attn_item<128, MA_KSTR>(Kl, Vt, qf, 0, 8, lane, elem, O, lsum);
            lsum += __shfl_xor(lsum, 32);
            const float inv = 1.0f / lsum;
            __syncthreads();
            LAS unsigned char* T = C.lds + wave * (32 * MA_KSTR);
#pragma unroll
            for (int dt = 0; dt < 4; ++dt)
#pragma unroll
                for (int r4 = 0; r4 < 4; ++r4) { u32x2 w; w.x = pk2(O[dt][4 * r4 + 0] * inv, O[dt][4 * r4 + 1] * inv); w.y = pk2(O[dt][4 * r4 + 2] * inv, O[dt][4 * r4 + 3] * inv);
                    *(LAS u32x2*)(T + (lane & 31) * MA_KSTR + (32 * dt + 8 * r4 + 4 * (lane >> 5)) * 2) = w; }
            asm volatile("s_waitcnt lgkmcnt(0)" ::: "memory");
            const size_t qb0 = (size_t)b * SEQ + 256 * n + 32 * wave;
#pragma unroll
            for (int i = 0; i < 8; ++i) { const int rw = 4 * i + (lane >> 4), ch = lane & 15; const size_t ob = (qb0 + rw) * 2048 + 1536 + h * 128 + 8 * ch;
                const u32x4 ov = *(const LAS u32x4*)(T + rw * MA_KSTR + ch * 16); const u32x4 gw = *(const u32x4*)(GATE + ob);
                u32x2 o8;
                o8.x = pk4_fp8(16.f * bf2f(ov.x & 0xffff) * bf2f(gw.x & 0xffff), 16.f * bf2f(ov.x >> 16) * bf2f(gw.x >> 16), 16.f * bf2f(ov.y & 0xffff) * bf2f(gw.y & 0xffff), 16.f * bf2f(ov.y >> 16) * bf2f(gw.y >> 16));
                o8.y = pk4_fp8(16.f * bf2f(ov.z & 0xffff) * bf2f(gw.z & 0xffff), 16.f * bf2f(ov.z >> 16) * bf2f(gw.z >> 16), 16.f * bf2f(ov.w & 0xffff) * bf2f(gw.w & 0xffff), 16.f * bf2f(ov.w >> 16) * bf2f(gw.w >> 16));
                *(u32x2*)((unsigned char*)OP + ob) = o8; }
        }
    }
}

__global__ void __launch_bounds__(NTHREADS, 2) mk_fwd(Args args) {
    extern __shared__ __attribute__((aligned(16))) unsigned char lds_raw[];
    Ctx C;
    C.in = args.in;
    C.out = args.out; C.ws = args.ws;
    C.lds = (LAS unsigned char*)lds_raw;
    C.tid = threadIdx.x; C.lane = C.tid & 63; C.wave = __builtin_amdgcn_readfirstlane(C.tid >> 6);
    C.G = gridDim.x; { const int bx = blockIdx.x; C.vcu = (C.G % 8 == 0) ? (bx % 8) * (C.G / 8) + bx / 8 : bx; }
    cg::grid_group grid = cg::this_grid();
    volatile LAS unsigned* bst = (volatile LAS unsigned*)(C.lds + LDS_BYTES - 64);
    if (C.tid < 16) bst[C.tid] = 0u;
    __syncthreads();
    if (blockIdx.x == 0) { unsigned* bw = (unsigned*)(args.ws + WS_CTL); for (int i = C.tid; i < XCD_BAR_WORDS; i += NTHREADS) bw[i] = 0u; }
    XcdBarrier xbar;
    const int lo = args.ph_lo, hi = args.ph_hi;
    unsigned char* ws = C.ws;
#ifndef PHMASK
#define PHMASK 0x7f
#endif
#define IN(k) (((PHMASK >> (k)) & 1) && lo <= (k) && (k) < hi)
#define SEAM(k) do { if (IN(k) && IN((k) + 1)) { if ((k) == 0) grid.sync(); else xcd_barrier(xbar); } } while (0)
    const int bx = (int)blockIdx.x;

    if (IN(0)) { p0_prologue(C); }
    grid.sync();
    xbar = xcd_barrier_post((unsigned*)(args.ws + WS_CTL), bst);
    if (IN(1)) {
        EpiIn E{C.lds, ws, (unsigned char*)C.out, C.in, 0, 1};
        { pg8::Gemm g{(const bf16_t*)(ws + WS_H), (const bf16_t*)(ws + WS_WINT), M, NWIN_A, 2048, 2048, 2048, 0}; pg8::StaticOrder S; S.init(M, NWIN_A, C.G, bx);
          pg8::gemm_phase<EpiIn, pg8::StaticOrder>(C.lds, g, S, E); }
        {
          pg8::Gemm g{(const bf16_t*)(ws + WS_H8), (const bf16_t*)(ws + WS_WMIX8), M, NWIN_B, 2048, 2048, 2048, 0}; pg8::StaticOrder S; S.init(M, NWIN_B, C.G, bx);
          E.pnoff = 2;
          pg8::gemm_phase<EpiIn, pg8::StaticOrder, true, true, true>(C.lds, g, S, E); E.pnoff = 0; }
        { E.memkv = 1; pg8::Gemm g{(const bf16_t*)(ws + WS_MEMN), (const bf16_t*)(ws + WS_WMEMT), BATCH * MEMLEN, 1024, 2048, 2048, 2048, 0}; pg8::StaticOrder S; S.init(BATCH * MEMLEN, 1024, C.G, (bx + 64) % C.G);
          pg8::gemm_phase<EpiIn, pg8::StaticOrder>(C.lds, g, S, E); }
    }
    SEAM(1);
    if (IN(2)) {
        { pg8::Gemm g{(const bf16_t*)(ws + WS_CKV), (const bf16_t*)(ws + WS_WKT), M, 768, 256, 256, 256, 0}; pg8::StaticOrder S; S.init(M, 768, C.G, bx);
          EpiKss E{(float*)(ws + WS_KSS)};
          pg8::gemm_phase<EpiKss, pg8::StaticOrder>(C.lds, g, S, E); }
        { int kq = 128; asm volatile("" : "+s"(kq));
          pg8::Gemm g{(const bf16_t*)(ws + WS_QA), (const bf16_t*)(ws + WS_WQBD), M, 1536, kq, 768, 128, 128}; pg8::StaticOrder S; S.init(M, 1536, C.G, bx);
          EpiBf E{(bf16_t*)(ws + WS_QABS), 1536};
          pg8::gemm_phase<EpiBf, pg8::StaticOrder>(C.lds, g, S, E); }
        fast_indexer<15>(C, (int*)(ws + WS_IDX));
        __syncthreads();
        fast_swa(C);
        __syncthreads();
        fast_mem(C);
    }
    SEAM(2);
    if (IN(3)) { fast_dsa(C); }
    SEAM(3);
    if (IN(4)) {
        pg8::Gemm g{(const bf16_t*)(ws + WS_PC), (const bf16_t*)(ws + WS_WVBD), M, 768, 512, 1536, 512, 512}; pg8::StaticOrder S; S.init(M, 768, C.G, bx);
        EpiGateMul E{(bf16_t*)(ws + WS_OP), (const bf16_t*)((unsigned char*)C.out + DO_GATE)};
        pg8::gemm_phase<EpiGateMul, pg8::StaticOrder>(C.lds, g, S, E);
    }
    SEAM(4);
    if (IN(5)) {
        pg8::Gemm g{(const bf16_t*)(ws + WS_OP), (const bf16_t*)(ws + WS_WUPT), M, 2048, 2048, 2048, 2048, 0, 0x7b7b7b7b, 0x7a7a7a7a}; pg8::StaticOrder S; S.init(M, 2048, C.G, bx);
        EpiMerge E{(bf16_t*)(ws + WS_MERGED), (const unsigned char*)(ws + WS_BIG), 6, 12};
        pg8::gemm_phase<EpiMerge, pg8::StaticOrder, true, true, true>(C.lds, g, S, E);
    }
    SEAM(5);
    if (IN(6)) {
        pg8::Gemm g{(const bf16_t*)(ws + WS_MERGED), (const bf16_t*)(ws + WS_WOT), M, 2048, 2048, 2048, 2048, 0, 0x7b7b7b7b, 0x79797979}; pg8::StaticOrder S; S.init(M, 2048, C.G, bx);
        EpiOut E{C.out, C.in[0]};
        pg8::gemm_phase<EpiOut, pg8::StaticOrder, true, true, true>(C.lds, g, S, E);
    }
#undef IN
#undef SEAM
}

extern "C" void kernel_launch(void* const* d_in, const int* in_sizes, int n_in, void* d_out, int out_size, void* d_ws, size_t ws_size, hipStream_t stream) {
    static int grid = 0;
    if (grid == 0) {
        if (n_in != 23 || out_size != M * DM || ws_size < WS_END) { fprintf(stderr, "kernel_launch: unexpected shapes (n_in %d out %d ws %zu)\n", n_in, out_size, ws_size); grid = -1; return; }
        int dev = 0, cus = 0, per_cu = 0;
        hipGetDevice(&dev); hipDeviceGetAttribute(&cus, hipDeviceAttributeMultiprocessorCount, dev);
        hipFuncSetAttribute((const void*)mk_fwd, hipFuncAttributeMaxDynamicSharedMemorySize, LDS_BYTES);
        hipOccupancyMaxActiveBlocksPerMultiprocessor(&per_cu, (const void*)mk_fwd, NTHREADS, LDS_BYTES);
        if (per_cu < 1) { fprintf(stderr, "kernel_launch: occupancy query says %d blocks/CU\n", per_cu); per_cu = 1; }
        (void)hipGetLastError();
        grid = cus;
    }
    if (grid < 0) return;
    Args a{};
    for (int i = 0; i < 23; ++i) a.in[i] = (const float*)d_in[i];
    a.out = (float*)d_out; a.ws = (unsigned char*)d_ws;
#if MK_SINGLE
    a.ph_lo = 0; a.ph_hi = 7; a.single = 1;
    void* kargs[] = {&a};
    hipError_t e = hipLaunchCooperativeKernel((const void*)mk_fwd, dim3(grid), dim3(NTHREADS), kargs, LDS_BYTES, stream);
    if (e != hipSuccess) fprintf(stderr, "cooperative launch failed: %s (grid %d)\n", hipGetErrorString(e), grid);
#else
    for (int p = 0; p < 7; ++p) { a.ph_lo = p; a.ph_hi = p + 1; a.single = 0;
        hipLaunchKernelGGL(mk_fwd, dim3(grid), dim3(NTHREADS), LDS_BYTES, stream, a); }
#endif
}
```
